# Optimizing an MI355X kernel written in HIP

```python
import jax, jax.numpy as jnp
from jax import lax
import numpy as np

D_MODEL = 2048
BATCH = 2
SEQ = 16384
DEPTH = 4

GRID_W = 64
CTX_LEN = 256
A_HEADS = 8
A_DV = D_MODEL // A_HEADS
A_DK = A_DV // 2
A_WIDTH = A_HEADS * A_DV
A_CHUNK = 64
A_FBIAS_LO = 3.0
A_FBIAS_HI = 6.0
B_HEADS = 16
B_DH = D_MODEL // B_HEADS
B_WIDTH = B_HEADS * B_DH
NA_KH = 8
NA_KW = 16
NA_QB = 16
ROPE_BASE = 10000.0
EPS = 1e-6
IN_NAMES = ('aq', 'ak', 'av', 'ao', 'az', 'ai_f', 'af_f', 'ai_b', 'af_b', 'bq', 'bk', 'bv', 'bz', 'ga', 'gb')
IN_SIZES = (A_HEADS * A_DK, A_HEADS * A_DK, A_WIDTH, A_WIDTH, A_WIDTH, A_HEADS, A_HEADS, A_HEADS, A_HEADS, B_WIDTH, B_WIDTH, B_WIDTH, B_WIDTH, D_MODEL, D_MODEL)
N_IN = 2 * A_HEADS * A_DK + 3 * A_WIDTH + 4 * A_HEADS + 4 * B_WIDTH + 2 * D_MODEL

kernel_name = 'hybrid_mlstm_natten_block'


def _in_offset(name):
    return int(sum(IN_SIZES[:IN_NAMES.index(name)]))


def _split_in(p):
    out = {}
    off = 0
    for name, size in zip(IN_NAMES, IN_SIZES):
        out[name] = p[..., off:off + size]
        off += size
    return out


def _heads(a, h):
    return a.reshape(a.shape[:-1] + (h, a.shape[-1] // h))


def _rms(x, g):
    xf = x.astype(jnp.float32)
    y = xf * lax.rsqrt(jnp.mean(xf * xf, axis=-1, keepdims=True) + EPS)
    return (y * g.astype(jnp.float32)).astype(x.dtype)


def _modulate(x, g, shift, scale):
    return _rms(x, g) * (1 + scale) + shift


def _rope_tables(n_tok):
    t = jnp.arange(n_tok)
    row = (t // GRID_W).astype(jnp.float32)
    col = (t % GRID_W).astype(jnp.float32)
    nf = A_DK // 4
    inv = ROPE_BASE ** (-jnp.arange(nf, dtype=jnp.float32) / nf)
    ar = row[:, None, None] * inv
    ac = col[:, None, None] * inv
    return (jnp.cos(ar), jnp.sin(ar), jnp.cos(ac), jnp.sin(ac))


def _rope(x, tabs):
    cos_r, sin_r, cos_c, sin_c = tabs
    xr, xc = jnp.split(x, 2, axis=-1)

    def rot(u, cs, sn):
        u1, u2 = jnp.split(u, 2, axis=-1)
        return jnp.concatenate([u1 * cs - u2 * sn, u1 * sn + u2 * cs], axis=-1)

    return jnp.concatenate([rot(xr, cos_r, sin_r), rot(xc, cos_c, sin_c)], axis=-1)


def _mlstm_scan(q, k, v, i_pre, f_pre, state, with_out):
    bsz, n_tok, n_heads, _ = k.shape
    nc = n_tok // A_CHUNK

    def chunks(a):
        return jnp.moveaxis(a.reshape((bsz, nc, A_CHUNK) + a.shape[2:]), 1, 0)

    tril = jnp.tril(jnp.ones((A_CHUNK, A_CHUNK), dtype=bool))

    def step(carry, xs):
        C, n, m = carry
        qc, kc, vc, ic, logf = xs
        b = jnp.cumsum(logf, axis=1)
        g = b[:, -1]
        a = g[:, None] - b + ic
        m_new = jnp.maximum(g + m, jnp.max(a, axis=1))
        w_prev = jnp.exp(g + m - m_new)
        w_tok = jnp.exp(a - m_new[:, None])
        C_new = w_prev[..., None, None] * C + jnp.einsum('bsh,bshv,bshd->bhvd', w_tok, vc, kc)
        n_new = w_prev[..., None] * n + jnp.einsum('bsh,bshd->bhd', w_tok, kc)
        h = None
        if with_out:
            log_d = b[:, :, None] - b[:, None] + ic[:, None]
            log_d = jnp.where(tril[None, :, :, None], log_d, -jnp.inf)
            inter = b + m[:, None]
            m_q = jnp.maximum(inter, jnp.max(log_d, axis=2))
            s = jnp.einsum('bjhd,bshd->bjsh', qc, kc) * jnp.exp(log_d - m_q[:, :, None])
            w_int = jnp.exp(inter - m_q)
            num = jnp.einsum('bjsh,bshv->bjhv', s, vc) + w_int[..., None] * jnp.einsum('bhvd,bjhd->bjhv', C, qc)
            den = jnp.sum(s, axis=2) + w_int * jnp.einsum('bhd,bjhd->bjh', n, qc)
            h = num / jnp.maximum(jnp.abs(den), jnp.exp(-m_q))[..., None]
        return (C_new, n_new, m_new), h

    xs = (chunks(q) if with_out else None, chunks(k), chunks(v), chunks(i_pre), chunks(jax.nn.log_sigmoid(f_pre)))
    state, h = lax.scan(step, state, xs)
    if with_out:
        h = jnp.moveaxis(h, 0, 1).reshape(bsz, n_tok, n_heads, -1)
    return h, state


def _rev(a):
    return jnp.flip(a, axis=1)


def _mlstm_out(h, p, g):
    hn = h * lax.rsqrt(jnp.mean(h * h, axis=-1, keepdims=True) + EPS) * g.astype(jnp.float32).reshape(A_HEADS, A_DV)
    y = hn.reshape(h.shape[:2] + (A_WIDTH,)).astype(p['ao'].dtype)
    return y * jax.nn.sigmoid(p['ao']) * jax.nn.silu(p['az'])


def _mlstm_branch(pl, pc, rope_tabs, norm_g, need_ctx):
    f32 = jnp.float32

    def qkv(p, use_rope):
        q = _heads(p['aq'], A_HEADS).astype(f32)
        k = _heads(p['ak'], A_HEADS).astype(f32) * (A_DK ** -0.5)
        v = _heads(p['av'], A_HEADS).astype(f32)
        if use_rope:
            q = _rope(q, rope_tabs)
            k = _rope(k, rope_tabs)
        return q, k, v

    def gates(p):
        return tuple(p[n].astype(f32) for n in ('ai_f', 'af_f', 'ai_b', 'af_b'))

    ql, kl, vl = qkv(pl, True)
    qc, kc, vc = qkv(pc, False)
    il_f, fl_f, il_b, fl_b = gates(pl)
    ic_f, fc_f, ic_b, fc_b = gates(pc)
    bsz = kc.shape[0]
    zero = (jnp.zeros((bsz, A_HEADS, A_DV, A_DK), f32), jnp.zeros((bsz, A_HEADS, A_DK), f32), jnp.zeros((bsz, A_HEADS), f32))
    hc_f, st_f = _mlstm_scan(qc if need_ctx else None, kc, vc, ic_f, fc_f, zero, need_ctx)
    hc_b, st_b = _mlstm_scan(_rev(qc) if need_ctx else None, _rev(kc), _rev(vc), _rev(ic_b), _rev(fc_b), zero, need_ctx)
    hl_f, _ = _mlstm_scan(ql, kl, vl, il_f, fl_f, st_f, True)
    hl_b, _ = _mlstm_scan(_rev(ql), _rev(kl), _rev(vl), _rev(il_b), _rev(fl_b), st_b, True)
    y_lat = _mlstm_out(hl_f + _rev(hl_b), pl, norm_g)
    y_ctx = _mlstm_out(hc_f + _rev(hc_b), pc, norm_g) if need_ctx else None
    return y_lat, y_ctx


def _na_col_tables():
    nblk = GRID_W // NA_QB
    kcw = NA_QB + NA_KW
    j = np.arange(nblk)
    cs = np.clip(j * NA_QB - NA_KW // 2, 0, GRID_W - kcw)
    col_idx = cs[:, None] + np.arange(kcw)[None]
    qcol = j[:, None] * NA_QB + np.arange(NA_QB)[None]
    ws = np.clip(qcol - NA_KW // 2, 0, GRID_W - NA_KW)
    kcol = col_idx[:, None, :]
    mask = (kcol >= ws[..., None]) & (kcol < ws[..., None] + NA_KW)
    dc = np.clip(kcol - qcol[..., None] + NA_KW - 1, 0, 2 * NA_KW - 2)
    return col_idx, mask, dc


def _na_branch(pl, pc, rows, q_g, k_g, rpb, need_ctx):
    f32 = jnp.float32
    scale = B_DH ** -0.5
    ql = _rms(_heads(pl['bq'], B_HEADS), q_g)
    kl = _rms(_heads(pl['bk'], B_HEADS), k_g)
    vl = _heads(pl['bv'], B_HEADS)
    kc = _rms(_heads(pc['bk'], B_HEADS), k_g)
    vc = _heads(pc['bv'], B_HEADS)
    bsz, n_tok = ql.shape[:2]
    kh = min(NA_KH, rows)
    col_idx, col_mask, dc_idx = _na_col_tables()
    nblk, kcw = col_idx.shape
    n_lat = kh * kcw
    mask = np.broadcast_to(col_mask[:, :, None, :], (nblk, NA_QB, kh, kcw)).reshape(nblk, NA_QB, n_lat)
    kg = kl.reshape(bsz, rows, GRID_W, B_HEADS, B_DH)
    vg = vl.reshape(bsz, rows, GRID_W, B_HEADS, B_DH)
    qg = jnp.moveaxis(ql.reshape(bsz, rows, nblk, NA_QB, B_HEADS, B_DH), 1, 0)

    def gather(a, rs):
        blk = lax.dynamic_slice_in_dim(a, rs, kh, axis=1)[:, :, col_idx]
        return blk.transpose(0, 2, 1, 3, 4, 5).reshape(bsz, nblk, n_lat, B_HEADS, B_DH)

    def row_step(args):
        r, q_r = args
        rs = jnp.clip(r - kh // 2, 0, rows - kh)
        k_b = gather(kg, rs)
        v_b = gather(vg, rs)
        dr = rs + jnp.arange(kh) - r + (NA_KH - 1)
        bias = rpb[:, dr][:, :, dc_idx].transpose(0, 2, 3, 1, 4).reshape(B_HEADS, nblk, NA_QB, n_lat)
        s_lat = jnp.einsum('bjuhd,bjkhd->bhjuk', q_r, k_b).astype(f32) * scale + bias.astype(f32)
        s_lat = jnp.where(mask, s_lat, -jnp.inf)
        s_ctx = jnp.einsum('bjuhd,bchd->bhjuc', q_r, kc).astype(f32) * scale
        p = jax.nn.softmax(jnp.concatenate([s_lat, s_ctx], axis=-1), axis=-1).astype(v_b.dtype)
        return (jnp.einsum('bhjuk,bjkhd->bjuhd', p[..., :n_lat], v_b)
                + jnp.einsum('bhjuc,bchd->bjuhd', p[..., n_lat:], vc))

    o = lax.map(row_step, (jnp.arange(rows), qg))
    o = jnp.moveaxis(o, 0, 1).reshape(bsz, n_tok, B_WIDTH)
    y_lat = o * jax.nn.silu(pl['bz'])
    y_ctx = None
    if need_ctx:
        qc = _rms(_heads(pc['bq'], B_HEADS), q_g)
        s = jnp.einsum('bqhd,bkhd->bhqk', qc, kc).astype(f32) * scale
        p = jax.nn.softmax(s, axis=-1).astype(vc.dtype)
        oc = jnp.einsum('bhqk,bkhd->bqhd', p, vc).reshape(bsz, -1, B_WIDTH)
        y_ctx = oc * jax.nn.silu(pc['bz'])
    return y_lat, y_ctx


def _merge(y_a, y_b, p, w_a, w_b, w_o, b_o):
    y = jax.nn.sigmoid(p['ga']) * (y_a @ w_a) + jax.nn.sigmoid(p['gb']) * (y_b @ w_b)
    return y @ w_o + b_o


def setup_inputs(seed: int = 0) -> dict:
    key = jax.random.key(seed)
    ks = jax.random.split(key, 17)

    def nrm(k, shape, s):
        return jax.random.normal(k, shape, jnp.float32) * s

    fbias = jnp.linspace(A_FBIAS_LO, A_FBIAS_HI, A_HEADS, dtype=jnp.float32)
    off_f = _in_offset('af_f')
    off_b = _in_offset('af_b')
    b_in = nrm(ks[8], (DEPTH, N_IN), 0.01)
    b_in = b_in.at[:, off_f:off_f + A_HEADS].add(fbias).at[:, off_b:off_b + A_HEADS].add(fbias)
    return {
        'x': nrm(ks[0], (BATCH, SEQ, D_MODEL), 1.0),
        'c': nrm(ks[1], (BATCH, D_MODEL), 1.0),
        'ctx': nrm(ks[2], (BATCH, CTX_LEN, D_MODEL), 1.0),
        'c_ctx': nrm(ks[3], (D_MODEL,), 1.0),
        'w_mod': nrm(ks[4], (DEPTH, D_MODEL, 3 * D_MODEL), 0.5 * D_MODEL ** -0.5),
        'b_mod': nrm(ks[5], (DEPTH, 3 * D_MODEL), 0.01),
        'norm_g': 1.0 + nrm(ks[6], (DEPTH, D_MODEL), 0.02),
        'w_in': nrm(ks[7], (DEPTH, D_MODEL, N_IN), D_MODEL ** -0.5),
        'b_in': b_in,
        'a_norm_g': 1.0 + nrm(ks[9], (DEPTH, A_WIDTH), 0.02),
        'w_br_a': nrm(ks[10], (DEPTH, A_WIDTH, D_MODEL), A_WIDTH ** -0.5),
        'w_br_b': nrm(ks[11], (DEPTH, B_WIDTH, D_MODEL), B_WIDTH ** -0.5),
        'na_q_g': 1.0 + nrm(ks[12], (DEPTH, B_DH), 0.02),
        'na_k_g': 1.0 + nrm(ks[13], (DEPTH, B_DH), 0.02),
        'na_rpb': nrm(ks[14], (DEPTH, B_HEADS, 2 * NA_KH - 1, 2 * NA_KW - 1), 0.05),
        'w_out': nrm(ks[15], (DEPTH, D_MODEL, D_MODEL), D_MODEL ** -0.5),
        'b_out': nrm(ks[16], (DEPTH, D_MODEL), 0.01),
    }


def reference(x, c, ctx, c_ctx, w_mod, b_mod, norm_g, w_in, b_in, a_norm_g, w_br_a, w_br_b, na_q_g, na_k_g, na_rpb, w_out, b_out):
    n_tok = x.shape[1]
    rows = n_tok // GRID_W
    rope_tabs = _rope_tables(n_tok)
    sc = jax.nn.silu(c)
    sc_ctx = jax.nn.silu(c_ctx)
    for l in range(DEPTH):
        need_ctx = l < DEPTH - 1
        shift, scale, gate = jnp.split(sc @ w_mod[l] + b_mod[l], 3, axis=-1)
        shift_c, scale_c, gate_c = jnp.split(sc_ctx @ w_mod[l] + b_mod[l], 3, axis=-1)
        h_lat = _modulate(x, norm_g[l], shift[:, None], scale[:, None])
        h_ctx = _modulate(ctx, norm_g[l], shift_c, scale_c)
        pl = _split_in(h_lat @ w_in[l] + b_in[l])
        pc = _split_in(h_ctx @ w_in[l] + b_in[l])
        ya_l, ya_c = _mlstm_branch(pl, pc, rope_tabs, a_norm_g[l], need_ctx)
        yb_l, yb_c = _na_branch(pl, pc, rows, na_q_g[l], na_k_g[l], na_rpb[l], need_ctx)
        x = x + gate[:, None] * _merge(ya_l, yb_l, pl, w_br_a[l], w_br_b[l], w_out[l], b_out[l])
        if need_ctx:
            ctx = ctx + gate_c * _merge(ya_c, yb_c, pc, w_br_a[l], w_br_b[l], w_out[l], b_out[l])
    return x
```

```cpp
#include <hip/hip_runtime.h>
#include <cstdio>
#include <cstdint>
#ifndef N_LAUNCH_MODE
#define N_LAUNCH_MODE 0
#endif
namespace pg8 {
#define PG8_LAS __attribute__((address_space(3)))
typedef unsigned short bf16_t;
typedef short bf16x8 __attribute__((ext_vector_type(8)));
typedef float f32x4 __attribute__((ext_vector_type(4)));
typedef unsigned u32x4 __attribute__((ext_vector_type(4)));
constexpr int BM = 256, BK = 64, HALF = 128, HTB = HALF * BK * 2  , STAGE_BYTES = 8 * HTB, NXCD = 8, WGM = 8;

__host__ __device__ __forceinline__ int lds_byte(int r, int c) { const int st = (r >> 4) * 2 + (c >> 5), rr = r & 15, cc = c & 31, ob = rr * 64 + cc * 2; return st * 1024 + (ob ^ (((ob >> 9) & 1) << 5)); }
__host__ __device__ __forceinline__ void stage_rc(int b, int& R, int& C) { const int st = b / 1024, sb = b % 1024, swz = sb ^ (((sb >> 9) & 1) << 5); R = (st >> 1) * 16 + swz / 64; C = (st & 1) * 32 + (swz % 64) / 2; }
__host__ __device__ __forceinline__ int perm32(int rho) { const int n = rho >> 4, i = rho & 15; return 8 * (i >> 2) + 4 * n + (i & 3); }

struct Unit { int pm, pn; };
struct Gemm { const bf16_t* A; const bf16_t* Bt; int M, N, K; };

struct StaticOrder {
    int nM, nN, nwg, G, c;
    __host__ __device__ void init(int M, int N, int G_, int c_) { nM = M / BM; nN = N / BM; nwg = nM * nN; G = G_; c = c_; }
    __host__ __device__ bool next(int i, Unit& u) const {
        const long L = (long)i * G + c; if (L >= nwg) return false;
        int wgid = (int)L; { const int q = nwg / NXCD, r = nwg % NXCD, xcd = wgid % NXCD, off = wgid / NXCD; wgid = (xcd < r ? xcd * (q + 1) : r * (q + 1) + (xcd - r) * q) + off; }
        const int nig = WGM * nN, gid = wgid / nig, fm = gid * WGM, gsz = (nM - fm) < WGM ? (nM - fm) : WGM;
        u.pm = fm + ((wgid % nig) % gsz); u.pn = (wgid % nig) / gsz; return true;
    }
    __device__ __forceinline__ void a_ready(const Unit&) const {}
    __device__ __forceinline__ void done(const Unit&) const {}
};


__device__ __forceinline__ unsigned cvt_pk_bf16(float lo, float hi) { unsigned r; asm volatile("v_cvt_pk_bf16_f32 %0, %1, %2" : "=v"(r) : "v"(lo), "v"(hi)); return r; }
__device__ __forceinline__ float bf_lo(unsigned w) { return __builtin_bit_cast(float, w << 16); }
__device__ __forceinline__ float bf_hi(unsigned w) { return __builtin_bit_cast(float, w & 0xffff0000u); }
__device__ __forceinline__ float sigmoid_f(float x) { return 1.0f / (1.0f + __expf(-x)); }

constexpr int E_MLAT = 32768, E_NP = 20480;

struct EpiIn {
    static constexpr bool PERM = true, AFTER_DRAIN = false;
    bf16_t* P; float* G; float* SSQ; const float* bias; const float* rope; int mall;
    __device__ __forceinline__ void operator()(const f32x4 (&acc)[2][2][4][2], const Unit& u, int wr, int wc, int fr, int fq) const {
        const int pn = u.pn; const int row0 = u.pm * BM + wr * 64 + fr;
        if (pn == 80) {
            if (wc == 0) {
#pragma unroll
                for (int ai = 0; ai < 2; ++ai)
#pragma unroll
                    for (int m = 0; m < 4; ++m) { const int row = row0 + ai * HALF + m * 16;
#pragma unroll
                        for (int n = 0; n < 2; ++n) { const f32x4 bv = *(const f32x4*)(bias + 8192 + 8 * fq + 4 * n);
                            *(f32x4*)(G + (size_t)row * 32 + 8 * fq + 4 * n) = acc[ai][0][m][n] + bv; } }
            }
            return;
        }
        const int colt = pn * BM; const int ocolt = colt < 8192 ? colt : colt + 32; const int cw = wc * 32 + 8 * fq;
        f32x4 bv[2][2];
#pragma unroll
        for (int bj = 0; bj < 2; ++bj)
#pragma unroll
            for (int n = 0; n < 2; ++n) bv[bj][n] = *(const f32x4*)(bias + ocolt + bj * HALF + cw + 4 * n);
        const bool is_rope = pn < 8;
        if (is_rope) {
#pragma unroll
            for (int bj = 0; bj < 2; ++bj) { const float* bh = bias + colt + bj * HALF + 64 * (wc >> 1) + 16 * (wc & 1) + 4 * fq;
                const f32x4 b1 = *(const f32x4*)bh, b2 = *(const f32x4*)(bh + 32);
                bv[bj][0] = (f32x4){b1[0], b2[0], b1[1], b2[1]}; bv[bj][1] = (f32x4){b1[2], b2[2], b1[3], b2[3]}; }
        } const float ksc = (pn >= 4 && pn < 8) ? 0.08838834764831845f : 1.0f;
        const bool is_ssq = (pn >= 32 && pn < 48); const int which = pn >= 40 ? 1 : 0; const int hd0 = 2 * (pn - 32 - 8 * which);
        const int blk = wc >> 1, i0 = 16 * (wc & 1) + 4 * fq;
#pragma unroll
        for (int ai = 0; ai < 2; ++ai)
#pragma unroll
            for (int m = 0; m < 4; ++m) { const int row = row0 + ai * HALF + m * 16; bf16_t* rowp = P + (size_t)row * E_NP + colt + cw;
                f32x4 cs0 = (f32x4){1.f, 0.f, 1.f, 0.f}, cs1 = cs0;
                if (is_rope && row < E_MLAT) { const int t = row & 16383; const int pos = blk ? (t & 63) : (t >> 6);
                    cs0 = *(const f32x4*)(rope + (size_t)(pos * 32 + i0) * 2); cs1 = *(const f32x4*)(rope + (size_t)(pos * 32 + i0) * 2 + 4); }
#pragma unroll
                for (int bj = 0; bj < 2; ++bj) { f32x4 v0 = acc[ai][bj][m][0] + bv[bj][0], v1 = acc[ai][bj][m][1] + bv[bj][1];
                    if (is_rope) {
                        f32x4 r0, r1;
                        r0[0] = v0[0] * cs0[0] - v0[1] * cs0[1]; r0[1] = v0[0] * cs0[1] + v0[1] * cs0[0]; r0[2] = v0[2] * cs0[2] - v0[3] * cs0[3]; r0[3] = v0[2] * cs0[3] + v0[3] * cs0[2];
                        r1[0] = v1[0] * cs1[0] - v1[1] * cs1[1]; r1[1] = v1[0] * cs1[1] + v1[1] * cs1[0]; r1[2] = v1[2] * cs1[2] - v1[3] * cs1[3]; r1[3] = v1[2] * cs1[3] + v1[3] * cs1[2];
                        v0 = r0 * ksc; v1 = r1 * ksc;
                    }
                    if (is_ssq) { float s = (v0[0] * v0[0] + v0[1] * v0[1]) + (v0[2] * v0[2] + v0[3] * v0[3]) + (v1[0] * v1[0] + v1[1] * v1[1]) + (v1[2] * v1[2] + v1[3] * v1[3]);
                        s += __shfl_xor(s, 16); s += __shfl_xor(s, 32);
                        if (fq == 0) SSQ[(((size_t)which * mall + row) * 16 + hd0 + bj) * 4 + wc] = s; }
                    u32x4 w; w.x = cvt_pk_bf16(v0[0], v0[1]); w.y = cvt_pk_bf16(v0[2], v0[3]); w.z = cvt_pk_bf16(v1[0], v1[1]); w.w = cvt_pk_bf16(v1[2], v1[3]);
                    *(u32x4*)(rowp + bj * HALF) = w; } }
    }
};

template <int SECOND> struct EpiMerge {
    static constexpr bool PERM = true, AFTER_DRAIN = false;
    const bf16_t* P; int goff; const bf16_t* Tin; bf16_t* O;
    __device__ __forceinline__ void operator()(const f32x4 (&acc)[2][2][4][2], const Unit& u, int wr, int wc, int fr, int fq) const {
        const int row0 = u.pm * BM + wr * 64 + fr; const int col0 = u.pn * BM + wc * 32 + 8 * fq;
#pragma unroll
        for (int ai = 0; ai < 2; ++ai)
#pragma unroll
            for (int m = 0; m < 4; ++m) { const int row = row0 + ai * HALF + m * 16;
#pragma unroll
                for (int bj = 0; bj < 2; ++bj) { const int col = col0 + bj * HALF;
                    const u32x4 gw = *(const u32x4*)(P + (size_t)row * E_NP + goff + col);
                    f32x4 v0 = acc[ai][bj][m][0], v1 = acc[ai][bj][m][1];
                    v0[0] *= sigmoid_f(bf_lo(gw.x)); v0[1] *= sigmoid_f(bf_hi(gw.x)); v0[2] *= sigmoid_f(bf_lo(gw.y)); v0[3] *= sigmoid_f(bf_hi(gw.y));
                    v1[0] *= sigmoid_f(bf_lo(gw.z)); v1[1] *= sigmoid_f(bf_hi(gw.z)); v1[2] *= sigmoid_f(bf_lo(gw.w)); v1[3] *= sigmoid_f(bf_hi(gw.w));
                    if (SECOND) { const u32x4 tw = *(const u32x4*)(Tin + (size_t)row * 2048 + col);
                        v0[0] += bf_lo(tw.x); v0[1] += bf_hi(tw.x); v0[2] += bf_lo(tw.y); v0[3] += bf_hi(tw.y); v1[0] += bf_lo(tw.z); v1[1] += bf_hi(tw.z); v1[2] += bf_lo(tw.w); v1[3] += bf_hi(tw.w); }
                    u32x4 w; w.x = cvt_pk_bf16(v0[0], v0[1]); w.y = cvt_pk_bf16(v0[2], v0[3]); w.z = cvt_pk_bf16(v1[0], v1[1]); w.w = cvt_pk_bf16(v1[2], v1[3]);
                    *(u32x4*)(O + (size_t)row * 2048 + col) = w; } }
    }
};

struct EpiOut {
    static constexpr bool PERM = true, AFTER_DRAIN = false;
    const float* xin_lat; float* xout_lat; const float* xin_ctx; float* xout_ctx; const float* mod; const float* bout;
    __device__ __forceinline__ void operator()(const f32x4 (&acc)[2][2][4][2], const Unit& u, int wr, int wc, int fr, int fq) const {
        const int row0 = u.pm * BM + wr * 64 + fr; const int col0 = u.pn * BM + wc * 32 + 8 * fq;
#pragma unroll
        for (int ai = 0; ai < 2; ++ai)
#pragma unroll
            for (int m = 0; m < 4; ++m) { const int row = row0 + ai * HALF + m * 16;
                const bool lat = row < E_MLAT; const int j = lat ? (row >> 14) : 2;
                const float* xi = lat ? xin_lat + (size_t)row * 2048 : xin_ctx + (size_t)(row - E_MLAT) * 2048;
                float* xo = lat ? xout_lat + (size_t)row * 2048 : xout_ctx + (size_t)(row - E_MLAT) * 2048;
                const float* gt = mod + j * 6144 + 4096;
#pragma unroll
                for (int bj = 0; bj < 2; ++bj)
#pragma unroll
                    for (int n = 0; n < 2; ++n) { const int col = col0 + bj * HALF + 4 * n;
                        const f32x4 xv = *(const f32x4*)(xi + col), gv = *(const f32x4*)(gt + col), bo = *(const f32x4*)(bout + col);
                        #if defined(DBG_MODE) && DBG_MODE == 1
                        *(f32x4*)(xo + col) = xv;
#else
                        *(f32x4*)(xo + col) = xv + gv * (acc[ai][bj][m][n] + bo);
#endif
                    } }
    }
};
template <class Epi, class Sched, bool ALIGN_EPI = false, bool SP2 = false>
__device__ __forceinline__ void gemm_phase(PG8_LAS unsigned char* lds, const Gemm g, const Sched& S, const Epi& E) {
    const int tid = threadIdx.x, wid = __builtin_amdgcn_readfirstlane(tid >> 6), lane = tid & 63, wr = wid >> 2, wc = wid & 3, fr = lane & 15, fq = lane >> 4;
    const int K = g.K, nt = K / BK;
    unsigned voffA[2], voffB[2];
#pragma unroll
    for (int i = 0; i < 2; ++i) { int R, C; stage_rc(tid * 16 + i * 8192, R, C); const int Rb = Epi::PERM ? ((R & ~31) + perm32(R & 31)) : R;
        voffA[i] = (unsigned)(R * K + C) * 2u; voffB[i] = (unsigned)(Rb * K + C) * 2u; }
    const size_t kstep = (size_t)(BK * 2);
    const size_t hstep = (size_t)HALF * K * 2;
    const size_t tstep = 2 * hstep;
    const unsigned ldsw = (unsigned)wid * 1024u;
    const int aoff = lds_byte(wr * 64 + fr, fq * 8), boff = lds_byte(wc * 32 + fr, fq * 8);
#define PG8_SA(b, h) (((b) * 2 + (h)) * HTB)
#define PG8_SB(b, h) ((4 + (b) * 2 + (h)) * HTB)
#define PG8_STAGE(bufoff, gbase, voff) do { _Pragma("unroll") for (int _i = 0; _i < 2; ++_i) \
        __builtin_amdgcn_global_load_lds((const unsigned*)((const char*)(gbase) + (voff)[_i]), (PG8_LAS unsigned*)(lds + (bufoff) + ldsw + _i * 8192), 16, 0, 0); } while (0)
#define PG8_LDA(dst, b, h) do { _Pragma("unroll") for (int m = 0; m < 4; ++m) _Pragma("unroll") for (int k = 0; k < 2; ++k) dst[m][k] = *(const PG8_LAS bf16x8*)(lds + PG8_SA(b, h) + aoff + m * 2048 + k * 1024); } while (0)
#define PG8_LDB(dst, b, h) do { _Pragma("unroll") for (int n = 0; n < 2; ++n) _Pragma("unroll") for (int k = 0; k < 2; ++k) dst[n][k] = *(const PG8_LAS bf16x8*)(lds + PG8_SB(b, h) + boff + n * 2048 + k * 1024); } while (0)
#define PG8_MMA(ai, bj, At, Bt) do { __builtin_amdgcn_s_setprio(1); _Pragma("unroll") for (int m = 0; m < 4; ++m) _Pragma("unroll") for (int n = 0; n < 2; ++n) _Pragma("unroll") for (int k = 0; k < 2; ++k) \
        acc[ai][bj][m][n] = __builtin_amdgcn_mfma_f32_16x16x32_bf16(Bt[n][k], At[m][k], acc[ai][bj][m][n], 0, 0, 0); __builtin_amdgcn_s_setprio(0); } while (0)
#define PG8_WAIT_V(n) asm volatile("s_waitcnt vmcnt(" #n ")" ::: "memory")
#define PG8_WAIT_L(n) asm volatile("s_waitcnt lgkmcnt(" #n ")" ::: "memory")
#define PG8_BAR __builtin_amdgcn_s_barrier()
#define PG8_SCHED __builtin_amdgcn_sched_barrier(0)
    Unit cur, nxt; int ui = 0;
    if (!S.next(0, cur)) return;
    f32x4 acc[2][2][4][2];
#pragma unroll
    for (int a = 0; a < 2; ++a)
#pragma unroll
        for (int b = 0; b < 2; ++b)
#pragma unroll
            for (int m = 0; m < 4; ++m)
#pragma unroll
                for (int n = 0; n < 2; ++n) acc[a][b][m][n] = (f32x4){0.f, 0.f, 0.f, 0.f};
    bf16x8 At[4][2], B0[2][2], B1[2][2];
    const char* cA = (const char*)g.A + (size_t)cur.pm * tstep; const char* cB = (const char*)g.Bt + (size_t)cur.pn * tstep;
    S.a_ready(cur);
    if constexpr (SP2) {
        PG8_STAGE(PG8_SB(0, 0), cB, voffB); PG8_STAGE(PG8_SB(0, 1), cB + hstep, voffB); PG8_STAGE(PG8_SA(0, 0), cA, voffA); PG8_STAGE(PG8_SA(0, 1), cA + hstep, voffA);
        if (wr == 1) PG8_BAR;
        PG8_WAIT_V(2); PG8_BAR;
        PG8_STAGE(PG8_SB(1, 0), cB + kstep, voffB); PG8_STAGE(PG8_SA(1, 0), cA + kstep, voffA); PG8_STAGE(PG8_SB(1, 1), cB + hstep + kstep, voffB);
        PG8_WAIT_V(6); PG8_BAR;
    } else {
        PG8_STAGE(PG8_SB(0, 0), cB, voffB); PG8_STAGE(PG8_SA(0, 0), cA, voffA); PG8_STAGE(PG8_SB(0, 1), cB + hstep, voffB); PG8_STAGE(PG8_SA(0, 1), cA + hstep, voffA);
        if (wr == 1) PG8_BAR;
        PG8_WAIT_V(4); PG8_BAR;
        PG8_STAGE(PG8_SB(1, 0), cB + kstep, voffB); PG8_STAGE(PG8_SA(1, 0), cA + kstep, voffA); PG8_STAGE(PG8_SB(1, 1), cB + hstep + kstep, voffB);
        PG8_WAIT_V(6); PG8_BAR;
    }
    for (;;) {
        const bool has_next = S.next(ui + 1, nxt);
        const char* nA = has_next ? (const char*)g.A + (size_t)nxt.pm * tstep : cA; const char* nB = has_next ? (const char*)g.Bt + (size_t)nxt.pn * tstep : cB;
        for (int t = 0; t < nt; t += 2) {
            const bool last = (t == nt - 2);
            const char* a1 = cA + (size_t)(t + 1) * kstep;
            const char* a2 = last ? nA : cA + (size_t)(t + 2) * kstep; const char* b2 = last ? nB : cB + (size_t)(t + 2) * kstep;
            const char* a3 = a2 + kstep; const char* b3 = b2 + kstep;
            if (last && has_next) S.a_ready(nxt);
            if constexpr (SP2) {
            PG8_LDB(B0, 0, 0); PG8_LDB(B1, 0, 1); PG8_SCHED; PG8_LDA(At, 0, 0); PG8_STAGE(PG8_SA(1, 1), a1 + hstep, voffA);
            PG8_WAIT_V(8); PG8_WAIT_L(0); PG8_BAR; PG8_MMA(0, 0, At, B0); PG8_MMA(0, 1, At, B1); PG8_BAR; PG8_SCHED;
            PG8_LDA(At, 0, 1); PG8_STAGE(PG8_SB(0, 0), b2, voffB); PG8_STAGE(PG8_SB(0, 1), b2 + hstep, voffB); PG8_STAGE(PG8_SA(0, 0), a2, voffA);
            PG8_WAIT_V(8); PG8_WAIT_L(0); PG8_BAR; PG8_MMA(1, 0, At, B0); PG8_MMA(1, 1, At, B1); PG8_BAR; PG8_SCHED;
            PG8_LDB(B0, 1, 0); PG8_LDB(B1, 1, 1); PG8_SCHED; PG8_LDA(At, 1, 0); PG8_STAGE(PG8_SA(0, 1), a2 + hstep, voffA);
            PG8_WAIT_V(8); PG8_WAIT_L(0); PG8_BAR; PG8_MMA(0, 0, At, B0); PG8_MMA(0, 1, At, B1); PG8_BAR; PG8_SCHED;
            PG8_LDA(At, 1, 1); PG8_STAGE(PG8_SB(1, 0), b3, voffB); PG8_STAGE(PG8_SB(1, 1), b3 + hstep, voffB); PG8_STAGE(PG8_SA(1, 0), a3, voffA);
            PG8_WAIT_V(8); PG8_WAIT_L(0); PG8_BAR; PG8_MMA(1, 0, At, B0); PG8_MMA(1, 1, At, B1); PG8_BAR; PG8_SCHED;
            } else {
            PG8_LDB(B0, 0, 0); PG8_SCHED; PG8_LDA(At, 0, 0); PG8_STAGE(PG8_SA(1, 1), a1 + hstep, voffA);
            PG8_WAIT_L(8); PG8_BAR; PG8_WAIT_L(0); PG8_MMA(0, 0, At, B0); PG8_BAR; PG8_SCHED;
            PG8_LDB(B1, 0, 1); PG8_STAGE(PG8_SB(0, 0), b2, voffB);
            PG8_BAR; PG8_WAIT_L(0); PG8_MMA(0, 1, At, B1); PG8_BAR;
            PG8_LDA(At, 0, 1); PG8_STAGE(PG8_SA(0, 0), a2, voffA);
            PG8_BAR; PG8_WAIT_L(0); PG8_MMA(1, 0, At, B0); PG8_BAR; PG8_SCHED;
            PG8_STAGE(PG8_SB(0, 1), b2 + hstep, voffB);
            PG8_WAIT_V(6); PG8_BAR; PG8_MMA(1, 1, At, B1); PG8_BAR;
            PG8_LDB(B0, 1, 0); PG8_SCHED; PG8_LDA(At, 1, 0); PG8_STAGE(PG8_SA(0, 1), a2 + hstep, voffA);
            PG8_WAIT_L(8); PG8_BAR; PG8_WAIT_L(0); PG8_MMA(0, 0, At, B0); PG8_BAR; PG8_SCHED;
            PG8_LDB(B1, 1, 1); PG8_STAGE(PG8_SB(1, 0), b3, voffB);
            PG8_BAR; PG8_WAIT_L(0); PG8_MMA(0, 1, At, B1); PG8_BAR;
            PG8_LDA(At, 1, 1); PG8_STAGE(PG8_SA(1, 0), a3, voffA);
            PG8_BAR; PG8_WAIT_L(0); PG8_MMA(1, 0, At, B0); PG8_BAR; PG8_SCHED;
            PG8_STAGE(PG8_SB(1, 1), b3 + hstep, voffB);
            PG8_WAIT_V(6); PG8_BAR; PG8_MMA(1, 1, At, B1); PG8_BAR;
            }
        }
        if constexpr (ALIGN_EPI) { if (wr == 0) PG8_BAR; }
        if constexpr (!Epi::AFTER_DRAIN) { E(acc, cur, wr, wc, fr, fq); S.done(cur); }
        if (!has_next) break;
#pragma unroll
        for (int a = 0; a < 2; ++a)
#pragma unroll
            for (int b = 0; b < 2; ++b)
#pragma unroll
                for (int m = 0; m < 4; ++m)
#pragma unroll
                    for (int n = 0; n < 2; ++n) acc[a][b][m][n] = (f32x4){0.f, 0.f, 0.f, 0.f};
        cur = nxt; cA = nA; cB = nB; ++ui;
        if constexpr (ALIGN_EPI) { if (wr == 1) PG8_BAR; }
    }
    PG8_WAIT_V(0);
    if constexpr (!ALIGN_EPI) { if (wr == 0) PG8_BAR; }
    PG8_BAR;
    if constexpr (Epi::AFTER_DRAIN) { E.fused(acc, cur, wr, wc, fr, fq, lds, wid, lane); S.done(cur); }
#undef PG8_SA
#undef PG8_SB
#undef PG8_STAGE
#undef PG8_LDA
#undef PG8_LDB
#undef PG8_MMA
#undef PG8_WAIT_V
#undef PG8_WAIT_L
#undef PG8_BAR
#undef PG8_SCHED
}
}
#define GAS __attribute__((address_space(1)))
#define LAS __attribute__((address_space(3)))
typedef unsigned short bf16;
typedef unsigned v4u __attribute__((ext_vector_type(4)));
typedef float f32x4 __attribute__((ext_vector_type(4)));
typedef short bf16x8 __attribute__((ext_vector_type(8)));
typedef GAS unsigned gu32;
typedef GAS unsigned long long gu64;
#define RLX_AGENT __ATOMIC_RELAXED, __HIP_MEMORY_SCOPE_AGENT
#define LDS_WAIT() asm volatile("s_waitcnt lgkmcnt(0)" ::: "memory")
#define VM_WAIT() asm volatile("s_waitcnt vmcnt(0)" ::: "memory")
__device__ __forceinline__ unsigned long long rt() { return __builtin_amdgcn_s_memrealtime(); }
__device__ __forceinline__ unsigned f2bf(float f) { unsigned u = __builtin_bit_cast(unsigned, f); return (u + 0x7fffu + ((u >> 16) & 1u)) >> 16; }
__device__ __forceinline__ unsigned pk2(float lo, float hi) { return f2bf(lo) | (f2bf(hi) << 16); }

#define XB_TMO      128
#define XB_XCNT(j)  (256  + 64 * (j))
#define XB_XSUB(j)  (1280 + 64 * (j))
#define XB_XGEN(j)  (2304 + 64 * (j))
#define XB_TOP      3328
#define XB_TOPGEN   3392
#define XCD_BAR_WORDS 3456
#define XB_SPIN_CAP (1u << 18)

__device__ __forceinline__ unsigned xb_ld(unsigned* p)              { return __hip_atomic_load(p, __ATOMIC_RELAXED, __HIP_MEMORY_SCOPE_AGENT); }
__device__ __forceinline__ unsigned xb_add(unsigned* p, unsigned v) { return __hip_atomic_fetch_add(p, v, __ATOMIC_RELAXED, __HIP_MEMORY_SCOPE_AGENT); }
__device__ __forceinline__ unsigned xb_xcc_id() { return (unsigned)__builtin_amdgcn_s_getreg((3 << 11) | 20) & 0xFu; }
#define XB_SPIN(cond, bar) do { unsigned _sp = 0; while (cond) { __builtin_amdgcn_s_sleep(1); \
    if ((++_sp & 255u) == 0u) { if (xb_ld(&(bar)[XB_TMO])) break; if (_sp > XB_SPIN_CAP) { atomicAdd(&(bar)[XB_TMO], 1u); break; } } } } while (0)

struct XcdBarrier {
    unsigned* bar; unsigned x;
    volatile LAS unsigned* st;
};

__device__ __forceinline__ XcdBarrier xcd_barrier_post(unsigned* bar, volatile LAS unsigned* st) {
    XcdBarrier b; b.bar = bar; b.x = xb_xcc_id(); b.st = st;
    if (threadIdx.x == 0) (void)xb_add(&bar[XB_XCNT(b.x)], 1u);
    return b;
}
__device__ __forceinline__ void xcd_barrier_complete(unsigned* bar, unsigned x, unsigned& nloc, unsigned& nx) {
    const unsigned G = gridDim.x * gridDim.y * gridDim.z;
    unsigned sum, cnt, mine, sp = 0u;
    for (;;) {
        sum = 0u; cnt = 0u; mine = 0u;
#pragma unroll
        for (unsigned j = 0; j < 16; ++j) { const unsigned c = xb_ld(&bar[XB_XCNT(j)]); sum += c; cnt += (c > 0u) ? 1u : 0u; mine = (j == x) ? c : mine; }
        if (sum == G) break;
        __builtin_amdgcn_s_sleep(1);
        if ((++sp & 255u) == 0u) { if (xb_ld(&bar[XB_TMO])) break; if (sp > XB_SPIN_CAP) { atomicAdd(&bar[XB_TMO], 1u); break; } }
    }
    nloc = mine > 0u ? mine : 1u; nx = cnt > 0u ? cnt : 1u;
}

__device__ __forceinline__ void xcd_barrier(const XcdBarrier& b) {
    asm volatile("s_waitcnt vmcnt(0)" ::: "memory");
    __syncthreads();
    if (threadIdx.x == 0) {
        unsigned* bar = b.bar;
        __builtin_amdgcn_s_waitcnt(0);
        unsigned nloc = b.st[0], nx = b.st[1];
        if (nloc == 0u) { xcd_barrier_complete(bar, b.x, nloc, nx); b.st[0] = nloc; b.st[1] = nx; }
        const unsigned old = xb_add(&bar[XB_XSUB(b.x)], 1u);
        const unsigned gen = old / nloc;
        if (old + 1u == (gen + 1u) * nloc) {
            __builtin_amdgcn_fence(__ATOMIC_RELEASE, "agent");
            asm volatile("s_waitcnt vmcnt(0)" ::: "memory");
            const unsigned og = xb_add(&bar[XB_TOP], 1u);
            const unsigned tg = og / nx;
            if (og + 1u == (tg + 1u) * nx) xb_add(&bar[XB_TOPGEN], 1u);
            else XB_SPIN(xb_ld(&bar[XB_TOPGEN]) == tg, bar);
            __builtin_amdgcn_fence(__ATOMIC_ACQUIRE, "agent");
            xb_add(&bar[XB_XGEN(b.x)], 1u);
            asm volatile("s_waitcnt vmcnt(0)" ::: "memory");
        } else {
            XB_SPIN(xb_ld(&bar[XB_XGEN(b.x)]) == gen, bar);
            __builtin_amdgcn_fence(__ATOMIC_ACQUIRE, "agent");
            asm volatile("s_waitcnt vmcnt(0)" ::: "memory");
        }
    }
    __syncthreads();
}


constexpr int NWAVES = 8;
constexpr int DM = 2048, NBATCH = 2, SEQ = 16384, CTXL = 256, DEPTH = 4;
constexpr int MLAT = NBATCH * SEQ, MCTX = NBATCH * CTXL, MALL = MLAT + MCTX;
constexpr int NIN = 20512, NP = 20480, NPAD = 20736;
constexpr int OFF_AQ = 0, OFF_AK = 1024, OFF_AV = 2048, OFF_AO = 4096, OFF_AZ = 6144, OFF_BQ = 8192, OFF_BK = 10240, OFF_BV = 12288, OFF_BZ = 14336, OFF_GA = 16384, OFF_GB = 18432;
constexpr float EPS = 1e-6f;
static_assert(MALL % 256 == 0 && NPAD % 256 == 0 && pg8::E_MLAT == MLAT && pg8::E_NP == NP, "shapes");

constexpr size_t MiB = 1u << 20;
constexpr size_t WS_CTL = 0, CTL_ZERO_BYTES = 1 * MiB;
constexpr size_t WS_MOD = 1 * MiB;
constexpr size_t WS_ROPE = 1 * MiB + 512 * 1024;
constexpr size_t WS_XC = 2 * MiB;
constexpr size_t WS_G = 6 * MiB;
constexpr size_t WS_SSQ = 11 * MiB;
constexpr size_t WS_STC = 28 * MiB;
constexpr size_t WS_STN = 64 * MiB;
constexpr size_t WS_STS = 64 * MiB + 256 * 1024;
constexpr size_t WS_WIN = 65 * MiB;
constexpr size_t WS_WAB = 389 * MiB;
constexpr size_t WS_WO = 453 * MiB;
constexpr size_t WS_H = 485 * MiB;
constexpr size_t WS_YB = 615 * MiB;
constexpr size_t WS_HF = 745 * MiB;
constexpr size_t WS_HB = 875 * MiB;
constexpr size_t WS_P = 1005 * MiB;
constexpr size_t WS_END = 2305 * MiB;
static_assert(WS_G + (size_t)MALL * 32 * 4 <= WS_SSQ && WS_SSQ + (size_t)2 * MALL * 64 * 4 <= WS_STC && WS_STC + (size_t)288 * 131072 <= WS_STN, "ws map 1");
static_assert(WS_WIN + (size_t)4 * NPAD * 2048 * 2 <= WS_WAB && WS_H + (size_t)MALL * 2048 * 2 <= WS_YB && WS_P + (size_t)MALL * NP * 2 <= WS_END, "ws map 2");
constexpr int CW_BAR = 4096;

constexpr int RING_BYTES = 131072;
constexpr int MISC_OFF = RING_BYTES + 320;
constexpr int LDS_BYTES = 147456;

typedef short s16x4 __attribute__((ext_vector_type(4)));
typedef float f32x16 __attribute__((ext_vector_type(16)));
typedef unsigned v2u __attribute__((ext_vector_type(2)));
typedef float f32x2 __attribute__((ext_vector_type(2)));
typedef __bf16 bf16x2_t __attribute__((ext_vector_type(2)));
__device__ __forceinline__ unsigned pkh(float lo, float hi) { f32x2 v = {lo, hi}; bf16x2_t b = __builtin_convertvector(v, bf16x2_t); return __builtin_bit_cast(unsigned, b); }
#define MFMA32(a, b, c) __builtin_amdgcn_mfma_f32_32x32x16_bf16((a), (b), (c), 0, 0, 0)
#define MFMA16(a, b, c) __builtin_amdgcn_mfma_f32_16x16x32_bf16((a), (b), (c), 0, 0, 0)

__device__ __forceinline__ float bf2f(unsigned short x) { return __builtin_bit_cast(float, (unsigned)x << 16); }
__device__ __forceinline__ float bflo(unsigned w) { return __builtin_bit_cast(float, w << 16); }
__device__ __forceinline__ float bfhi(unsigned w) { return __builtin_bit_cast(float, w & 0xffff0000u); }
__device__ __forceinline__ float sigm(float x) { return 1.0f / (1.0f + __expf(-x)); }
__device__ __forceinline__ float silu(float x) { return x / (1.0f + __expf(-x)); }
__device__ __forceinline__ int crow(int reg, int h) { return (reg & 3) + 8 * (reg >> 2) + 4 * h; }
__device__ __forceinline__ float wave_sum(float v) {
#pragma unroll
    for (int o = 1; o < 64; o <<= 1) v += __shfl_xor(v, o);
    return v;
}
__device__ __forceinline__ s16x4 tr_read(const LAS unsigned char* p) { return __builtin_bit_cast(s16x4, __builtin_amdgcn_ds_read_tr16_b64_v4i16((LAS s16x4*)p)); }
__device__ __forceinline__ bf16x8 cat8(s16x4 lo, s16x4 hi) { return __builtin_shufflevector(lo, hi, 0, 1, 2, 3, 4, 5, 6, 7); }
__device__ __forceinline__ int clampi(int v, int lo, int hi) { return v < lo ? lo : (v > hi ? hi : v); }

struct Args { const float* in[17]; float* out; unsigned char* ws; int ph_lo, ph_hi; };

__device__ __forceinline__ void transpose_item(const float* W, int K, int N, bf16* WT, int dst_row0, int rstride, int k0, int n0, LAS float* scr, int lane) {
#pragma unroll 8
    for (int i = 0; i < 32; ++i) { const int kk = 2 * i + (lane >> 5); scr[kk * 33 + (lane & 31)] = W[(size_t)(k0 + kk) * N + n0 + (lane & 31)]; }
    LDS_WAIT(); asm volatile("" ::: "memory");
    const int c = lane & 7;
#pragma unroll
    for (int j = 0; j < 4; ++j) { const int n = (lane >> 3) + 8 * j; const LAS float* s = scr + (8 * c) * 33 + n;
        v4u o; o.x = pkh(s[0 * 33], s[1 * 33]); o.y = pkh(s[2 * 33], s[3 * 33]); o.z = pkh(s[4 * 33], s[5 * 33]); o.w = pkh(s[6 * 33], s[7 * 33]);
        *(GAS v4u*)(WT + (size_t)(dst_row0 + n * rstride) * K + k0 + 8 * c) = o; }
    LDS_WAIT(); asm volatile("" ::: "memory");
}

__constant__ float ROPE_INV[32] = {
1.000000000e+00f, 7.498942614e-01f, 5.623413324e-01f, 4.216965139e-01f, 3.162277639e-01f, 2.371373773e-01f, 1.778279394e-01f, 1.333521307e-01f, 1.000000015e-01f, 7.498941571e-02f, 5.623413250e-02f, 4.216965288e-02f, 3.162277490e-02f, 2.371373773e-02f, 1.778279431e-02f, 1.333521493e-02f, 9.999999776e-03f, 7.498941850e-03f, 5.623413250e-03f, 4.216964822e-03f, 3.162277630e-03f, 2.371373586e-03f, 1.778279431e-03f, 1.333521446e-03f, 1.000000047e-03f, 7.498942432e-04f, 5.623413017e-04f, 4.216965172e-04f, 3.162277571e-04f, 2.371373703e-04f, 1.778279402e-04f, 1.333521504e-04f
};

__device__ __forceinline__ void prologue(const Args& a, LAS unsigned char* lds, int tid, int lane, int wave) {
    unsigned char* ws = a.ws;
    const int G = gridDim.x, bx = blockIdx.x;
    {
        const float* c = a.in[1]; const float* cctx = a.in[3]; const float* wmod = a.in[4]; const float* bmod = a.in[5];
        float* MOD = (float*)(ws + WS_MOD);
        LAS float* red = (LAS float*)lds;
        for (int uu = bx; uu < 96; uu += G) {
            const int l = uu / 24, nc = uu % 24;
            f32x4 a0 = {0.f, 0.f, 0.f, 0.f}, a1 = a0, a2 = a0;
            const float* wp = wmod + ((size_t)l * 2048 + wave * 256) * 6144 + nc * 256 + 4 * lane;
#pragma unroll 4
            for (int k = 0; k < 256; ++k) { const int kk = wave * 256 + k;
                const f32x4 wv = *(const f32x4*)(wp + (size_t)k * 6144);
                const float s0 = silu(c[kk]), s1 = silu(c[2048 + kk]), s2 = silu(cctx[kk]);
                a0 += wv * s0; a1 += wv * s1; a2 += wv * s2; }
            *(LAS f32x4*)(red + (wave * 3 + 0) * 256 + 4 * lane) = a0; *(LAS f32x4*)(red + (wave * 3 + 1) * 256 + 4 * lane) = a1; *(LAS f32x4*)(red + (wave * 3 + 2) * 256 + 4 * lane) = a2;
            __syncthreads();
            for (int o = tid; o < 768; o += 512) { const int j = o >> 8, ci = o & 255; float s = 0.f;
#pragma unroll
                for (int w = 0; w < 8; ++w) s += red[(w * 3 + j) * 256 + ci];
                MOD[(size_t)(l * 3 + j) * 6144 + nc * 256 + ci] = s + bmod[(size_t)l * 6144 + nc * 256 + ci]; }
            __syncthreads();
        }
    }
    {
        float* ROPE = (float*)(ws + WS_ROPE);
        const int gid = bx * 512 + tid;
        if (gid < 8192) { const int pos = gid >> 5, i = gid & 31;
            const float ang = (float)pos * ROPE_INV[i]; const double x = (double)ang;
            const double kq = __builtin_rint(x * 0.63661977236758134308); double r = __builtin_fma(-kq, 1.57079632679489655800, x); r = __builtin_fma(-kq, 6.12323399573676603587e-17, r);
            const int q = ((int)kq) & 3; const double r2 = r * r;
            const double sn = r * (1.0 + r2 * (-1.0 / 6 + r2 * (1.0 / 120 + r2 * (-1.0 / 5040 + r2 * (1.0 / 362880 + r2 * (-1.0 / 39916800 + r2 * (1.0 / 6227020800.0)))))));
            const double cs = 1.0 + r2 * (-0.5 + r2 * (1.0 / 24 + r2 * (-1.0 / 720 + r2 * (1.0 / 40320 + r2 * (-1.0 / 3628800 + r2 * (1.0 / 479001600.0 + r2 * (-1.0 / 87178291200.0)))))));
            const double co = q == 0 ? cs : (q == 1 ? -sn : (q == 2 ? -cs : sn)); const double si = q == 0 ? sn : (q == 1 ? cs : (q == 2 ? -sn : -cs));
            ROPE[gid * 2] = (float)co; ROPE[gid * 2 + 1] = (float)si; }
    }
    {
        LAS float* scr = (LAS float*)(lds + wave * 8448);
        const int gw = bx * NWAVES + wave, NGW = G * NWAVES;
        constexpr int I_IN = 32 * 641, I_SQ = 32 * 64;
        constexpr int NITEMS = 4 * I_IN + 12 * I_SQ;
        for (int it = gw; it < NITEMS; it += NGW) {
            if (it < 4 * I_IN) { const int l = it / I_IN, r = it % I_IN, kb = r / 641, nb = r % 641;
                int dst = nb < 256 ? 32 * nb : (nb == 256 ? 20480 : 32 * nb - 32), rstr = 1;
                if (nb < 64) { const int n0 = 32 * nb, w0 = n0 & 127; dst = (n0 & ~127) + 64 * (w0 >> 6) + ((w0 >> 5) & 1); rstr = 2; }
                transpose_item(a.in[7] + (size_t)l * 2048 * NIN, 2048, NIN, (bf16*)(ws + WS_WIN) + (size_t)l * NPAD * 2048, dst, rstr, 64 * kb, 32 * nb, scr, lane);
            } else { const int r0 = it - 4 * I_IN, mat = r0 / (4 * I_SQ), r1 = r0 % (4 * I_SQ), l = r1 / I_SQ, r = r1 % I_SQ, kb = r / 64, nb = r % 64;
                const float* src = (mat == 0 ? a.in[10] : (mat == 1 ? a.in[11] : a.in[15])) + (size_t)l * 2048 * 2048;
                bf16* dstp = mat == 2 ? (bf16*)(ws + WS_WO) + (size_t)l * 2048 * 2048 : (bf16*)(ws + WS_WAB) + ((size_t)l * 2 + mat) * 2048 * 2048;
                transpose_item(src, 2048, 2048, dstp, 32 * nb, 1, 64 * kb, 32 * nb, scr, lane);
            }
        }
        const int gt = bx * 512 + tid, NGT = G * 512;
        for (int p = gt; p < 4 * 57344; p += NGT) { const int l = p / 57344, q = p % 57344;
            *(GAS v4u*)((unsigned char*)(ws + WS_WIN) + ((size_t)l * NPAD + 20512) * 4096 + (size_t)q * 16) = (v4u){0u, 0u, 0u, 0u}; }
    }
}

__device__ __forceinline__ void norm_phase(const Args& a, LAS unsigned char* lds, int l, int tid, int lane, int wave) {
    unsigned char* ws = a.ws;
    const float* MOD = (const float*)(ws + WS_MOD) + (size_t)l * 3 * 6144;
    const float* g = a.in[6] + (size_t)l * 2048;
    LAS float* Al = (LAS float*)lds; LAS float* Sl = Al + 3 * 2048;
    for (int idx = tid; idx < 3 * 2048; idx += 512) { const int j = idx >> 11, col = idx & 2047;
        Al[idx] = g[col] * (1.0f + MOD[j * 6144 + 2048 + col]); Sl[idx] = MOD[j * 6144 + col]; }
    __syncthreads();
    const float* xlat = l == 0 ? a.in[0] : a.out; const float* xctx = l == 0 ? a.in[2] : (const float*)(ws + WS_XC);
    bf16* H = (bf16*)(ws + WS_H);
    const int gw = blockIdx.x * NWAVES + wave, NGW = gridDim.x * NWAVES;
    for (int row = gw; row < MALL; row += NGW) {
        const bool lat = row < MLAT; const int j = lat ? (row >> 14) : 2;
        const float* xr = lat ? xlat + (size_t)row * 2048 : xctx + (size_t)(row - MLAT) * 2048;
        f32x4 v[8]; float ss = 0.f;
#pragma unroll
        for (int jj = 0; jj < 8; ++jj) { v[jj] = *(const GAS f32x4*)(xr + 4 * lane + 256 * jj); ss += (v[jj].x * v[jj].x + v[jj].y * v[jj].y) + (v[jj].z * v[jj].z + v[jj].w * v[jj].w); }
        const float rstd = 1.0f / sqrtf(wave_sum(ss) * (1.0f / 2048.0f) + EPS);
        GAS unsigned long long* o8 = (GAS unsigned long long*)(H + (size_t)row * 2048) + lane;
#pragma unroll
        for (int jj = 0; jj < 8; ++jj) { const f32x4 av = *(LAS f32x4*)(Al + j * 2048 + 4 * lane + 256 * jj), sv = *(LAS f32x4*)(Sl + j * 2048 + 4 * lane + 256 * jj);
            const f32x4 o = v[jj] * rstd * av + sv;
            o8[64 * jj] = (unsigned long long)pkh(o.x, o.y) | ((unsigned long long)pkh(o.z, o.w) << 32); }
    }
    __syncthreads();
}

constexpr int ML_KT = 0, ML_QT = 17408, ML_KW = 34816, ML_VT = 55296, ML_PT = 92160, ML_SC = 101376;
constexpr int KT_STR = 272, KW_STR = 320, VT_STR = 576, PT_STR = 144;
constexpr int SC_U = 0, SC_MJ = 256, SC_WI = 512, SC_TH = 768, SC_NQ = 1024, SC_N = 1280;
__device__ __forceinline__ v4u scale_bf8(v4u x, float s) {
    v4u o; o.x = pkh(bflo(x.x) * s, bfhi(x.x) * s); o.y = pkh(bflo(x.y) * s, bfhi(x.y) * s); o.z = pkh(bflo(x.z) * s, bfhi(x.z) * s); o.w = pkh(bflo(x.w) * s, bfhi(x.w) * s); return o;
}
__device__ __forceinline__ bf16x8 pack_acc8(const f32x16& x, int s) {
    v4u p; p.x = pkh(x[8 * s + 0], x[8 * s + 1]); p.y = pkh(x[8 * s + 2], x[8 * s + 3]); p.z = pkh(x[8 * s + 4], x[8 * s + 5]); p.w = pkh(x[8 * s + 6], x[8 * s + 7]);
    return __builtin_bit_cast(bf16x8, p);
}

__device__ __forceinline__ int ml_chunk_base(int seg, int dir, int b, int ci) {
    if (seg == 0) { const int c = dir ? 3 - ci : ci; return MLAT + b * 256 + 64 * c; }
    const int cc = 32 * (seg - 1) + ci; const int c = dir ? 255 - cc : cc; return b * 16384 + 64 * c;
}
template <bool with_out, bool init_comb>
__device__ __forceinline__ void mlstm_unit(const Args& a, LAS unsigned char* lds, int b, int h, int dir, int seg, int tid, int lane, int wave) {
    unsigned char* ws = a.ws;
    const bf16* P = (const bf16*)(ws + WS_P); const float* Gt = (const float*)(ws + WS_G);
    bf16* HOUT = (bf16*)(ws + (dir ? WS_HB : WS_HF));
    float* STC = (float*)(ws + WS_STC); float* STN = (float*)(ws + WS_STN); float* STS = (float*)(ws + WS_STS);
    const int r = lane & 31, hh = lane >> 5, q4 = (lane & 15) >> 2, p4 = lane & 3, blk = (lane >> 4) & 1;
    const int sidx0 = ((b * 8 + h) * 2 + dir) * 9, sidx = sidx0 + seg;
    LAS float* nl = (LAS float*)(lds + ML_SC + SC_N);
    f32x16 C[4];
#pragma unroll
    for (int i = 0; i < 4; ++i)
#pragma unroll
        for (int e = 0; e < 16; ++e) C[i][e] = 0.f;
    float m = -1e30f, Ftot = 0.f; int nb = 0;
    __syncthreads();
    if (!init_comb) { if (tid < 128) nl[tid] = 0.f; }
    else {
        float run = 0.f, m_in = -3e38f;
        for (int k = seg - 1; k >= 0; --k) { const float mk = STS[(sidx0 + k) * 4], fk = STS[(sidx0 + k) * 4 + 1]; m_in = fmaxf(m_in, mk + run); run += fk; }
        run = 0.f; float nacc = 0.f;
        for (int k = seg - 1; k >= 0; --k) { const float mk = STS[(sidx0 + k) * 4], fk = STS[(sidx0 + k) * 4 + 1]; const float cf = __expf(mk + run - m_in); run += fk;
            const f32x4* src = (const f32x4*)(STC + (size_t)(sidx0 + k) * 32768) + tid;
#pragma unroll
            for (int i = 0; i < 4; ++i)
#pragma unroll
                for (int g4 = 0; g4 < 4; ++g4) { const f32x4 v = src[(4 * i + g4) * 512];
                    C[i][4 * g4 + 0] += cf * v.x; C[i][4 * g4 + 1] += cf * v.y; C[i][4 * g4 + 2] += cf * v.z; C[i][4 * g4 + 3] += cf * v.w; }
            if (tid < 128) nacc += cf * STN[(sidx0 + k) * 128 + tid];
        }
        if (tid < 128) nl[tid] = nacc;
        m = m_in;
    }
    const int nch = seg == 0 ? 4 : 32;
    v4u kreg[2], qreg[2], vreg[4]; float gi = 0.f, gf = 0.f;
    const int lrow_kq = dir ? 63 - (tid >> 4) : (tid >> 4), lrow_v = dir ? 63 - (tid >> 5) : (tid >> 5), lrow_g = dir ? 63 - lane : lane;
    const int off_kq = lrow_kq * NP + 8 * (tid & 15), off_v = lrow_v * NP + 8 * (tid & 31), off_g = lrow_g * 32 + 16 * dir + h;
    const int step_kq = (dir ? -32 : 32) * NP, step_v = (dir ? -16 : 16) * NP;
#define ML_PREFETCH_Q(ci) do { const int base_ = ml_chunk_base(seg, dir, b, ci); const bf16* pb_ = P + (size_t)base_ * NP; \
        _Pragma("unroll") for (int i = 0; i < 2; ++i) qreg[i] = *(const GAS v4u*)(pb_ + (OFF_AQ + h * 128 + i * step_kq) + off_kq); } while (0)
#define ML_PREFETCH(ci) do { const int base_ = ml_chunk_base(seg, dir, b, ci); const bf16* pb_ = P + (size_t)base_ * NP; \
        _Pragma("unroll") for (int i = 0; i < 2; ++i) { kreg[i] = *(const GAS v4u*)(pb_ + (OFF_AK + h * 128 + i * step_kq) + off_kq); } \
        _Pragma("unroll") for (int i = 0; i < 4; ++i) vreg[i] = *(const GAS v4u*)(pb_ + (OFF_AV + h * 256 + i * step_v) + off_v); \
        { const float* gb_ = Gt + (size_t)base_ * 32; gi = gb_[off_g]; gf = gb_[off_g + 8]; } } while (0)
    ML_PREFETCH(0);
    if (with_out) ML_PREFETCH_Q(0);
    for (int ci = 0; ci < nch; ++ci) {
        const int base = ml_chunk_base(seg, dir, b, ci);
        __syncthreads();
        const float logf = fminf(gf, 0.f) - log1pf(__expf(-fabsf(gf)));
        float bs = logf;
#pragma unroll
        for (int o = 1; o < 64; o <<= 1) { const float t = __shfl_up(bs, o); if (lane >= o) bs += t; }
        const float g = __shfl(bs, 63);
        const float u = gi - bs;
        float cm = u;
#pragma unroll
        for (int o = 1; o < 64; o <<= 1) { const float t = __shfl_up(cm, o); if (lane >= o) cm = fmaxf(cm, t); }
        const float Mj = fmaxf(m, cm);
        const float m_new = fmaxf(g + m, g + __shfl(cm, 63));
        const float w_prev = __expf(g + m - m_new);
        const float w_tok = __expf(g + u - m_new);
        if (wave == 0) { LAS float* sc = (LAS float*)(lds + ML_SC); sc[SC_U / 4 + lane] = u; sc[SC_MJ / 4 + lane] = Mj; sc[SC_WI / 4 + lane] = __expf(m - Mj); sc[SC_TH / 4 + lane] = __expf(-(bs + Mj)); }
#pragma unroll
        for (int i = 0; i < 2; ++i) { const int idx = tid + 512 * i, srow = idx >> 4, ch = idx & 15; const float wt = __shfl(w_tok, srow);
            *(LAS v4u*)(lds + ML_KW + srow * KW_STR + ch * 16) = scale_bf8(kreg[i], wt);
            if (with_out) { *(LAS v4u*)(lds + ML_KT + srow * KT_STR + ch * 16) = kreg[i]; *(LAS v4u*)(lds + ML_QT + srow * KT_STR + ch * 16) = qreg[i]; } }
#pragma unroll
        for (int i = 0; i < 4; ++i) { const int idx = tid + 512 * i, srow = idx >> 5, ch = idx & 31; *(LAS v4u*)(lds + ML_VT + srow * VT_STR + ch * 16) = vreg[i]; }
        __syncthreads();
        if (with_out) {
            const int jt16 = wave >> 1, l15 = lane & 15, l4 = lane >> 4;
            const int j = 16 * jt16 + l15; const float Mjj = *(LAS float*)(lds + ML_SC + SC_MJ + 4 * j);
#pragma unroll
            for (int tt = 0; tt < 2; ++tt) { const int st16 = 2 * (wave & 1) + tt; f32x4 sacc = {0.f, 0.f, 0.f, 0.f};
#pragma unroll
                for (int ks = 0; ks < 4; ++ks) { const bf16x8 ka = *(LAS bf16x8*)(lds + ML_KT + (16 * st16 + l15) * KT_STR + (32 * ks + 8 * l4) * 2);
                    const bf16x8 qb = *(LAS bf16x8*)(lds + ML_QT + (16 * jt16 + l15) * KT_STR + (32 * ks + 8 * l4) * 2); sacc = MFMA16(ka, qb, sacc); }
                const int s0 = 16 * st16 + 4 * l4; const f32x4 uv = *(LAS f32x4*)(lds + ML_SC + SC_U + 4 * s0);
                float pv[4];
#pragma unroll
                for (int e = 0; e < 4; ++e) pv[e] = (s0 + e <= j) ? sacc[e] * __expf(uv[e] - Mjj) : 0.f;
                v2u w; w.x = pkh(pv[0], pv[1]); w.y = pkh(pv[2], pv[3]);
                *(LAS v2u*)(lds + ML_PT + j * PT_STR + s0 * 2) = w; }
            { const int jq = tid >> 3, part = tid & 7; const v4u q0 = *(LAS v4u*)(lds + ML_QT + jq * KT_STR + part * 32), q1 = *(LAS v4u*)(lds + ML_QT + jq * KT_STR + part * 32 + 16);
                const LAS f32x4* np = (const LAS f32x4*)(nl + nb * 128 + part * 16); const f32x4 n0 = np[0], n1 = np[1], n2 = np[2], n3 = np[3];
                float s = bflo(q0.x) * n0.x + bfhi(q0.x) * n0.y + bflo(q0.y) * n0.z + bfhi(q0.y) * n0.w + bflo(q0.z) * n1.x + bfhi(q0.z) * n1.y + bflo(q0.w) * n1.z + bfhi(q0.w) * n1.w
                        + bflo(q1.x) * n2.x + bfhi(q1.x) * n2.y + bflo(q1.y) * n2.z + bfhi(q1.y) * n2.w + bflo(q1.z) * n3.x + bfhi(q1.z) * n3.y + bflo(q1.w) * n3.z + bfhi(q1.w) * n3.w;
                s += __shfl_xor(s, 1); s += __shfl_xor(s, 2); s += __shfl_xor(s, 4);
                if (part == 0) *(LAS float*)(lds + ML_SC + SC_NQ + 4 * jq) = s; }
        }
        if (tid < 128) { float s = 0.f;
#pragma unroll 8
            for (int sr = 0; sr < 64; ++sr) s += bf2f(*(LAS unsigned short*)(lds + ML_KW + sr * KW_STR + tid * 2));
            nl[(nb ^ 1) * 128 + tid] = w_prev * nl[nb * 128 + tid] + s; }
        __syncthreads();
        if (ci + 1 < nch) ML_PREFETCH(ci + 1);
        bf16x8 vf[4];
#pragma unroll
        for (int ks = 0; ks < 4; ++ks) { const LAS unsigned char* vp = lds + ML_VT + (16 * ks + 8 * hh + q4) * VT_STR + (32 * wave + 16 * blk + 4 * p4) * 2;
            vf[ks] = cat8(tr_read(vp), tr_read(vp + 4 * VT_STR)); }
        if (with_out) {
#pragma unroll 1
            for (int jt = 0; jt < 2; ++jt) {
                f32x16 acc; float rs = 0.f;
#pragma unroll
                for (int e = 0; e < 16; ++e) acc[e] = 0.f;
                const int j = 32 * jt + r;
                const float wint = *(LAS float*)(lds + ML_SC + SC_WI + 4 * j), nq = *(LAS float*)(lds + ML_SC + SC_NQ + 4 * j), thr = *(LAS float*)(lds + ML_SC + SC_TH + 4 * j);
#pragma unroll
                for (int i = 0; i < 4; ++i)
#pragma unroll
                    for (int s2 = 0; s2 < 2; ++s2) { const bf16x8 ca = pack_acc8(C[i], s2);
                        const LAS unsigned char* qp = lds + ML_QT + (32 * jt + r) * KT_STR + (32 * i + 16 * s2 + 4 * hh) * 2;
                        const bf16x8 qb = cat8(*(LAS s16x4*)qp, *(LAS s16x4*)(qp + 16)); acc = MFMA32(ca, qb, acc); }
#pragma unroll
                for (int e = 0; e < 16; ++e) acc[e] *= wint;
#pragma unroll
                for (int ks = 0; ks < 4; ++ks) { const v4u pw = *(LAS v4u*)(lds + ML_PT + (32 * jt + r) * PT_STR + (16 * ks + 8 * hh) * 2);
                    rs += (bflo(pw.x) + bfhi(pw.x)) + (bflo(pw.y) + bfhi(pw.y)) + (bflo(pw.z) + bfhi(pw.z)) + (bflo(pw.w) + bfhi(pw.w));
                    acc = MFMA32(vf[ks], __builtin_bit_cast(bf16x8, pw), acc); }
                rs += __shfl_xor(rs, 32);
                const float den = rs + wint * nq; const float inv = 1.0f / fmaxf(fabsf(den), thr);
                bf16* op = HOUT + (size_t)base * 2048 + (h * 256 + 32 * wave) + ((dir ? 63 - j : j) * 2048 + 4 * hh);
#pragma unroll
                for (int g4 = 0; g4 < 4; ++g4) { v2u w; w.x = pkh(acc[4 * g4 + 0] * inv, acc[4 * g4 + 1] * inv); w.y = pkh(acc[4 * g4 + 2] * inv, acc[4 * g4 + 3] * inv); *(GAS v2u*)(op + 8 * g4) = w; }
            }
            __builtin_amdgcn_sched_barrier(0);
            if (ci + 1 < nch) ML_PREFETCH_Q(ci + 1);
        }
#pragma unroll
        for (int i = 0; i < 4; ++i) {
#pragma unroll
            for (int e = 0; e < 16; ++e) C[i][e] *= w_prev;
#pragma unroll
            for (int ks = 0; ks < 4; ++ks) { const LAS unsigned char* kp = lds + ML_KW + (16 * ks + 8 * hh + q4) * KW_STR + (32 * i + 16 * blk + 4 * p4) * 2;
                const bf16x8 ka = cat8(tr_read(kp), tr_read(kp + 4 * KW_STR)); C[i] = MFMA32(ka, vf[ks], C[i]); }
            __builtin_amdgcn_sched_barrier(0);
        }
        m = m_new; Ftot += g; nb ^= 1;
    }
#undef ML_PREFETCH
#undef ML_PREFETCH_Q
    if (!init_comb) {
        f32x4* dst = (f32x4*)(STC + (size_t)sidx * 32768) + tid;
#pragma unroll
        for (int i = 0; i < 4; ++i)
#pragma unroll
            for (int g4 = 0; g4 < 4; ++g4) dst[(4 * i + g4) * 512] = (f32x4){C[i][4 * g4 + 0], C[i][4 * g4 + 1], C[i][4 * g4 + 2], C[i][4 * g4 + 3]};
        __syncthreads();
        if (tid < 128) STN[sidx * 128 + tid] = nl[nb * 128 + tid];
        if (tid == 0) { STS[sidx * 4] = m; STS[sidx * 4 + 1] = Ftot; }
    }
}

template <int SUB>
__device__ __forceinline__ void mlstm_phase(const Args& a, LAS unsigned char* lds, int pass, bool need_ctx, int tid, int lane, int wave) {
    if (pass == 1) {
        if (SUB != 2) for (int uu = blockIdx.x; uu < 32; uu += gridDim.x) { const int b = uu >> 4, h = (uu >> 1) & 7, dir = uu & 1; mlstm_unit<true, false>(a, lds, b, h, dir, 0, tid, lane, wave); }
        int v0 = (int)blockIdx.x - 32; if (v0 < 0) v0 += gridDim.x;
        if (SUB != 1) for (int v = v0; v < 224; v += gridDim.x) { const int bhd = v / 7, seg = 1 + v % 7; const int b = bhd >> 4, h = (bhd >> 1) & 7, dir = bhd & 1; mlstm_unit<false, false>(a, lds, b, h, dir, seg, tid, lane, wave); }
    } else {
        for (int uu = blockIdx.x; uu < 256; uu += gridDim.x) { const int bhd = uu >> 3, seg = 1 + (uu & 7); const int b = bhd >> 4, h = (bhd >> 1) & 7, dir = bhd & 1; mlstm_unit<true, true>(a, lds, b, h, dir, seg, tid, lane, wave); }
    }
    __syncthreads();
}

__device__ __forceinline__ void post_phase(const Args& a, LAS unsigned char* lds, int l, bool need_ctx, int tid, int lane, int wave) {
    unsigned char* ws = a.ws;
    const bf16* P = (const bf16*)(ws + WS_P); const bf16* HF = (const bf16*)(ws + WS_HF); const bf16* HB = (const bf16*)(ws + WS_HB); bf16* YA = (bf16*)(ws + WS_H);
    LAS float* gl = (LAS float*)lds;
    for (int idx = tid; idx < 2048; idx += 512) gl[idx] = a.in[9][(size_t)l * 2048 + idx];
    __syncthreads();
    const int nrows = need_ctx ? MALL : MLAT;
    const int gw = blockIdx.x * NWAVES + wave, NGW = gridDim.x * NWAVES;
    for (int row = gw; row < nrows; row += NGW) {
        float hs[32]; float ss = 0.f;
#pragma unroll
        for (int c = 0; c < 4; ++c) { const v4u x = *(const GAS v4u*)(HF + (size_t)row * 2048 + 32 * lane + 8 * c), y = *(const GAS v4u*)(HB + (size_t)row * 2048 + 32 * lane + 8 * c);
            hs[8 * c + 0] = bflo(x.x) + bflo(y.x); hs[8 * c + 1] = bfhi(x.x) + bfhi(y.x); hs[8 * c + 2] = bflo(x.y) + bflo(y.y); hs[8 * c + 3] = bfhi(x.y) + bfhi(y.y);
            hs[8 * c + 4] = bflo(x.z) + bflo(y.z); hs[8 * c + 5] = bfhi(x.z) + bfhi(y.z); hs[8 * c + 6] = bflo(x.w) + bflo(y.w); hs[8 * c + 7] = bfhi(x.w) + bfhi(y.w); }
#pragma unroll
        for (int e = 0; e < 32; ++e) ss += hs[e] * hs[e];
        ss += __shfl_xor(ss, 1); ss += __shfl_xor(ss, 2); ss += __shfl_xor(ss, 4);
        const float rstd = 1.0f / sqrtf(ss * (1.0f / 256.0f) + EPS);
#pragma unroll
        for (int c = 0; c < 4; ++c) { const v4u ao = *(const GAS v4u*)(P + (size_t)row * NP + OFF_AO + 32 * lane + 8 * c), az = *(const GAS v4u*)(P + (size_t)row * NP + OFF_AZ + 32 * lane + 8 * c);
            const f32x4 g0 = *(LAS f32x4*)(gl + 32 * lane + 8 * c), g1 = *(LAS f32x4*)(gl + 32 * lane + 8 * c + 4);
            float o[8];
            o[0] = hs[8 * c + 0] * rstd * g0.x * sigm(bflo(ao.x)) * silu(bflo(az.x)); o[1] = hs[8 * c + 1] * rstd * g0.y * sigm(bfhi(ao.x)) * silu(bfhi(az.x));
            o[2] = hs[8 * c + 2] * rstd * g0.z * sigm(bflo(ao.y)) * silu(bflo(az.y)); o[3] = hs[8 * c + 3] * rstd * g0.w * sigm(bfhi(ao.y)) * silu(bfhi(az.y));
            o[4] = hs[8 * c + 4] * rstd * g1.x * sigm(bflo(ao.z)) * silu(bflo(az.z)); o[5] = hs[8 * c + 5] * rstd * g1.y * sigm(bfhi(ao.z)) * silu(bfhi(az.z));
            o[6] = hs[8 * c + 6] * rstd * g1.z * sigm(bflo(ao.w)) * silu(bflo(az.w)); o[7] = hs[8 * c + 7] * rstd * g1.w * sigm(bfhi(ao.w)) * silu(bfhi(az.w));
            v4u w; w.x = pkh(o[0], o[1]); w.y = pkh(o[2], o[3]); w.z = pkh(o[4], o[5]); w.w = pkh(o[6], o[7]);
            *(GAS v4u*)(YA + (size_t)row * 2048 + 32 * lane + 8 * c) = w; }
    }
    __syncthreads();
}

constexpr int NA_KT0 = 0, NA_VT0 = 34816, NA_PT = 75776, NA_RK0 = 112640, NA_RPB = 113152, NA_FAC = 115200;
constexpr int NK_STR = 272, NV_STR = 320, NP_STR = 144;
constexpr float NEG_BIG = -1e30f;

__device__ __forceinline__ void na_unit(const Args& a, LAS unsigned char* lds, int l, int b, int head, int r0, bool is_ctx, int tid, int lane, int wave) {
    unsigned char* ws = a.ws;
    const bf16* P = (const bf16*)(ws + WS_P); const float* SSQ = (const float*)(ws + WS_SSQ); bf16* YB = (bf16*)(ws + WS_YB);
    const int r = lane & 31, hh = lane >> 5, q4 = (lane & 15) >> 2, p4 = lane & 3, blk = (lane >> 4) & 1;
    const int cb = wave & 3, pair = wave >> 2;
    const int qrow = r0 + 2 * pair + (r >> 4), qcol = 16 * cb + (r & 15);
    const size_t qtok = is_ctx ? (size_t)(MLAT + b * 256 + 32 * wave + r) : (size_t)(b * 16384 + qrow * 64 + qcol);
    const int ws_q = clampi(qcol - 8, 0, 48), rs_q = clampi(qrow - 4, 0, 248);
    const int cs = clampi(16 * cb - 8, 0, 32);
    const int rs_a = clampi(r0 + 2 * pair - 4, 0, 248), rs_b = clampi(r0 + 2 * pair + 1 - 4, 0, 248);
    const int kr_lo = clampi(r0 - 4, 0, 248), kr_hi = clampi(r0 + 3 - 4, 0, 248) + 8;
    const int nlat = is_ctx ? 0 : kr_hi - kr_lo, nsteps = nlat + 4;
    __syncthreads();
    { const float* rp = a.in[14] + ((size_t)l * 16 + head) * 465; LAS float* rl = (LAS float*)(lds + NA_RPB);
        if (tid < 465) rl[tid] = rp[tid];
        if (tid < 128) ((LAS float*)(lds + NA_FAC))[tid] = a.in[12][(size_t)l * 128 + tid] * a.in[13][(size_t)l * 128 + tid] * 0.08838834764831845f; }
    __syncthreads();
    bf16x8 qf[8];
    { const f32x4 sq = *(const GAS f32x4*)(SSQ + (qtok * 16 + head) * 4); const float rq = 1.0f / sqrtf(((sq.x + sq.y) + (sq.z + sq.w)) * (1.0f / 128.0f) + EPS);
#pragma unroll
        for (int ks = 0; ks < 8; ++ks) { const v4u x = *(const GAS v4u*)(P + qtok * NP + OFF_BQ + head * 128 + 16 * ks + 8 * hh);
            const LAS f32x4* fp = (const LAS f32x4*)(lds + NA_FAC + (16 * ks + 8 * hh) * 4); const f32x4 f0 = fp[0] * rq, f1 = fp[1] * rq;
            v4u o; o.x = pkh(bflo(x.x) * f0.x, bfhi(x.x) * f0.y); o.y = pkh(bflo(x.y) * f0.z, bfhi(x.y) * f0.w); o.z = pkh(bflo(x.z) * f1.x, bfhi(x.z) * f1.y); o.w = pkh(bflo(x.w) * f1.z, bfhi(x.w) * f1.w);
            qf[ks] = __builtin_bit_cast(bf16x8, o); } }
    f32x16 O[4];
#pragma unroll
    for (int i = 0; i < 4; ++i)
#pragma unroll
        for (int e = 0; e < 16; ++e) O[i][e] = 0.f;
    float mrun = NEG_BIG, lsum = 0.f;
    LAS unsigned char* ptw = lds + NA_PT + wave * 4608;
    v4u kreg[2], vreg[2]; f32x4 sreg = {0.f, 0.f, 0.f, 0.f};
#define NA_PREFETCH(st) do { const size_t row0_ = (st) < nlat ? (size_t)(b * 16384 + (kr_lo + (st)) * 64) : (size_t)(MLAT + b * 256 + 64 * ((st) - nlat)); \
        _Pragma("unroll") for (int i = 0; i < 2; ++i) { const int idx = tid + 512 * i, kk = idx >> 4, ch = idx & 15; \
            kreg[i] = *(const GAS v4u*)(P + (row0_ + kk) * NP + OFF_BK + head * 128 + 8 * ch); vreg[i] = *(const GAS v4u*)(P + (row0_ + kk) * NP + OFF_BV + head * 128 + 8 * ch); } \
        if (tid < 64) sreg = *(const GAS f32x4*)(SSQ + (((size_t)MALL + row0_ + tid) * 16 + head) * 4); } while (0)
    NA_PREFETCH(0);
    for (int st = 0; st < nsteps; ++st) {
        const int buf = st & 1;
        LAS unsigned char* kt = lds + NA_KT0 + buf * 17408; LAS unsigned char* vt = lds + NA_VT0 + buf * 20480; LAS float* rkl = (LAS float*)(lds + NA_RK0 + buf * 256);
#pragma unroll
        for (int i = 0; i < 2; ++i) { const int idx = tid + 512 * i, kk = idx >> 4, ch = idx & 15;
            *(LAS v4u*)(kt + kk * NK_STR + ch * 16) = kreg[i]; *(LAS v4u*)(vt + kk * NV_STR + ch * 16) = vreg[i]; }
        if (tid < 64) rkl[tid] = 1.0f / sqrtf(((sreg.x + sreg.y) + (sreg.z + sreg.w)) * (1.0f / 128.0f) + EPS);
        if (st + 1 < nsteps) NA_PREFETCH(st + 1);
        __syncthreads();
        const bool lat = st < nlat; const int kr = kr_lo + st;
        const bool active = !lat || (kr >= rs_a && kr < rs_a + 8) || (kr >= rs_b && kr < rs_b + 8);
        if (active) {
            const int ntile = lat ? 1 : 2;
            for (int tl = 0; tl < ntile; ++tl) {
                const int ko = lat ? cs : 32 * tl;
                f32x16 sacc;
#pragma unroll
                for (int e = 0; e < 16; ++e) sacc[e] = 0.f;
#pragma unroll
                for (int ks = 0; ks < 8; ++ks) { const bf16x8 ka = *(LAS bf16x8*)(kt + (ko + r) * NK_STR + (16 * ks + 8 * hh) * 2); sacc = MFMA32(ka, qf[ks], sacc); }
                float sv[16]; float tmax = NEG_BIG;
                const bool rowok = !lat || (kr >= rs_q && kr < rs_q + 8);
                const int dr = kr - qrow + 7;
#pragma unroll
                for (int g4 = 0; g4 < 4; ++g4) { const f32x4 rk4 = *(LAS f32x4*)(rkl + ko + 8 * g4 + 4 * hh);
#pragma unroll
                    for (int e = 0; e < 4; ++e) { const int kc = ko + 8 * g4 + 4 * hh + e; float s = sacc[4 * g4 + e] * rk4[e];
                        bool ok = true;
                        if (lat) { ok = rowok && kc >= ws_q && kc < ws_q + 16; const int bi = ok ? dr * 31 + (kc - qcol + 15) : 0; s += ((LAS float*)(lds + NA_RPB))[bi]; }
                        s = ok ? s : NEG_BIG; sv[4 * g4 + e] = s; tmax = fmaxf(tmax, s); } }
                tmax = fmaxf(tmax, __shfl_xor(tmax, 32));
                const float mnew = fmaxf(mrun, tmax); const float alpha = __expf(mrun - mnew); mrun = mnew;
                float psum = 0.f;
#pragma unroll
                for (int g4 = 0; g4 < 4; ++g4) { float pe[4];
#pragma unroll
                    for (int e = 0; e < 4; ++e) pe[e] = sv[4 * g4 + e] > -1e29f ? __expf(sv[4 * g4 + e] - mnew) : 0.f;
                    v2u w; w.x = pkh(pe[0], pe[1]); w.y = pkh(pe[2], pe[3]);
                    psum += (bflo(w.x) + bfhi(w.x)) + (bflo(w.y) + bfhi(w.y));
                    *(LAS v2u*)(ptw + r * NP_STR + (8 * g4 + 4 * hh) * 2) = w; }
                lsum = lsum * alpha + psum;
#pragma unroll
                for (int i = 0; i < 4; ++i)
#pragma unroll
                    for (int e = 0; e < 16; ++e) O[i][e] *= alpha;
                asm volatile("s_waitcnt lgkmcnt(0)" ::: "memory");
#pragma unroll
                for (int ks = 0; ks < 2; ++ks) { const bf16x8 pb = *(LAS bf16x8*)(ptw + r * NP_STR + (16 * ks + 8 * hh) * 2);
#pragma unroll
                    for (int i = 0; i < 4; ++i) { const LAS unsigned char* vp = vt + (ko + 16 * ks + 8 * hh + q4) * NV_STR + (32 * i + 16 * blk + 4 * p4) * 2;
                        const bf16x8 va = cat8(tr_read(vp), tr_read(vp + 4 * NV_STR)); O[i] = MFMA32(va, pb, O[i]); } }
                asm volatile("s_waitcnt lgkmcnt(0)" ::: "memory");
            }
        }
    }
#undef NA_PREFETCH
    lsum += __shfl_xor(lsum, 32);
    const float inv = 1.0f / lsum;
#pragma unroll
    for (int i = 0; i < 4; ++i)
#pragma unroll
        for (int g4 = 0; g4 < 4; ++g4) { const int d0 = 32 * i + 8 * g4 + 4 * hh;
            const v2u z = *(const GAS v2u*)(P + qtok * NP + OFF_BZ + head * 128 + d0);
            const float o0 = O[i][4 * g4 + 0] * inv * silu(bflo(z.x)), o1 = O[i][4 * g4 + 1] * inv * silu(bfhi(z.x)), o2 = O[i][4 * g4 + 2] * inv * silu(bflo(z.y)), o3 = O[i][4 * g4 + 3] * inv * silu(bfhi(z.y));
            v2u w; w.x = pkh(o0, o1); w.y = pkh(o2, o3); *(GAS v2u*)(YB + qtok * 2048 + head * 128 + d0) = w; }
}

__device__ __forceinline__ void na_phase(const Args& a, LAS unsigned char* lds, int l, bool need_ctx, int tid, int lane, int wave) {
    const int nun = 2048 + (need_ctx ? 32 : 0);
    for (int uu = blockIdx.x; uu < nun; uu += gridDim.x) {
        if (uu < 2048) { const int b = uu >> 10, head = (uu >> 6) & 15, rq = uu & 63; na_unit(a, lds, l, b, head, 4 * rq, false, tid, lane, wave); }
        else { const int v = uu - 2048; na_unit(a, lds, l, v >> 4, v & 15, 0, true, tid, lane, wave); }
    }
    __syncthreads();
}

constexpr int NPHASE = 1 + 9 * DEPTH;
#define PH_ON(x) (PHSEL < 0 || PHSEL == (x))
template <int PHSEL>
__global__ void __launch_bounds__(NWAVES * 64, 2) fwd_kernel(Args args) {
    extern __shared__ __attribute__((aligned(16))) unsigned char lds_raw[];
    LAS unsigned char* lds = (LAS unsigned char*)lds_raw;
    const int tid = threadIdx.x, lane = tid & 63, wave = __builtin_amdgcn_readfirstlane(tid >> 6);
    volatile LAS unsigned* MISC = (volatile LAS unsigned*)(lds + MISC_OFF);
    for (int u = tid; u < (LDS_BYTES - RING_BYTES) / 4; u += NWAVES * 64) ((LAS unsigned*)(lds + RING_BYTES))[u] = 0u;
    __syncthreads();
    unsigned char* ws = args.ws;
    gu32* ctl = (gu32*)(ws + WS_CTL);
    const bool use_bar = (args.ph_hi - args.ph_lo) > 1;
    XcdBarrier bar; bar.bar = (unsigned*)(ctl + CW_BAR); bar.x = 0; bar.st = nullptr;
    if (use_bar) bar = xcd_barrier_post((unsigned*)(ctl + CW_BAR), MISC + 8);
    const int lo = args.ph_lo, hi = args.ph_hi;
#define IN(k) (lo <= (k) && (k) < hi)
#define SEAM(k) do { if (IN(k) && IN((k) + 1)) xcd_barrier(bar); } while (0)

    if (PH_ON(0) && IN(0)) { prologue(args, lds, tid, lane, wave); SEAM(0); }
    for (int l = 0; l < DEPTH; ++l) {
        const int pb = 1 + 9 * l; const bool need_ctx = l < DEPTH - 1;
        const int mrows = need_ctx ? MALL : MLAT;
        const float* MODl = (const float*)(ws + WS_MOD) + (size_t)l * 3 * 6144;
        if (PH_ON(1) && IN(pb + 0)) { norm_phase(args, lds, l, tid, lane, wave); SEAM(pb + 0); }
        if (PH_ON(2) && IN(pb + 1)) {
            pg8::Gemm g{(const pg8::bf16_t*)(ws + WS_H), (const pg8::bf16_t*)(ws + WS_WIN) + (size_t)l * NPAD * 2048, MALL, NPAD, 2048};
            pg8::StaticOrder S; S.init(MALL, NPAD, (int)gridDim.x, (int)blockIdx.x);
            pg8::EpiIn E{(pg8::bf16_t*)(ws + WS_P), (float*)(ws + WS_G), (float*)(ws + WS_SSQ), args.in[8] + (size_t)l * NIN, (const float*)(ws + WS_ROPE), MALL};
            pg8::gemm_phase<pg8::EpiIn, pg8::StaticOrder, true, true>(lds, g, S, E);
            SEAM(pb + 1);
        }
        if ((PH_ON(3) || PHSEL == 10) && IN(pb + 2)) { mlstm_phase<PHSEL == 3 ? 1 : (PHSEL == 10 ? 2 : 0)>(args, lds, 1, need_ctx, tid, lane, wave); SEAM(pb + 2); }
        if (PH_ON(4) && IN(pb + 3)) { mlstm_phase<0>(args, lds, 2, need_ctx, tid, lane, wave); SEAM(pb + 3); }
        if (PH_ON(5) && IN(pb + 4)) { na_phase(args, lds, l, need_ctx, tid, lane, wave); SEAM(pb + 4); }
        if (PH_ON(6) && IN(pb + 5)) { post_phase(args, lds, l, need_ctx, tid, lane, wave); SEAM(pb + 5); }
        if (PH_ON(7) && IN(pb + 6)) {
            pg8::Gemm g{(const pg8::bf16_t*)(ws + WS_H), (const pg8::bf16_t*)(ws + WS_WAB) + ((size_t)l * 2 + 0) * 2048 * 2048, mrows, 2048, 2048};
            pg8::StaticOrder S; S.init(mrows, 2048, (int)gridDim.x, (int)blockIdx.x);
            pg8::EpiMerge<0> E{(const pg8::bf16_t*)(ws + WS_P), OFF_GA, nullptr, (pg8::bf16_t*)(ws + WS_HF)};
            pg8::gemm_phase<pg8::EpiMerge<0>, pg8::StaticOrder, true, true>(lds, g, S, E);
            SEAM(pb + 6);
        }
        if (PH_ON(8) && IN(pb + 7)) {
            pg8::Gemm g{(const pg8::bf16_t*)(ws + WS_YB), (const pg8::bf16_t*)(ws + WS_WAB) + ((size_t)l * 2 + 1) * 2048 * 2048, mrows, 2048, 2048};
            pg8::StaticOrder S; S.init(mrows, 2048, (int)gridDim.x, (int)blockIdx.x);
            pg8::EpiMerge<1> E{(const pg8::bf16_t*)(ws + WS_P), OFF_GB, (const pg8::bf16_t*)(ws + WS_HF), (pg8::bf16_t*)(ws + WS_HB)};
            pg8::gemm_phase<pg8::EpiMerge<1>, pg8::StaticOrder, true, true>(lds, g, S, E);
            SEAM(pb + 7);
        }
        if (PH_ON(9) && IN(pb + 8)) {
            pg8::Gemm g{(const pg8::bf16_t*)(ws + WS_HB), (const pg8::bf16_t*)(ws + WS_WO) + (size_t)l * 2048 * 2048, mrows, 2048, 2048};
            pg8::StaticOrder S; S.init(mrows, 2048, (int)gridDim.x, (int)blockIdx.x);
            pg8::EpiOut E{l == 0 ? args.in[0] : args.out, args.out, l == 0 ? args.in[2] : (const float*)(ws + WS_XC), (float*)(ws + WS_XC), MODl, args.in[16] + (size_t)l * 2048};
            pg8::gemm_phase<pg8::EpiOut, pg8::StaticOrder, true, true>(lds, g, S, E);
            SEAM(pb + 8);
        }
    }
#undef IN
#undef SEAM
}

template <int PHSEL> static void launch_one(const Args& a, int grid, hipStream_t stream, bool first) {
    if (first) (void)hipFuncSetAttribute((const void*)fwd_kernel<PHSEL>, hipFuncAttributeMaxDynamicSharedMemorySize, LDS_BYTES);
    hipLaunchKernelGGL(fwd_kernel<PHSEL>, dim3(grid), dim3(NWAVES * 64), LDS_BYTES, stream, a);
}
extern "C" void kernel_launch(void* const* d_in, const int* in_sizes, int n_in, void* d_out, int out_size, void* d_ws, size_t ws_size, hipStream_t stream) {
    static int grid = 0; static bool first = true;
    if (grid == 0) {
        if (n_in != 17 || out_size != MLAT * DM || ws_size < WS_END) { fprintf(stderr, "kernel_launch: unexpected shapes / workspace (n_in %d out %d ws %zu need %zu)\n", n_in, out_size, ws_size, (size_t)WS_END); grid = -1; return; }
        int dev = 0, cus = 0;
        if (hipGetDevice(&dev) != hipSuccess || hipDeviceGetAttribute(&cus, hipDeviceAttributeMultiprocessorCount, dev) != hipSuccess) { grid = -1; return; }
        grid = cus;
    }
    if (grid < 0) return;
    if (hipMemsetAsync((char*)d_ws + WS_CTL, 0, CTL_ZERO_BYTES, stream) != hipSuccess) return;
    Args a{};
    for (int i = 0; i < 17; ++i) a.in[i] = (const float*)d_in[i];
    a.out = (float*)d_out; a.ws = (unsigned char*)d_ws;
#if N_LAUNCH_MODE == 1
    a.ph_lo = 0; a.ph_hi = NPHASE;
    launch_one<-1>(a, grid, stream, first);
#else
    a.ph_lo = 0; a.ph_hi = 1; launch_one<0>(a, grid, stream, first);
    for (int l = 0; l < DEPTH; ++l) { const int pb = 1 + 9 * l;
        a.ph_lo = pb + 0; a.ph_hi = pb + 1; launch_one<1>(a, grid, stream, first);
        a.ph_lo = pb + 1; a.ph_hi = pb + 2; launch_one<2>(a, grid, stream, first);
        a.ph_lo = pb + 2; a.ph_hi = pb + 3; launch_one<3>(a, grid, stream, first); launch_one<10>(a, grid, stream, first);
        a.ph_lo = pb + 3; a.ph_hi = pb + 4; launch_one<4>(a, grid, stream, first);
        a.ph_lo = pb + 4; a.ph_hi = pb + 5; launch_one<5>(a, grid, stream, first);
        a.ph_lo = pb + 5; a.ph_hi = pb + 6; launch_one<6>(a, grid, stream, first);
        a.ph_lo = pb + 6; a.ph_hi = pb + 7; launch_one<7>(a, grid, stream, first);
        a.ph_lo = pb + 7; a.ph_hi = pb + 8; launch_one<8>(a, grid, stream, first);
        a.ph_lo = pb + 8; a.ph_hi = pb + 9; launch_one<9>(a, grid, stream, first);
    }
#endif
    first = false;
}
```

```cpp
#include <hip/hip_runtime.h>
#include <cstdio>
#include <cstdint>
#ifndef N_LAUNCH_MODE
#define N_LAUNCH_MODE 1
#endif
namespace pg8 {
#define PG8_LAS __attribute__((address_space(3)))
typedef unsigned short bf16_t;
typedef short bf16x8 __attribute__((ext_vector_type(8)));
typedef float f32x4 __attribute__((ext_vector_type(4)));
typedef unsigned u32x4 __attribute__((ext_vector_type(4)));
typedef int i32x4 __attribute__((ext_vector_type(4)));
constexpr int BM = 256, BK = 64, HALF = 128, HTB = HALF * BK * 2  , STAGE_BYTES = 8 * HTB, NXCD = 8, WGM = 5;

__host__ __device__ __forceinline__ int lds_byte(int r, int c) { const int st = (r >> 4) * 2 + (c >> 5), rr = r & 15, cc = c & 31, ob = rr * 64 + cc * 2; return st * 1024 + (ob ^ (((ob >> 9) & 1) << 5)); }
__host__ __device__ __forceinline__ void stage_rc(int b, int& R, int& C) { const int st = b / 1024, sb = b % 1024, swz = sb ^ (((sb >> 9) & 1) << 5); R = (st >> 1) * 16 + swz / 64; C = (st & 1) * 32 + (swz % 64) / 2; }
__host__ __device__ __forceinline__ int perm32(int rho) { const int n = rho >> 4, i = rho & 15; return 8 * (i >> 2) + 4 * n + (i & 3); }

struct Unit { int pm, pn; };
struct Gemm { const bf16_t* A; const bf16_t* Bt; int M, N, K, kext; };

struct StaticOrder {
    int nM, nN, nwg, G, c, wgm;
    __host__ __device__ void init(int M, int N, int G_, int c_, int wgm_ = WGM) { nM = M / BM; nN = N / BM; nwg = nM * nN; G = G_; c = c_; wgm = wgm_; }
    __host__ __device__ bool next(int i, Unit& u) const { return at((long)i * G + c, u); }
    __host__ __device__ bool at(const long L, Unit& u) const {
        if (L >= nwg) return false;
        int wgid = (int)L; { const int q = nwg / NXCD, r = nwg % NXCD, xcd = wgid % NXCD, off = wgid / NXCD; wgid = (xcd < r ? xcd * (q + 1) : r * (q + 1) + (xcd - r) * q) + off; }
        const int nig = wgm * nN, gid = wgid / nig, fm = gid * wgm, gsz = (nM - fm) < wgm ? (nM - fm) : wgm;
        u.pm = fm + ((wgid % nig) % gsz); u.pn = (wgid % nig) / gsz; return true;
    }
    __device__ __forceinline__ void a_ready(const Unit&) const {}
    __device__ __forceinline__ void done(const Unit&) const {}
};


__device__ __forceinline__ unsigned cvt_pk_bf16(float lo, float hi) { unsigned r; asm volatile("v_cvt_pk_bf16_f32 %0, %1, %2" : "=v"(r) : "v"(lo), "v"(hi)); return r; }
__device__ __forceinline__ float bf_lo(unsigned w) { return __builtin_bit_cast(float, w << 16); }
__device__ __forceinline__ float bf_hi(unsigned w) { return __builtin_bit_cast(float, w & 0xffff0000u); }
__device__ __forceinline__ float sigmoid_f(float x) { return __builtin_amdgcn_rcpf(1.0f + __builtin_amdgcn_exp2f(-1.4426950408889634f * x)); }

constexpr int E_MLAT = 32768, E_NP = 20608;

constexpr int EPI_LDS0 = 134144;
template <bool I8> struct EpiInT {
    static constexpr bool PERM = true, AFTER_DRAIN = false, PREFETCH = true;
    bf16_t* P; float* G; float* SSQ; const float* pb; const float* rope; int mall; const float* rs; const float* cs;
    __device__ __forceinline__ void prefetch(PG8_LAS unsigned char* lds, const Unit& u, int par, int wid, int lane) const {
        PG8_LAS unsigned char* base = lds + EPI_LDS0 + par * 3072;
        if (wid < 4) { const int c = u.pn * BM + 64 * wid + lane;
            __builtin_amdgcn_global_load_lds((const unsigned*)(pb + c), (PG8_LAS unsigned*)(base + 1024 + 256 * wid), 4, 0, 0);
            if constexpr (I8) __builtin_amdgcn_global_load_lds((const unsigned*)(cs + c), (PG8_LAS unsigned*)(base + 256 * wid), 4, 0, 0);
        } else { if constexpr (I8) { const int r = u.pm * BM + 64 * (wid - 4) + lane;
            __builtin_amdgcn_global_load_lds((const unsigned*)(rs + r), (PG8_LAS unsigned*)(base + 2048 + 256 * (wid - 4)), 4, 0, 0); } }
    }
    __device__ __forceinline__ void operator()(const f32x4 (&acc)[2][2][4][2], const Unit& u, int wr, int wc, int fr, int fq, const PG8_LAS unsigned char* lds, int par) const {
        asm volatile("" : "+v"(fr), "+v"(fq));
        const int pn = u.pn; const int row0 = u.pm * BM + wr * 64 + fr;
        const PG8_LAS unsigned char* lb = lds + EPI_LDS0 + par * 3072;
        if constexpr (I8) {
            f32x4 (&A)[2][2][4][2] = const_cast<f32x4 (&)[2][2][4][2]>(acc);
            f32x4 cv[2][2]; float rsv[2][4];
#pragma unroll
            for (int bj = 0; bj < 2; ++bj)
#pragma unroll
                for (int n = 0; n < 2; ++n) cv[bj][n] = *(const PG8_LAS f32x4*)(lb + (bj * HALF + wc * 32 + 8 * fq + 4 * n) * 4);
#pragma unroll
            for (int ai = 0; ai < 2; ++ai)
#pragma unroll
                for (int m = 0; m < 4; ++m) rsv[ai][m] = *(const PG8_LAS float*)(lb + 2048 + (wr * 64 + fr + ai * HALF + m * 16) * 4);
#pragma unroll
            for (int ai = 0; ai < 2; ++ai)
#pragma unroll
                for (int m = 0; m < 4; ++m)
#pragma unroll
                    for (int bj = 0; bj < 2; ++bj)
#pragma unroll
                        for (int n = 0; n < 2; ++n) A[ai][bj][m][n] = __builtin_convertvector(__builtin_bit_cast(i32x4, A[ai][bj][m][n]), f32x4) * (cv[bj][n] * rsv[ai][m]);
        }
        if (pn == 80) {
            if (wc == 0) {
#pragma unroll
                for (int ai = 0; ai < 2; ++ai)
#pragma unroll
                    for (int m = 0; m < 4; ++m) { const int row = row0 + ai * HALF + m * 16;
#pragma unroll
                        for (int n = 0; n < 2; ++n) { const f32x4 bv = *(const PG8_LAS f32x4*)(lb + 1024 + (8 * fq + 4 * n) * 4);
                            *(f32x4*)(G + (size_t)row * 32 + 8 * fq + 4 * n) = acc[ai][0][m][n] + bv; } }
            }
            return;
        }
        const int colt = pn * BM; const int cw = wc * 32 + 8 * fq;
        f32x4 bv[2][2];
#pragma unroll
        for (int bj = 0; bj < 2; ++bj)
#pragma unroll
            for (int n = 0; n < 2; ++n) bv[bj][n] = *(const PG8_LAS f32x4*)(lb + 1024 + (bj * HALF + cw + 4 * n) * 4);
        const bool is_rope = pn < 8;
        const float ksc = (pn >= 4 && pn < 8) ? 0.08838834764831845f : 1.0f;
        const bool is_gz = (pn >= 16 && pn < 32);
        const bool is_ssq = (pn >= 32 && pn < 48); const int which = pn >= 40 ? 1 : 0; const int hd0 = 2 * (pn - 32 - 8 * which);
        const int blk = wc >> 1, i0 = 16 * (wc & 1) + 4 * fq;
        if (is_rope) {
            const bool latrows = u.pm * BM < E_MLAT;
#pragma unroll
            for (int ah = 0; ah < 4; ++ah) { const int ai = ah >> 1, mh = ah & 1; f32x4 csA[2], csB[2];
#pragma unroll
                for (int mm = 0; mm < 2; ++mm) { const int m = 2 * mh + mm; const int row = row0 + ai * HALF + m * 16; csA[mm] = (f32x4){1.f, 0.f, 1.f, 0.f}; csB[mm] = csA[mm];
                    if (latrows) { const int t = row & 16383; const int pos = blk ? (t & 63) : (t >> 6); csA[mm] = *(const f32x4*)(rope + (size_t)(pos * 32 + i0) * 2); csB[mm] = *(const f32x4*)(rope + (size_t)(pos * 32 + i0) * 2 + 4); } }
#pragma unroll
                for (int mm = 0; mm < 2; ++mm) { const int m = 2 * mh + mm; const int row = row0 + ai * HALF + m * 16; bf16_t* rowp = P + (size_t)row * E_NP + colt + cw; const f32x4 cs0 = csA[mm], cs1 = csB[mm];
#pragma unroll
                    for (int bj = 0; bj < 2; ++bj) { const f32x4 v0 = acc[ai][bj][m][0] + bv[bj][0], v1 = acc[ai][bj][m][1] + bv[bj][1];
                        f32x4 r0, r1;
                        r0[0] = v0[0] * cs0[0] - v0[1] * cs0[1]; r0[1] = v0[0] * cs0[1] + v0[1] * cs0[0]; r0[2] = v0[2] * cs0[2] - v0[3] * cs0[3]; r0[3] = v0[2] * cs0[3] + v0[3] * cs0[2];
                        r1[0] = v1[0] * cs1[0] - v1[1] * cs1[1]; r1[1] = v1[0] * cs1[1] + v1[1] * cs1[0]; r1[2] = v1[2] * cs1[2] - v1[3] * cs1[3]; r1[3] = v1[2] * cs1[3] + v1[3] * cs1[2];
                        r0 = r0 * ksc; r1 = r1 * ksc;
                        u32x4 w; w.x = cvt_pk_bf16(r0[0], r0[1]); w.y = cvt_pk_bf16(r0[2], r0[3]); w.z = cvt_pk_bf16(r1[0], r1[1]); w.w = cvt_pk_bf16(r1[2], r1[3]);
                        *(u32x4*)(rowp + bj * HALF) = w; } } }
            return;
        }
#pragma unroll
        for (int ai = 0; ai < 2; ++ai)
#pragma unroll
            for (int m = 0; m < 4; ++m) { const int row = row0 + ai * HALF + m * 16; bf16_t* rowp = P + (size_t)row * E_NP + colt + cw;
                const f32x4 cs0 = (f32x4){1.f, 0.f, 1.f, 0.f}, cs1 = cs0;
#pragma unroll
                for (int bj = 0; bj < 2; ++bj) { f32x4 v0 = acc[ai][bj][m][0] + bv[bj][0], v1 = acc[ai][bj][m][1] + bv[bj][1];
                    if (is_gz) { const int cb = 128 * (pn - 16) + 64 * bj + 16 * wc + 4 * fq;
                        const float g0 = sigmoid_f(v0[0]) * v0[1] * sigmoid_f(v0[1]), g1 = sigmoid_f(v0[2]) * v0[3] * sigmoid_f(v0[3]), g2 = sigmoid_f(v1[0]) * v1[1] * sigmoid_f(v1[1]), g3 = sigmoid_f(v1[2]) * v1[3] * sigmoid_f(v1[3]);
                        typedef unsigned u32x2e __attribute__((ext_vector_type(2))); u32x2e wz; wz.x = cvt_pk_bf16(g0, g1); wz.y = cvt_pk_bf16(g2, g3);
                        *(u32x2e*)(P + (size_t)row * E_NP + 4096 + cb) = wz; continue; }
                    if (is_rope) {
                        f32x4 r0, r1;
                        r0[0] = v0[0] * cs0[0] - v0[1] * cs0[1]; r0[1] = v0[0] * cs0[1] + v0[1] * cs0[0]; r0[2] = v0[2] * cs0[2] - v0[3] * cs0[3]; r0[3] = v0[2] * cs0[3] + v0[3] * cs0[2];
                        r1[0] = v1[0] * cs1[0] - v1[1] * cs1[1]; r1[1] = v1[0] * cs1[1] + v1[1] * cs1[0]; r1[2] = v1[2] * cs1[2] - v1[3] * cs1[3]; r1[3] = v1[2] * cs1[3] + v1[3] * cs1[2];
                        v0 = r0 * ksc; v1 = r1 * ksc;
                    }
                    if (is_ssq) { float s = (v0[0] * v0[0] + v0[1] * v0[1]) + (v0[2] * v0[2] + v0[3] * v0[3]) + (v1[0] * v1[0] + v1[1] * v1[1]) + (v1[2] * v1[2] + v1[3] * v1[3]);
                        const int ln = fq * 16 + fr; s += __builtin_bit_cast(float, __builtin_amdgcn_ds_bpermute((ln ^ 16) << 2, __builtin_bit_cast(int, s))); s += __builtin_bit_cast(float, __builtin_amdgcn_ds_bpermute((ln ^ 32) << 2, __builtin_bit_cast(int, s)));
                        if (fq == 0) SSQ[(((size_t)which * mall + row) * 16 + hd0 + bj) * 4 + wc] = s; }
                    u32x4 w; w.x = cvt_pk_bf16(v0[0], v0[1]); w.y = cvt_pk_bf16(v0[2], v0[3]); w.z = cvt_pk_bf16(v1[0], v1[1]); w.w = cvt_pk_bf16(v1[2], v1[3]);
                    *(u32x4*)(rowp + bj * HALF) = w; } }
    }
};
typedef EpiInT<false> EpiIn;
typedef EpiInT<true> EpiInQ;

template <int SECOND> struct EpiMerge {
    static constexpr bool PERM = true, AFTER_DRAIN = false, PREFETCH = false;
    const bf16_t* P; int goff; const bf16_t* Tin; bf16_t* O;
    __device__ __forceinline__ void operator()(const f32x4 (&acc)[2][2][4][2], const Unit& u, int wr, int wc, int fr, int fq) const {
        const int row0 = u.pm * BM + wr * 64 + fr; const int col0 = u.pn * BM + wc * 32 + 8 * fq;
#pragma unroll
        for (int ai = 0; ai < 2; ++ai)
#pragma unroll
            for (int m = 0; m < 4; ++m) { const int row = row0 + ai * HALF + m * 16;
#pragma unroll
                for (int bj = 0; bj < 2; ++bj) { const int col = col0 + bj * HALF;
                    const u32x4 gw = *(const u32x4*)(P + (size_t)row * E_NP + goff + col);
                    f32x4 v0 = acc[ai][bj][m][0], v1 = acc[ai][bj][m][1];
                    v0[0] *= sigmoid_f(bf_lo(gw.x)); v0[1] *= sigmoid_f(bf_hi(gw.x)); v0[2] *= sigmoid_f(bf_lo(gw.y)); v0[3] *= sigmoid_f(bf_hi(gw.y));
                    v1[0] *= sigmoid_f(bf_lo(gw.z)); v1[1] *= sigmoid_f(bf_hi(gw.z)); v1[2] *= sigmoid_f(bf_lo(gw.w)); v1[3] *= sigmoid_f(bf_hi(gw.w));
                    if (SECOND) { const u32x4 tw = *(const u32x4*)(Tin + (size_t)row * 2048 + col);
                        v0[0] += bf_lo(tw.x); v0[1] += bf_hi(tw.x); v0[2] += bf_lo(tw.y); v0[3] += bf_hi(tw.y); v1[0] += bf_lo(tw.z); v1[1] += bf_hi(tw.z); v1[2] += bf_lo(tw.w); v1[3] += bf_hi(tw.w); }
                    u32x4 w; w.x = cvt_pk_bf16(v0[0], v0[1]); w.y = cvt_pk_bf16(v0[2], v0[3]); w.z = cvt_pk_bf16(v1[0], v1[1]); w.w = cvt_pk_bf16(v1[2], v1[3]);
                    *(u32x4*)(O + (size_t)row * 2048 + col) = w; } }
    }
};

struct PairOrder {
    StaticOrder base; int single;
    __device__ bool next(int i, Unit& u) const {
        if (single >= 0) { if (i >= 1) return false; const int t = single & 15, br = single >> 4; u.pm = 128 + (t >> 3) + 130 * br; u.pn = (t & 7) + 8 * br; return true; }
        if (!base.next(i >> 1, u)) return false;
        if (i & 1) { u.pm += 130; u.pn += 8; }
        return true; }
    __device__ __forceinline__ void a_ready(const Unit&) const {}
    __device__ __forceinline__ void done(const Unit&) const {}
};
struct MapOrder {
    StaticOrder base; unsigned mask; int i0 = 0, i1 = 1 << 30, n2 = 0, n1 = 0;
    __device__ bool next(int i, Unit& u) const {
        i += i0; if (i >= i1) return false;
        if (n2 > 0 && i >= base.nwg / base.G) {
            const int j = i - base.nwg / base.G, c = base.c; long L = (long)(base.nwg / base.G) * base.G;
            if (c < n2) { if (j >= 2) return false; L += 2 * c + j; } else if (c < n2 + n1) { if (j >= 1) return false; L += 2 * n2 + (c - n2); } else return false;
            if (!base.at(L, u)) return false;
        } else
        if (!base.next(i, u)) return false;
        const int g = u.pn >> 3; int pos = 10, cnt = 0;
#pragma unroll
        for (int b = 0; b < 10; ++b) if ((mask >> b) & 1u) { if (cnt == g) pos = b; ++cnt; }
        u.pn = pos * 8 + (u.pn & 7);
        return true; }
    __device__ __forceinline__ void a_ready(const Unit&) const {}
    __device__ __forceinline__ void done(const Unit&) const {}
};
struct EpiMergePair {
    static constexpr bool PERM = true, AFTER_DRAIN = false, PREFETCH = false;
    const bf16_t* P; bf16_t* T; long yoff; int add_t;
    __device__ __forceinline__ void operator()(const f32x4 (&acc)[2][2][4][2], const Unit& u, int wr, int wc, int fr, int fq) const {
        const bool second = u.pn >= 8; const int pm = second ? u.pm - 130 : u.pm, pn = second ? u.pn - 8 : u.pn; const int goff = second ? 18432 : 16384;
        const int row0 = pm * BM + wr * 64 + fr; const int col0 = pn * BM + wc * 32 + 8 * fq;
        const bool addt = second && add_t;
#pragma unroll
        for (int ai = 0; ai < 2; ++ai) {
            u32x4 gw[4][2], tw[4][2];
#pragma unroll
            for (int m = 0; m < 4; ++m)
#pragma unroll
                for (int bj = 0; bj < 2; ++bj) { const int row = row0 + ai * HALF + m * 16, col = col0 + bj * HALF;
                    gw[m][bj] = *(const u32x4*)(P + (size_t)row * E_NP + goff + col);
                    tw[m][bj] = addt ? *(const u32x4*)(T + (size_t)row * 2048 + col) : (u32x4){0u, 0u, 0u, 0u}; }
#pragma unroll
            for (int m = 0; m < 4; ++m)
#pragma unroll
                for (int bj = 0; bj < 2; ++bj) { const int row = row0 + ai * HALF + m * 16, col = col0 + bj * HALF;
                    const u32x4 g = gw[m][bj], t = tw[m][bj];
                    f32x4 v0 = acc[ai][bj][m][0], v1 = acc[ai][bj][m][1];
                    v0[0] = v0[0] * sigmoid_f(bf_lo(g.x)) + bf_lo(t.x); v0[1] = v0[1] * sigmoid_f(bf_hi(g.x)) + bf_hi(t.x); v0[2] = v0[2] * sigmoid_f(bf_lo(g.y)) + bf_lo(t.y); v0[3] = v0[3] * sigmoid_f(bf_hi(g.y)) + bf_hi(t.y);
                    v1[0] = v1[0] * sigmoid_f(bf_lo(g.z)) + bf_lo(t.z); v1[1] = v1[1] * sigmoid_f(bf_hi(g.z)) + bf_hi(t.z); v1[2] = v1[2] * sigmoid_f(bf_lo(g.w)) + bf_lo(t.w); v1[3] = v1[3] * sigmoid_f(bf_hi(g.w)) + bf_hi(t.w);
                    u32x4 w; w.x = cvt_pk_bf16(v0[0], v0[1]); w.y = cvt_pk_bf16(v0[2], v0[3]); w.z = cvt_pk_bf16(v1[0], v1[1]); w.w = cvt_pk_bf16(v1[2], v1[3]);
                    *(u32x4*)(T + (second ? yoff : 0l) + (size_t)row * 2048 + col) = w; }
        }
        if (!second) asm volatile("s_waitcnt vmcnt(0)" ::: "memory");
    }
};

struct SliceOrder {
    int c;
    __device__ bool next(int i, Unit& u) const { if (i >= 1 || c >= 64) return false; const int t = c >> 2; u.pm = 128 + (t >> 3); u.pn = t & 7; return true; }
    __device__ __forceinline__ void a_ready(const Unit&) const {}
    __device__ __forceinline__ void done(const Unit&) const {}
};
struct EpiPart {
    static constexpr bool PERM = true, AFTER_DRAIN = false, PREFETCH = false;
    float* part;
    __device__ __forceinline__ void operator()(const f32x4 (&acc)[2][2][4][2], const Unit& u, int wr, int wc, int fr, int fq) const {
        const int row0 = (u.pm - 128) * BM + wr * 64 + fr; const int col0 = u.pn * BM + wc * 32 + 8 * fq;
#pragma unroll
        for (int ai = 0; ai < 2; ++ai)
#pragma unroll
            for (int m = 0; m < 4; ++m)
#pragma unroll
                for (int bj = 0; bj < 2; ++bj)
#pragma unroll
                    for (int n = 0; n < 2; ++n) *(f32x4*)(part + (size_t)(row0 + ai * HALF + m * 16) * 2048 + col0 + bj * HALF + 4 * n) = acc[ai][bj][m][n];
    }
};

struct EpiOut {
    static constexpr bool PERM = true, AFTER_DRAIN = false, PREFETCH = false;
    const float* xin_lat; float* xout_lat; const float* xin_ctx; float* xout_ctx; const float* mod; const float* bout;
    __device__ __forceinline__ void operator()(const f32x4 (&acc)[2][2][4][2], const Unit& u, int wr, int wc, int fr, int fq) const {
        const int row0 = u.pm * BM + wr * 64 + fr; const int col0 = u.pn * BM + wc * 32 + 8 * fq;
        const bool lat = u.pm * BM < E_MLAT; const int jb = lat ? ((u.pm * BM) >> 14) : 2;
        const float* gt = mod + jb * 6144 + 4096;
        f32x4 gv[2][2], bo[2][2];
#pragma unroll
        for (int bj = 0; bj < 2; ++bj)
#pragma unroll
            for (int n = 0; n < 2; ++n) { const int col = col0 + bj * HALF + 4 * n; gv[bj][n] = *(const f32x4*)(gt + col); bo[bj][n] = *(const f32x4*)(bout + col); }
#pragma unroll
        for (int ai = 0; ai < 2; ++ai)
#pragma unroll
            for (int mh = 0; mh < 2; ++mh) {
                f32x4 xv[2][2][2];
#pragma unroll
                for (int mm = 0; mm < 2; ++mm) { const int row = row0 + ai * HALF + (2 * mh + mm) * 16;
                    const float* xi = lat ? xin_lat + (size_t)row * 2048 : xin_ctx + (size_t)(row - E_MLAT) * 2048;
#pragma unroll
                    for (int bj = 0; bj < 2; ++bj)
#pragma unroll
                        for (int n = 0; n < 2; ++n) xv[mm][bj][n] = *(const f32x4*)(xi + col0 + bj * HALF + 4 * n); }
#pragma unroll
                for (int mm = 0; mm < 2; ++mm) { const int m = 2 * mh + mm, row = row0 + ai * HALF + m * 16;
                    float* xo = lat ? xout_lat + (size_t)row * 2048 : xout_ctx + (size_t)(row - E_MLAT) * 2048;
#pragma unroll
                    for (int bj = 0; bj < 2; ++bj)
#pragma unroll
                        for (int n = 0; n < 2; ++n) {
#if defined(DBG_MODE) && DBG_MODE == 1
                            *(f32x4*)(xo + col0 + bj * HALF + 4 * n) = xv[mm][bj][n];
#else
                            *(f32x4*)(xo + col0 + bj * HALF + 4 * n) = xv[mm][bj][n] + gv[bj][n] * (acc[ai][bj][m][n] + bo[bj][n]);
#endif
                        } }
            }
    }
};
template <class Epi, class Sched, bool ALIGN_EPI = false, bool SP2 = false, bool I8 = false>
__device__ __forceinline__ void gemm_phase(PG8_LAS unsigned char* lds, const Gemm g, const Sched& S, const Epi& E, const int wid_in) {
    int lane_o; asm volatile("v_mbcnt_lo_u32_b32 %0, -1, 0\n\tv_mbcnt_hi_u32_b32 %0, -1, %0" : "=v"(lane_o)); const int tid = wid_in * 64 + lane_o;
    const int wid = wid_in, lane = lane_o, wr = wid >> 2, wc = wid & 3, fr = lane & 15, fq = lane >> 4;
    const int K = g.K, nt = g.kext / BK;
    unsigned voffA[2], voffB[2];
#pragma unroll
    for (int i = 0; i < 2; ++i) { int R, C; stage_rc(tid * 16 + i * 8192, R, C); const int Rb = Epi::PERM ? ((R & ~31) + perm32(R & 31)) : R;
        voffA[i] = (unsigned)(R * K + C) * 2u; voffB[i] = (unsigned)(Rb * K + C) * 2u; }
    const size_t kstep = (size_t)(BK * 2);
    const size_t hstep = (size_t)HALF * K * 2;
    const size_t tstep = 2 * hstep;
    const unsigned ldsw = (unsigned)wid * 1024u;
    const int aoff = lds_byte(wr * 64 + fr, fq * 8), boff = lds_byte(wc * 32 + fr, fq * 8);
#define PG8_SA(b, h) (((b) * 2 + (h)) * HTB)
#define PG8_SB(b, h) ((4 + (b) * 2 + (h)) * HTB)
#define PG8_STAGE(bufoff, gbase, voff) do { _Pragma("unroll") for (int _i = 0; _i < 2; ++_i) \
        __builtin_amdgcn_global_load_lds((const unsigned*)((const char*)(gbase) + (voff)[_i]), (PG8_LAS unsigned*)(lds + (bufoff) + ldsw + _i * 8192), 16, 0, 0); } while (0)
#define PG8_LDA(dst, b, h) do { _Pragma("unroll") for (int m = 0; m < 4; ++m) _Pragma("unroll") for (int k = 0; k < 2; ++k) dst[m][k] = *(const PG8_LAS bf16x8*)(lds + PG8_SA(b, h) + aoff + m * 2048 + k * 1024); } while (0)
#define PG8_LDB(dst, b, h) do { _Pragma("unroll") for (int n = 0; n < 2; ++n) _Pragma("unroll") for (int k = 0; k < 2; ++k) dst[n][k] = *(const PG8_LAS bf16x8*)(lds + PG8_SB(b, h) + boff + n * 2048 + k * 1024); } while (0)
#define PG8_MMA(ai, bj, At, Bt) do { __builtin_amdgcn_s_setprio(1); _Pragma("unroll") for (int m = 0; m < 4; ++m) _Pragma("unroll") for (int n = 0; n < 2; ++n) _Pragma("unroll") for (int k = 0; k < 2; ++k) \
        { if constexpr (I8) acc[ai][bj][m][n] = __builtin_bit_cast(f32x4, __builtin_amdgcn_mfma_i32_16x16x64_i8(__builtin_bit_cast(i32x4, Bt[n][k]), __builtin_bit_cast(i32x4, At[m][k]), __builtin_bit_cast(i32x4, acc[ai][bj][m][n]), 0, 0, 0)); \
          else acc[ai][bj][m][n] = __builtin_amdgcn_mfma_f32_16x16x32_bf16(Bt[n][k], At[m][k], acc[ai][bj][m][n], 0, 0, 0); } __builtin_amdgcn_s_setprio(0); } while (0)
#define PG8_WAIT_V(n) asm volatile("s_waitcnt vmcnt(" #n ")" ::: "memory")
#define PG8_WAIT_L(n) asm volatile("s_waitcnt lgkmcnt(" #n ")" ::: "memory")
#define PG8_BAR __builtin_amdgcn_s_barrier()
#define PG8_SCHED __builtin_amdgcn_sched_barrier(0)
    Unit cur, nxt; int ui = 0;
    if (!S.next(0, cur)) return;
    if constexpr (Epi::PREFETCH) E.prefetch(lds, cur, 0, wid, lane);
    f32x4 acc[2][2][4][2];
#pragma unroll
    for (int a = 0; a < 2; ++a)
#pragma unroll
        for (int b = 0; b < 2; ++b)
#pragma unroll
            for (int m = 0; m < 4; ++m)
#pragma unroll
                for (int n = 0; n < 2; ++n) acc[a][b][m][n] = (f32x4){0.f, 0.f, 0.f, 0.f};
    bf16x8 At[4][2], B0[2][2], B1[2][2];
    const char* cA = (const char*)g.A + (size_t)cur.pm * tstep; const char* cB = (const char*)g.Bt + (size_t)cur.pn * tstep;
    S.a_ready(cur);
    if constexpr (SP2) {
        PG8_STAGE(PG8_SB(0, 0), cB, voffB); PG8_STAGE(PG8_SB(0, 1), cB + hstep, voffB); PG8_STAGE(PG8_SA(0, 0), cA, voffA); PG8_STAGE(PG8_SA(0, 1), cA + hstep, voffA);
        if (wr == 1) PG8_BAR;
        PG8_WAIT_V(2); PG8_BAR;
        PG8_STAGE(PG8_SB(1, 0), cB + kstep, voffB); PG8_STAGE(PG8_SA(1, 0), cA + kstep, voffA); PG8_STAGE(PG8_SB(1, 1), cB + hstep + kstep, voffB);
        PG8_WAIT_V(6); PG8_BAR;
    } else {
        PG8_STAGE(PG8_SB(0, 0), cB, voffB); PG8_STAGE(PG8_SA(0, 0), cA, voffA); PG8_STAGE(PG8_SB(0, 1), cB + hstep, voffB); PG8_STAGE(PG8_SA(0, 1), cA + hstep, voffA);
        if (wr == 1) PG8_BAR;
        PG8_WAIT_V(4); PG8_BAR;
        PG8_STAGE(PG8_SB(1, 0), cB + kstep, voffB); PG8_STAGE(PG8_SA(1, 0), cA + kstep, voffA); PG8_STAGE(PG8_SB(1, 1), cB + hstep + kstep, voffB);
        PG8_WAIT_V(6); PG8_BAR;
    }
    for (;;) {
        const bool has_next = S.next(ui + 1, nxt);
        const char* nA = has_next ? (const char*)g.A + (size_t)nxt.pm * tstep : cA; const char* nB = has_next ? (const char*)g.Bt + (size_t)nxt.pn * tstep : cB;
        for (int t = 0; t < nt; t += 2) {
            const bool last = (t == nt - 2);
            const char* a1 = cA + (size_t)(t + 1) * kstep;
            const char* a2 = last ? nA : cA + (size_t)(t + 2) * kstep; const char* b2 = last ? nB : cB + (size_t)(t + 2) * kstep;
            const char* a3 = a2 + kstep; const char* b3 = b2 + kstep;
            if (last && has_next) S.a_ready(nxt);
            if constexpr (SP2) {
            PG8_LDB(B0, 0, 0); PG8_LDB(B1, 0, 1); PG8_SCHED; PG8_LDA(At, 0, 0); PG8_STAGE(PG8_SA(1, 1), a1 + hstep, voffA);
            PG8_WAIT_V(8); PG8_WAIT_L(0); PG8_BAR; PG8_MMA(0, 0, At, B0); PG8_MMA(0, 1, At, B1); PG8_BAR; PG8_SCHED;
            PG8_LDA(At, 0, 1); PG8_STAGE(PG8_SB(0, 0), b2, voffB); PG8_STAGE(PG8_SB(0, 1), b2 + hstep, voffB); PG8_STAGE(PG8_SA(0, 0), a2, voffA);
            PG8_WAIT_V(8); PG8_WAIT_L(0); PG8_BAR; PG8_MMA(1, 0, At, B0); PG8_MMA(1, 1, At, B1); PG8_BAR; PG8_SCHED;
            PG8_LDB(B0, 1, 0); PG8_LDB(B1, 1, 1); PG8_SCHED; PG8_LDA(At, 1, 0); PG8_STAGE(PG8_SA(0, 1), a2 + hstep, voffA);
            PG8_WAIT_V(8); PG8_WAIT_L(0); PG8_BAR; PG8_MMA(0, 0, At, B0); PG8_MMA(0, 1, At, B1); PG8_BAR; PG8_SCHED;
            PG8_LDA(At, 1, 1); PG8_STAGE(PG8_SB(1, 0), b3, voffB); PG8_STAGE(PG8_SB(1, 1), b3 + hstep, voffB); PG8_STAGE(PG8_SA(1, 0), a3, voffA);
            PG8_WAIT_V(8); PG8_WAIT_L(0); PG8_BAR; PG8_MMA(1, 0, At, B0); PG8_MMA(1, 1, At, B1); PG8_BAR; PG8_SCHED;
            } else {
            PG8_LDB(B0, 0, 0); PG8_SCHED; PG8_LDA(At, 0, 0); PG8_STAGE(PG8_SA(1, 1), a1 + hstep, voffA);
            PG8_WAIT_L(8); PG8_BAR; PG8_WAIT_L(0); PG8_MMA(0, 0, At, B0); PG8_BAR; PG8_SCHED;
            PG8_LDB(B1, 0, 1); PG8_STAGE(PG8_SB(0, 0), b2, voffB);
            PG8_BAR; PG8_WAIT_L(0); PG8_MMA(0, 1, At, B1); PG8_BAR;
            PG8_LDA(At, 0, 1); PG8_STAGE(PG8_SA(0, 0), a2, voffA);
            PG8_BAR; PG8_WAIT_L(0); PG8_MMA(1, 0, At, B0); PG8_BAR; PG8_SCHED;
            PG8_STAGE(PG8_SB(0, 1), b2 + hstep, voffB);
            PG8_WAIT_V(6); PG8_BAR; PG8_MMA(1, 1, At, B1); PG8_BAR;
            PG8_LDB(B0, 1, 0); PG8_SCHED; PG8_LDA(At, 1, 0); PG8_STAGE(PG8_SA(0, 1), a2 + hstep, voffA);
            PG8_WAIT_L(8); PG8_BAR; PG8_WAIT_L(0); PG8_MMA(0, 0, At, B0); PG8_BAR; PG8_SCHED;
            PG8_LDB(B1, 1, 1); PG8_STAGE(PG8_SB(1, 0), b3, voffB);
            PG8_BAR; PG8_WAIT_L(0); PG8_MMA(0, 1, At, B1); PG8_BAR;
            PG8_LDA(At, 1, 1); PG8_STAGE(PG8_SA(1, 0), a3, voffA);
            PG8_BAR; PG8_WAIT_L(0); PG8_MMA(1, 0, At, B0); PG8_BAR; PG8_SCHED;
            PG8_STAGE(PG8_SB(1, 1), b3 + hstep, voffB);
            PG8_WAIT_V(6); PG8_BAR; PG8_MMA(1, 1, At, B1); PG8_BAR;
            }
        }
        if constexpr (ALIGN_EPI) { if (wr == 0) PG8_BAR; }
        if constexpr (!Epi::AFTER_DRAIN) { if constexpr (Epi::PREFETCH) E(acc, cur, wr, wc, fr, fq, lds, ui & 1); else E(acc, cur, wr, wc, fr, fq); S.done(cur); }
        if (!has_next) break;
#pragma unroll
        for (int a = 0; a < 2; ++a)
#pragma unroll
            for (int b = 0; b < 2; ++b)
#pragma unroll
                for (int m = 0; m < 4; ++m)
#pragma unroll
                    for (int n = 0; n < 2; ++n) acc[a][b][m][n] = (f32x4){0.f, 0.f, 0.f, 0.f};
        cur = nxt; cA = nA; cB = nB; ++ui;
        if constexpr (Epi::PREFETCH) E.prefetch(lds, cur, ui & 1, wid, lane);
        if constexpr (ALIGN_EPI) { if (wr == 1) PG8_BAR; }
    }
    PG8_WAIT_V(0);
    if constexpr (!ALIGN_EPI) { if (wr == 0) PG8_BAR; }
    PG8_BAR;
    if constexpr (Epi::AFTER_DRAIN) { E.fused(acc, cur, wr, wc, fr, fq, lds, wid, lane); S.done(cur); }
#undef PG8_SA
#undef PG8_SB
#undef PG8_STAGE
#undef PG8_LDA
#undef PG8_LDB
#undef PG8_MMA
#undef PG8_WAIT_V
#undef PG8_WAIT_L
#undef PG8_BAR
#undef PG8_SCHED
}
}
#define GAS __attribute__((address_space(1)))
#define LAS __attribute__((address_space(3)))
typedef unsigned short bf16;
typedef unsigned v4u __attribute__((ext_vector_type(4)));
typedef float f32x4 __attribute__((ext_vector_type(4)));
typedef short bf16x8 __attribute__((ext_vector_type(8)));
typedef GAS unsigned gu32;
typedef GAS unsigned long long gu64;
#define RLX_AGENT __ATOMIC_RELAXED, __HIP_MEMORY_SCOPE_AGENT
#define LDS_WAIT() asm volatile("s_waitcnt lgkmcnt(0)" ::: "memory")
#define VM_WAIT() asm volatile("s_waitcnt vmcnt(0)" ::: "memory")
__device__ __forceinline__ unsigned long long rt() { return __builtin_amdgcn_s_memrealtime(); }
__device__ __forceinline__ unsigned f2bf(float f) { unsigned u = __builtin_bit_cast(unsigned, f); return (u + 0x7fffu + ((u >> 16) & 1u)) >> 16; }
__device__ __forceinline__ unsigned pk2(float lo, float hi) { return f2bf(lo) | (f2bf(hi) << 16); }

#define XB_TMO      128
#define XB_XCNT(j)  (256  + 64 * (j))
#define XB_XSUB(j)  (1280 + 64 * (j))
#define XB_XGEN(j)  (2304 + 64 * (j))
#define XB_TOP      3328
#define XB_TOPGEN   3392
#define XCD_BAR_WORDS 3456
#define XB_SPIN_CAP (1u << 18)

__device__ __forceinline__ unsigned xb_ld(unsigned* p)              { return __hip_atomic_load(p, __ATOMIC_RELAXED, __HIP_MEMORY_SCOPE_AGENT); }
__device__ __forceinline__ unsigned xb_add(unsigned* p, unsigned v) { return __hip_atomic_fetch_add(p, v, __ATOMIC_RELAXED, __HIP_MEMORY_SCOPE_AGENT); }
__device__ __forceinline__ unsigned xb_xcc_id() { return (unsigned)__builtin_amdgcn_s_getreg((3 << 11) | 20) & 0xFu; }
#define XB_SPIN(cond, bar) do { unsigned _sp = 0; while (cond) { __builtin_amdgcn_s_sleep(1); \
    if ((++_sp & 255u) == 0u) { if (xb_ld(&(bar)[XB_TMO])) break; if (_sp > XB_SPIN_CAP) { atomicAdd(&(bar)[XB_TMO], 1u); break; } } } } while (0)

struct XcdBarrier {
    unsigned* bar; unsigned x;
    volatile LAS unsigned* st;
};

__device__ __forceinline__ XcdBarrier xcd_barrier_post(unsigned* bar, volatile LAS unsigned* st) {
    XcdBarrier b; b.bar = bar; b.x = xb_xcc_id(); b.st = st;
    if (threadIdx.x == 0) (void)xb_add(&bar[XB_XCNT(b.x)], 1u);
    return b;
}
__device__ __forceinline__ void xcd_barrier_complete(unsigned* bar, unsigned x, unsigned& nloc, unsigned& nx) {
    const unsigned G = gridDim.x * gridDim.y * gridDim.z;
    unsigned sum, cnt, mine, sp = 0u;
    for (;;) {
        sum = 0u; cnt = 0u; mine = 0u;
#pragma unroll
        for (unsigned j = 0; j < 16; ++j) { const unsigned c = xb_ld(&bar[XB_XCNT(j)]); sum += c; cnt += (c > 0u) ? 1u : 0u; mine = (j == x) ? c : mine; }
        if (sum == G) break;
        __builtin_amdgcn_s_sleep(1);
        if ((++sp & 255u) == 0u) { if (xb_ld(&bar[XB_TMO])) break; if (sp > XB_SPIN_CAP) { atomicAdd(&bar[XB_TMO], 1u); break; } }
    }
    nloc = mine > 0u ? mine : 1u; nx = cnt > 0u ? cnt : 1u;
}

__device__ __forceinline__ void xcd_barrier(const XcdBarrier& b) {
    asm volatile("s_waitcnt vmcnt(0)" ::: "memory");
    __syncthreads();
    if (threadIdx.x == 0) {
        unsigned* bar = b.bar;
        __builtin_amdgcn_s_waitcnt(0);
        unsigned nloc = b.st[0], nx = b.st[1];
        if (nloc == 0u) { xcd_barrier_complete(bar, b.x, nloc, nx); b.st[0] = nloc; b.st[1] = nx; }
        const unsigned old = xb_add(&bar[XB_XSUB(b.x)], 1u);
        const unsigned gen = old / nloc;
        if (old + 1u == (gen + 1u) * nloc) {
            __builtin_amdgcn_fence(__ATOMIC_RELEASE, "agent");
            asm volatile("s_waitcnt vmcnt(0)" ::: "memory");
            const unsigned og = xb_add(&bar[XB_TOP], 1u);
            const unsigned tg = og / nx;
            if (og + 1u == (tg + 1u) * nx) xb_add(&bar[XB_TOPGEN], 1u);
            else XB_SPIN(xb_ld(&bar[XB_TOPGEN]) == tg, bar);
            __builtin_amdgcn_fence(__ATOMIC_ACQUIRE, "agent");
            xb_add(&bar[XB_XGEN(b.x)], 1u);
            asm volatile("s_waitcnt vmcnt(0)" ::: "memory");
        } else {
            XB_SPIN(xb_ld(&bar[XB_XGEN(b.x)]) == gen, bar);
            __builtin_amdgcn_fence(__ATOMIC_ACQUIRE, "agent");
            asm volatile("s_waitcnt vmcnt(0)" ::: "memory");
        }
    }
    __syncthreads();
}


#ifndef G1_I8
#define G1_I8 1
#endif
#ifndef I8_MASK
#define I8_MASK 0x3FEu
#endif
#ifndef G1_WGMQ
#define G1_WGMQ 5
#endif
#ifndef G1_BAL
#define G1_BAL 0
#endif
#ifndef G1Q_ALIGN
#define G1Q_ALIGN true
#endif
#ifndef G1Q_SP2
#define G1Q_SP2 true
#endif
#ifndef G1_STAGGER
#define G1_STAGGER 0
#endif
#define I8_TILE(pn) ((pn) < 80 && ((I8_MASK >> ((pn) >> 3)) & 1u))
#define I8_NT (8 * __builtin_popcount(I8_MASK))
constexpr int NWAVES = 8;
constexpr int DM = 2048, NBATCH = 2, SEQ = 16384, CTXL = 256, DEPTH = 4;
constexpr int MLAT = NBATCH * SEQ, MCTX = NBATCH * CTXL, MALL = MLAT + MCTX;
constexpr int NIN = 20512, NP = 20608, NPAD = 20736;
constexpr int OFF_AQ = 0, OFF_AK = 1024, OFF_AV = 2048, OFF_AO = 4096, OFF_AZ = 6144, OFF_BQ = 8192, OFF_BK = 10240, OFF_BV = 12288, OFF_BZ = 14336, OFF_GA = 16384, OFF_GB = 18432;
constexpr float EPS = 1e-6f;
static_assert(MALL % 256 == 0 && NPAD % 256 == 0 && pg8::E_MLAT == MLAT && pg8::E_NP == NP, "shapes");

constexpr size_t MiB = 1u << 20;
constexpr size_t WS_CTL = 0, CTL_ZERO_BYTES = 1 * MiB;
constexpr size_t WS_MOD = 1 * MiB;
constexpr size_t WS_ROPE = 1 * MiB + 512 * 1024;
constexpr size_t WS_XC = 2 * MiB;
constexpr size_t WS_G = 6 * MiB;
constexpr size_t WS_SSQ = 11 * MiB;
constexpr size_t WS_STC = 28 * MiB;
constexpr size_t WS_STN = 64 * MiB;
constexpr size_t WS_STS = 64 * MiB + 256 * 1024;
constexpr size_t WS_WIN = 65 * MiB;
constexpr size_t WS_WAB = 389 * MiB;
constexpr size_t WS_WO = 453 * MiB;
constexpr size_t WS_H = 485 * MiB;
constexpr size_t WS_YB = 615 * MiB;
constexpr size_t WS_HF = 745 * MiB;
constexpr size_t WS_HB = 875 * MiB;
constexpr size_t WS_P = 1005 * MiB;
constexpr size_t WS_PART = 2320 * MiB;
constexpr size_t WS_WQ = 2336 * MiB;
constexpr size_t WS_CS = 2498 * MiB;
constexpr size_t WS_RS = 2498 * MiB + 512 * 1024;
constexpr size_t WS_HQ = WS_YB;
constexpr size_t WS_PB = 2498 * MiB + 768 * 1024;
constexpr size_t WS_END = 2500 * MiB;
static_assert(WS_WQ + (size_t)4 * NPAD * 2048 <= WS_CS && WS_CS + (size_t)4 * NPAD * 4 <= WS_RS && WS_RS + (size_t)MALL * 4 <= WS_PB && WS_PB + (size_t)4 * NPAD * 4 <= WS_END, "ws map 3");
static_assert(WS_G + (size_t)MALL * 32 * 4 <= WS_SSQ && WS_SSQ + (size_t)2 * MALL * 64 * 4 <= WS_STC && WS_STC + (size_t)288 * 131072 <= WS_STN, "ws map 1");
static_assert(WS_WIN + (size_t)4 * NPAD * 2048 * 2 <= WS_WAB && WS_H + (size_t)MALL * 2048 * 2 <= WS_YB && WS_P + (size_t)MALL * NP * 2 <= WS_END, "ws map 2");
constexpr int CW_BAR = 4096;

constexpr int RING_BYTES = 131072;
constexpr int MISC_OFF = RING_BYTES + 320;
constexpr int LDS_BYTES = 147456;

typedef short s16x4 __attribute__((ext_vector_type(4)));
typedef float f32x16 __attribute__((ext_vector_type(16)));
typedef unsigned v2u __attribute__((ext_vector_type(2)));
typedef float f32x2 __attribute__((ext_vector_type(2)));
typedef __bf16 bf16x2_t __attribute__((ext_vector_type(2)));
__device__ __forceinline__ unsigned pkh(float lo, float hi) { f32x2 v = {lo, hi}; bf16x2_t b = __builtin_convertvector(v, bf16x2_t); return __builtin_bit_cast(unsigned, b); }
#define MFMA32(a, b, c) __builtin_amdgcn_mfma_f32_32x32x16_bf16((a), (b), (c), 0, 0, 0)
#define MFMA16(a, b, c) __builtin_amdgcn_mfma_f32_16x16x32_bf16((a), (b), (c), 0, 0, 0)

__device__ __forceinline__ float bf2f(unsigned short x) { return __builtin_bit_cast(float, (unsigned)x << 16); }
__device__ __forceinline__ float bflo(unsigned w) { return __builtin_bit_cast(float, w << 16); }
__device__ __forceinline__ float bfhi(unsigned w) { return __builtin_bit_cast(float, w & 0xffff0000u); }
__device__ __forceinline__ float sigm(float x) { return __builtin_amdgcn_rcpf(1.0f + __builtin_amdgcn_exp2f(-1.4426950408889634f * x)); }
__device__ __forceinline__ float silu(float x) { return x * __builtin_amdgcn_rcpf(1.0f + __builtin_amdgcn_exp2f(-1.4426950408889634f * x)); }
__device__ __forceinline__ int crow(int reg, int h) { return (reg & 3) + 8 * (reg >> 2) + 4 * h; }
__device__ __forceinline__ float shx(float v, int mask, int lane) { return __builtin_bit_cast(float, __builtin_amdgcn_ds_bpermute((lane ^ mask) << 2, __builtin_bit_cast(int, v))); }
__device__ __forceinline__ float shi(float v, int src, int lane) { (void)lane; return __builtin_bit_cast(float, __builtin_amdgcn_ds_bpermute(src << 2, __builtin_bit_cast(int, v))); }
__device__ __forceinline__ float shup(float v, int d, int lane) { return __builtin_bit_cast(float, __builtin_amdgcn_ds_bpermute((lane >= d ? lane - d : lane) << 2, __builtin_bit_cast(int, v))); }
__device__ __forceinline__ float wave_sum(float v, int lane) {
#pragma unroll
    for (int o = 1; o < 64; o <<= 1) v += shx(v, o, lane);
    return v;
}
__device__ __forceinline__ s16x4 tr_read(const LAS unsigned char* p) { return __builtin_bit_cast(s16x4, __builtin_amdgcn_ds_read_tr16_b64_v4i16((LAS s16x4*)p)); }
__device__ __forceinline__ bf16x8 cat8(s16x4 lo, s16x4 hi) { return __builtin_shufflevector(lo, hi, 0, 1, 2, 3, 4, 5, 6, 7); }
__device__ __forceinline__ int fresh_lane() { int l; asm volatile("v_mbcnt_lo_u32_b32 %0, -1, 0\n\tv_mbcnt_hi_u32_b32 %0, -1, %0" : "=v"(l)); return l; }
#define LBAR() asm volatile("s_waitcnt lgkmcnt(0)\n\ts_barrier" ::: "memory")
__device__ __forceinline__ void pair_swap(v2u& a, v2u& b) {
    auto r0 = __builtin_amdgcn_permlane32_swap(a.x, b.x, false, false); a.x = r0[0]; b.x = r0[1];
    auto r1 = __builtin_amdgcn_permlane32_swap(a.y, b.y, false, false); a.y = r1[0]; b.y = r1[1];
}
__device__ __forceinline__ int clampi(int v, int lo, int hi) { return v < lo ? lo : (v > hi ? hi : v); }

struct Args { const float* in[17]; float* out; unsigned char* ws; int ph_lo, ph_hi; };

__device__ __forceinline__ void transpose_item(const float* W, int K, int N, bf16* WT, int dst_row0, int rstride, int k0, int n0, LAS float* scr, int lane) {
    { f32x4 v[8];
#pragma unroll
        for (int i = 0; i < 8; ++i) v[i] = *(const GAS f32x4*)(W + (size_t)(k0 + 8 * i + (lane >> 3)) * N + n0 + 4 * (lane & 7));
#pragma unroll
        for (int i = 0; i < 8; ++i) { LAS float* d = scr + (8 * i + (lane >> 3)) * 33 + 4 * (lane & 7); d[0] = v[i].x; d[1] = v[i].y; d[2] = v[i].z; d[3] = v[i].w; } }
    LDS_WAIT(); asm volatile("" ::: "memory");
    const int c = lane & 7;
#pragma unroll
    for (int j = 0; j < 4; ++j) { const int n = (lane >> 3) + 8 * j; const LAS float* s = scr + (8 * c) * 33 + n;
        v4u o; o.x = pkh(s[0 * 33], s[1 * 33]); o.y = pkh(s[2 * 33], s[3 * 33]); o.z = pkh(s[4 * 33], s[5 * 33]); o.w = pkh(s[6 * 33], s[7 * 33]);
        *(GAS v4u*)(WT + (size_t)(dst_row0 + n * rstride) * K + k0 + 8 * c) = o; }
    LDS_WAIT(); asm volatile("" ::: "memory");
}

__constant__ float ROPE_INV[32] = {
1.000000000e+00f, 7.498942614e-01f, 5.623413324e-01f, 4.216965139e-01f, 3.162277639e-01f, 2.371373773e-01f, 1.778279394e-01f, 1.333521307e-01f, 1.000000015e-01f, 7.498941571e-02f, 5.623413250e-02f, 4.216965288e-02f, 3.162277490e-02f, 2.371373773e-02f, 1.778279431e-02f, 1.333521493e-02f, 9.999999776e-03f, 7.498941850e-03f, 5.623413250e-03f, 4.216964822e-03f, 3.162277630e-03f, 2.371373586e-03f, 1.778279431e-03f, 1.333521446e-03f, 1.000000047e-03f, 7.498942432e-04f, 5.623413017e-04f, 4.216965172e-04f, 3.162277571e-04f, 2.371373703e-04f, 1.778279402e-04f, 1.333521504e-04f
};

__device__ __forceinline__ float wave_max(float v, int lane) {
#pragma unroll
    for (int o = 1; o < 64; o <<= 1) v = fmaxf(v, shx(v, o, lane));
    return v;
}
__device__ __forceinline__ unsigned pack_i8(float a, float b, float c, float d) {
    const unsigned ua = __builtin_bit_cast(unsigned, a + 12582912.0f), ub = __builtin_bit_cast(unsigned, b + 12582912.0f), uc = __builtin_bit_cast(unsigned, c + 12582912.0f), ud = __builtin_bit_cast(unsigned, d + 12582912.0f);
    return (ua & 0xffu) | ((ub & 0xffu) << 8) | ((uc & 0xffu) << 16) | (ud << 24);
}
constexpr int SLAB_RS = 4104, SLAB_WMAX = 132096, SLAB_SLOT = 133120, CW_SLAB = 64;
__device__ __forceinline__ void win_slab_item(const Args& a, LAS unsigned char* lds, int l, int nb, int tid, int lane, int wave) {
    unsigned char* ws = a.ws;
    const float* W = a.in[7] + (size_t)l * 2048 * NIN + 32 * nb;
    LAS float* wmax = (LAS float*)(lds + SLAB_WMAX);
    const int cg = tid & 7, kr2 = tid >> 3;
    f32x4 mxv = {0.f, 0.f, 0.f, 0.f};
    for (int s0 = 0; s0 < 16; s0 += 8) {
        f32x4 v0[8], v1[8];
#pragma unroll
        for (int s = 0; s < 8; ++s) { const int k = 2 * kr2 + 128 * (s0 + s); v0[s] = *(const GAS f32x4*)(W + (size_t)k * NIN + 4 * cg); v1[s] = *(const GAS f32x4*)(W + (size_t)(k + 1) * NIN + 4 * cg); }
#pragma unroll
        for (int s = 0; s < 8; ++s) { const int k = 2 * kr2 + 128 * (s0 + s);
            LAS unsigned char* d = lds + (4 * cg) * SLAB_RS + 2 * k;
            const unsigned p0 = pkh(v0[s].x, v1[s].x), p1 = pkh(v0[s].y, v1[s].y), p2 = pkh(v0[s].z, v1[s].z), p3 = pkh(v0[s].w, v1[s].w);
            *(LAS unsigned*)(d) = p0; *(LAS unsigned*)(d + SLAB_RS) = p1; *(LAS unsigned*)(d + 2 * SLAB_RS) = p2; *(LAS unsigned*)(d + 3 * SLAB_RS) = p3;
            mxv.x = fmaxf(mxv.x, fmaxf(__builtin_fabsf(bflo(p0)), __builtin_fabsf(bfhi(p0)))); mxv.y = fmaxf(mxv.y, fmaxf(__builtin_fabsf(bflo(p1)), __builtin_fabsf(bfhi(p1))));
            mxv.z = fmaxf(mxv.z, fmaxf(__builtin_fabsf(bflo(p2)), __builtin_fabsf(bfhi(p2)))); mxv.w = fmaxf(mxv.w, fmaxf(__builtin_fabsf(bflo(p3)), __builtin_fabsf(bfhi(p3)))); }
    }
#pragma unroll
    for (int o = 8; o < 64; o <<= 1) { mxv.x = fmaxf(mxv.x, shx(mxv.x, o, lane)); mxv.y = fmaxf(mxv.y, shx(mxv.y, o, lane)); mxv.z = fmaxf(mxv.z, shx(mxv.z, o, lane)); mxv.w = fmaxf(mxv.w, shx(mxv.w, o, lane)); }
    if (lane < 8) *(LAS f32x4*)(wmax + wave * 32 + 4 * lane) = mxv;
    __syncthreads();
    int dst = nb < 256 ? 32 * nb : (nb == 256 ? 20480 : 32 * nb - 32), rstr = 1;
    if (nb < 64) { const int n0 = 32 * nb, w0 = n0 & 127; dst = (n0 & ~127) + 64 * (w0 >> 6) + ((w0 >> 5) & 1); rstr = 2; }
    else if (nb >= 128 && nb < 192) { dst = 4096 + 2 * (32 * nb - 4096); rstr = 2; }
    else if (nb >= 192 && nb < 256) { dst = 4096 + 2 * (32 * nb - 6144) + 1; rstr = 2; }
#pragma unroll 1
    for (int cc = 0; cc < 4; ++cc) { const int col = 4 * wave + cc, drow = dst + col * rstr;
        float mx = 0.f;
#pragma unroll
        for (int w = 0; w < 8; ++w) mx = fmaxf(mx, wmax[w * 32 + col]);
        const LAS unsigned char* src = lds + col * SLAB_RS + 8 * lane;
        v2u p[8];
#pragma unroll
        for (int i = 0; i < 8; ++i) p[i] = *(const LAS v2u*)(src + 512 * i);
        if (lane == 0) ((float*)(ws + WS_PB))[(size_t)l * NPAD + drow] = a.in[8][(size_t)l * NIN + 32 * nb + col];
        if (I8_TILE(drow >> 8)) {
            mx = fmaxf(mx, 1e-30f); const float inv = 127.0f * __builtin_amdgcn_rcpf(mx);
            GAS unsigned* o = (GAS unsigned*)(ws + WS_WQ + ((size_t)l * NPAD + drow) * 2048) + lane;
#pragma unroll
            for (int i = 0; i < 8; ++i) o[64 * i] = pack_i8(bflo(p[i].x) * inv, bfhi(p[i].x) * inv, bflo(p[i].y) * inv, bfhi(p[i].y) * inv);
            if (lane == 0) ((float*)(ws + WS_CS))[(size_t)l * NPAD + drow] = mx * (1.0f / 127.0f);
        } else {
            GAS v2u* o = (GAS v2u*)(ws + WS_WIN + ((size_t)l * NPAD + drow) * 4096) + lane;
#pragma unroll
            for (int i = 0; i < 8; ++i) o[64 * i] = p[i];
        }
    }
}

__device__ __forceinline__ void prologue(const Args& a, LAS unsigned char* lds, int tid, int lane, int wave, int rep = 0) {
    unsigned char* ws = a.ws;
    const int G = gridDim.x, bx = blockIdx.x;
    {
        const float* c = a.in[1]; const float* cctx = a.in[3]; const float* wmod = a.in[4]; const float* bmod = a.in[5];
        float* MOD = (float*)(ws + WS_MOD);
        LAS float* red = (LAS float*)lds;
        for (int uu = bx; uu < 96; uu += G) {
            const int l = uu / 24, nc = uu % 24;
            f32x4 a0 = {0.f, 0.f, 0.f, 0.f}, a1 = a0, a2 = a0;
            const float* wp = wmod + ((size_t)l * 2048 + wave * 256) * 6144 + nc * 256 + 4 * lane;
#pragma unroll 16
            for (int k = 0; k < 256; ++k) { const int kk = wave * 256 + k;
                const f32x4 wv = *(const f32x4*)(wp + (size_t)k * 6144);
                const float s0 = silu(c[kk]), s1 = silu(c[2048 + kk]), s2 = silu(cctx[kk]);
                a0 += wv * s0; a1 += wv * s1; a2 += wv * s2; }
            *(LAS f32x4*)(red + (wave * 3 + 0) * 256 + 4 * lane) = a0; *(LAS f32x4*)(red + (wave * 3 + 1) * 256 + 4 * lane) = a1; *(LAS f32x4*)(red + (wave * 3 + 2) * 256 + 4 * lane) = a2;
            __syncthreads();
            for (int o = tid; o < 768; o += 512) { const int j = o >> 8, ci = o & 255; float s = 0.f;
#pragma unroll
                for (int w = 0; w < 8; ++w) s += red[(w * 3 + j) * 256 + ci];
                MOD[(size_t)(l * 3 + j) * 6144 + nc * 256 + ci] = s + bmod[(size_t)l * 6144 + nc * 256 + ci]; }
            __syncthreads();
        }
    }
    {
        float* ROPE = (float*)(ws + WS_ROPE);
        const int gid = bx * 512 + tid;
        if (gid < 8192) { const int pos = gid >> 5, i = gid & 31;
            const float ang = (float)pos * ROPE_INV[i]; const double x = (double)ang;
            const double kq = __builtin_rint(x * 0.63661977236758134308); double r = __builtin_fma(-kq, 1.57079632679489655800, x); r = __builtin_fma(-kq, 6.12323399573676603587e-17, r);
            const int q = ((int)kq) & 3; const double r2 = r * r;
            const double sn = r * (1.0 + r2 * (-1.0 / 6 + r2 * (1.0 / 120 + r2 * (-1.0 / 5040 + r2 * (1.0 / 362880 + r2 * (-1.0 / 39916800 + r2 * (1.0 / 6227020800.0)))))));
            const double cs = 1.0 + r2 * (-0.5 + r2 * (1.0 / 24 + r2 * (-1.0 / 720 + r2 * (1.0 / 40320 + r2 * (-1.0 / 3628800 + r2 * (1.0 / 479001600.0 + r2 * (-1.0 / 87178291200.0)))))));
            const double co = q == 0 ? cs : (q == 1 ? -sn : (q == 2 ? -cs : sn)); const double si = q == 0 ? sn : (q == 1 ? cs : (q == 2 ? -sn : -cs));
            ROPE[gid * 2] = (float)co; ROPE[gid * 2 + 1] = (float)si; }
    }
    {
        LAS float* scr = (LAS float*)(lds + wave * 8448);
        const int gw = bx * NWAVES + wave, NGW = G * NWAVES;
        constexpr int I_SQ = 32 * 64;
        for (int r0 = gw; r0 < 12 * I_SQ; r0 += NGW) {
            const int mat = r0 / (4 * I_SQ), r1 = r0 % (4 * I_SQ), l = r1 / I_SQ, r = r1 % I_SQ, kb = r / 64, nb = r % 64;
            const float* src = (mat == 0 ? a.in[10] : (mat == 1 ? a.in[11] : a.in[15])) + (size_t)l * 2048 * 2048;
            bf16* dstp = mat == 2 ? (bf16*)(ws + WS_WO) + (size_t)l * 2048 * 2048 : (bf16*)(ws + WS_WAB) + ((size_t)l * 2 + mat) * 2048 * 2048;
            transpose_item(src, 2048, 2048, dstp, 32 * nb, 1, 64 * kb, 32 * nb, scr, lane);
        }
        const int gt = bx * 512 + tid, NGT = G * 512;
        for (int p = gt; p < 4 * 57344; p += NGT) { const int l = p / 57344, q = p % 57344;
            *(GAS v4u*)((unsigned char*)(ws + WS_WIN) + ((size_t)l * NPAD + 20512) * 4096 + (size_t)q * 16) = (v4u){0u, 0u, 0u, 0u}; }
    }
    {
        volatile LAS int* slot = (volatile LAS int*)(lds + SLAB_SLOT);
        for (;;) {
            __syncthreads();
            if (tid == 0) *slot = (int)__hip_atomic_fetch_add((unsigned*)(ws + WS_CTL) + CW_SLAB + rep, 1u, __ATOMIC_RELAXED, __HIP_MEMORY_SCOPE_AGENT);
            __syncthreads();
            const int it = __builtin_amdgcn_readfirstlane(*slot);
            if (it >= 4 * 641) break;
            win_slab_item(a, lds, it / 641, it % 641, tid, lane, wave);
        }
    }
}

__device__ __forceinline__ void wquant_rows(unsigned char* ws, int lane, int wave) {
    const int gw = blockIdx.x * NWAVES + wave, NGW = gridDim.x * NWAVES;
    for (int r = gw; r < 4 * NPAD; r += NGW) {
        { const int pn = (r % NPAD) >> 8; if (!I8_TILE(pn)) continue; }
        const GAS v4u* src = (const GAS v4u*)(ws + WS_WIN + (size_t)r * 4096) + lane;
        v4u p[4];
#pragma unroll
        for (int i = 0; i < 4; ++i) p[i] = src[64 * i];
        float mx = 0.f;
#pragma unroll
        for (int i = 0; i < 4; ++i) { mx = fmaxf(mx, fmaxf(fmaxf(__builtin_fabsf(bflo(p[i].x)), __builtin_fabsf(bfhi(p[i].x))), fmaxf(__builtin_fabsf(bflo(p[i].y)), __builtin_fabsf(bfhi(p[i].y)))));
            mx = fmaxf(mx, fmaxf(fmaxf(__builtin_fabsf(bflo(p[i].z)), __builtin_fabsf(bfhi(p[i].z))), fmaxf(__builtin_fabsf(bflo(p[i].w)), __builtin_fabsf(bfhi(p[i].w))))); }
        mx = fmaxf(wave_max(mx, lane), 1e-30f);
        const float inv = 127.0f * __builtin_amdgcn_rcpf(mx);
        GAS v2u* dst = (GAS v2u*)(ws + WS_WQ + (size_t)r * 2048) + lane;
#pragma unroll
        for (int i = 0; i < 4; ++i) { v2u o; o.x = pack_i8(bflo(p[i].x) * inv, bfhi(p[i].x) * inv, bflo(p[i].y) * inv, bfhi(p[i].y) * inv); o.y = pack_i8(bflo(p[i].z) * inv, bfhi(p[i].z) * inv, bflo(p[i].w) * inv, bfhi(p[i].w) * inv);
            dst[64 * i] = o; }
        if (lane == 0) ((float*)(ws + WS_CS))[r] = mx * (1.0f / 127.0f);
    }
}

__device__ __forceinline__ void norm_phase(const Args& a, LAS unsigned char* lds, int l, int tid, int lane, int wave) {
    unsigned char* ws = a.ws;
    const float* MOD = (const float*)(ws + WS_MOD) + (size_t)l * 3 * 6144;
    const float* g = a.in[6] + (size_t)l * 2048;
    LAS float* Al = (LAS float*)lds; LAS float* Sl = Al + 3 * 2048;
    for (int idx = tid; idx < 3 * 2048; idx += 512) { const int j = idx >> 11, col = idx & 2047;
        Al[idx] = g[col] * (1.0f + MOD[j * 6144 + 2048 + col]); Sl[idx] = MOD[j * 6144 + col]; }
    __syncthreads();
    const float* xlat = l == 0 ? a.in[0] : a.out; const float* xctx = l <= 1 ? a.in[2] : (const float*)(ws + WS_XC);
    bf16* H = (bf16*)(ws + WS_H);
    const int gw = blockIdx.x * NWAVES + wave, NGW = gridDim.x * NWAVES;
    f32x4 vn[8];
#define NORM_LOAD(row_, dst) do { const bool lat_ = (row_) < MLAT; const float* xr_ = lat_ ? xlat + (size_t)(row_) * 2048 : xctx + (size_t)((row_) - MLAT) * 2048; \
        _Pragma("unroll") for (int jj = 0; jj < 8; ++jj) dst[jj] = *(const GAS f32x4*)(xr_ + 4 * lane + 256 * jj); } while (0)
    if (gw < MALL) NORM_LOAD(gw, vn);
    for (int row = gw; row < MALL; row += NGW) {
        const bool lat = row < MLAT; const int j = lat ? (row >> 14) : 2;
        f32x4 v[8]; float ss = 0.f;
#pragma unroll
        for (int jj = 0; jj < 8; ++jj) v[jj] = vn[jj];
        if (row + NGW < MALL) NORM_LOAD(row + NGW, vn);
        if (!lat && l > 0) {
            const float* part = (const float*)(ws + WS_PART) + (size_t)(row - MLAT) * 2048; const float* gt = (const float*)(ws + WS_MOD) + (size_t)(l - 1) * 3 * 6144 + 2 * 6144 + 4096; const float* bo = a.in[16] + (size_t)(l - 1) * 2048;
            float* xw = (float*)(ws + WS_XC) + (size_t)(row - MLAT) * 2048;
#pragma unroll
            for (int jj = 0; jj < 8; ++jj) { const int col = 4 * lane + 256 * jj;
                const f32x4 p0 = *(const GAS f32x4*)(part + col), p1 = *(const GAS f32x4*)(part + (size_t)512 * 2048 + col), p2 = *(const GAS f32x4*)(part + (size_t)2 * 512 * 2048 + col), p3 = *(const GAS f32x4*)(part + (size_t)3 * 512 * 2048 + col);
                v[jj] = v[jj] + *(const GAS f32x4*)(gt + col) * (((p0 + p1) + (p2 + p3)) + *(const GAS f32x4*)(bo + col));
                *(GAS f32x4*)(xw + col) = v[jj]; }
        }
#pragma unroll
        for (int jj = 0; jj < 8; ++jj) ss += (v[jj].x * v[jj].x + v[jj].y * v[jj].y) + (v[jj].z * v[jj].z + v[jj].w * v[jj].w);
        const float rstd = __builtin_amdgcn_rsqf(wave_sum(ss, lane) * (1.0f / 2048.0f) + EPS);
#if G1_I8
        float mx = 0.f;
        GAS unsigned long long* o8 = (GAS unsigned long long*)(H + (size_t)row * 2048) + lane;
#pragma unroll
        for (int jj = 0; jj < 8; ++jj) { const f32x4 av = *(LAS f32x4*)(Al + j * 2048 + 4 * lane + 256 * jj), sv = *(LAS f32x4*)(Sl + j * 2048 + 4 * lane + 256 * jj);
            v[jj] = v[jj] * rstd * av + sv;
            o8[64 * jj] = (unsigned long long)pkh(v[jj].x, v[jj].y) | ((unsigned long long)pkh(v[jj].z, v[jj].w) << 32);
            mx = fmaxf(mx, fmaxf(fmaxf(__builtin_fabsf(v[jj].x), __builtin_fabsf(v[jj].y)), fmaxf(__builtin_fabsf(v[jj].z), __builtin_fabsf(v[jj].w)))); }
        mx = fmaxf(wave_max(mx, lane), 1e-30f);
        const float inv = 127.0f * __builtin_amdgcn_rcpf(mx);
        GAS unsigned* o4 = (GAS unsigned*)(ws + WS_HQ + (size_t)row * 2048) + lane;
#pragma unroll
        for (int jj = 0; jj < 8; ++jj) o4[64 * jj] = pack_i8(v[jj].x * inv, v[jj].y * inv, v[jj].z * inv, v[jj].w * inv);
        if (lane == 0) ((float*)(ws + WS_RS))[row] = mx * (1.0f / 127.0f);
#else
        GAS unsigned long long* o8 = (GAS unsigned long long*)(H + (size_t)row * 2048) + lane;
#pragma unroll
        for (int jj = 0; jj < 8; ++jj) { const f32x4 av = *(LAS f32x4*)(Al + j * 2048 + 4 * lane + 256 * jj), sv = *(LAS f32x4*)(Sl + j * 2048 + 4 * lane + 256 * jj);
            const f32x4 o = v[jj] * rstd * av + sv;
            o8[64 * jj] = (unsigned long long)pkh(o.x, o.y) | ((unsigned long long)pkh(o.z, o.w) << 32); }
#endif
    }
#undef NORM_LOAD
    __syncthreads();
}

constexpr int ML_KT = 0, ML_QT = 17408, ML_KW = 34816, ML_VT = 55296, ML_PT = 92160, ML_SC = 101376;
constexpr int KT_STR = 272, KW_STR = 320, VT_STR = 576, PT_STR = 144;
constexpr int SC_U = 0, SC_MJ = 256, SC_WI = 512, SC_TH = 768, SC_NQ = 1024, SC_N = 1280;
constexpr int GS_BS = 103680, GS_U = 111872, GS_CM = 120064, GS_G = 128256;
__device__ __forceinline__ v4u scale_bf8(v4u x, float s) {
    v4u o; o.x = pkh(bflo(x.x) * s, bfhi(x.x) * s); o.y = pkh(bflo(x.y) * s, bfhi(x.y) * s); o.z = pkh(bflo(x.z) * s, bfhi(x.z) * s); o.w = pkh(bflo(x.w) * s, bfhi(x.w) * s); return o;
}
__device__ __forceinline__ bf16x8 pack_acc8(const f32x16& x, int s) {
    v4u p; p.x = pkh(x[8 * s + 0], x[8 * s + 1]); p.y = pkh(x[8 * s + 2], x[8 * s + 3]); p.z = pkh(x[8 * s + 4], x[8 * s + 5]); p.w = pkh(x[8 * s + 6], x[8 * s + 7]);
    return __builtin_bit_cast(bf16x8, p);
}

__device__ __forceinline__ int ml_chunk_base(int seg, int dir, int b, int ci) {
    if (seg == 0) { const int c = dir ? 3 - ci : ci; return MLAT + b * 256 + 64 * c; }
    const int cc = 32 * (seg - 1) + ci; const int c = dir ? 255 - cc : cc; return b * 16384 + 64 * c;
}
template <bool with_out, bool init_comb>
__device__ __forceinline__ void mlstm_unit(const Args& a, LAS unsigned char* lds, int b, int h, int dir, int seg, int tid_, int lane_, int wave) {
    const int lane = fresh_lane(), tid = wave * 64 + lane;
    unsigned char* ws = a.ws;
    const bf16* P = (const bf16*)(ws + WS_P); const float* Gt = (const float*)(ws + WS_G);
    bf16* HOUT = (bf16*)(ws + (dir ? WS_HB : WS_HF));
    float* STC = (float*)(ws + WS_STC); float* STN = (float*)(ws + WS_STN); float* STS = (float*)(ws + WS_STS);
    const int r = lane & 31, hh = lane >> 5, q4 = (lane & 15) >> 2, p4 = lane & 3, blk = (lane >> 4) & 1;
    const int sidx0 = ((b * 8 + h) * 2 + dir) * 9, sidx = sidx0 + seg;
    LAS float* nl = (LAS float*)(lds + ML_SC + SC_N);
    f32x16 C[4];
#pragma unroll
    for (int i = 0; i < 4; ++i)
#pragma unroll
        for (int e = 0; e < 16; ++e) C[i][e] = 0.f;
    float m = -1e30f, Ftot = 0.f; int nb = 0;
    __syncthreads();
    if (!init_comb) { if (tid < 128) nl[tid] = 0.f; }
    else {
        float run = 0.f, m_in = -3e38f;
        for (int k = seg - 1; k >= 0; --k) { const float mk = STS[(sidx0 + k) * 4], fk = STS[(sidx0 + k) * 4 + 1]; m_in = fmaxf(m_in, mk + run); run += fk; }
        run = 0.f; float nacc = 0.f;
        for (int k = seg - 1; k >= 0; --k) { const float mk = STS[(sidx0 + k) * 4], fk = STS[(sidx0 + k) * 4 + 1]; const float cf = __expf(mk + run - m_in); run += fk;
            const f32x4* src = (const f32x4*)(STC + (size_t)(sidx0 + k) * 32768) + tid;
#pragma unroll
            for (int i = 0; i < 4; ++i)
#pragma unroll
                for (int g4 = 0; g4 < 4; ++g4) { const f32x4 v = src[(4 * i + g4) * 512];
                    C[i][4 * g4 + 0] += cf * v.x; C[i][4 * g4 + 1] += cf * v.y; C[i][4 * g4 + 2] += cf * v.z; C[i][4 * g4 + 3] += cf * v.w; }
            if (tid < 128) nacc += cf * STN[(sidx0 + k) * 128 + tid];
        }
        if (tid < 128) nl[tid] = nacc;
        m = m_in;
    }
    const int nch = seg == 0 ? 4 : 32;
    {
        const int lrow_g = dir ? 63 - lane : lane; const int off_g = lrow_g * 32 + 16 * dir + h;
        float gi4[4], gf4[4];
#pragma unroll
        for (int q = 0; q < 4; ++q) { const int cj = wave + 8 * q; gi4[q] = 0.f; gf4[q] = 0.f;
            if (cj < nch) { const float* gb_ = Gt + (size_t)ml_chunk_base(seg, dir, b, cj) * 32; gi4[q] = gb_[off_g]; gf4[q] = gb_[off_g + 8]; } }
#pragma unroll
        for (int q = 0; q < 4; ++q) { const int cj = wave + 8 * q;
            if (cj < nch) { const float gi = gi4[q], gf = gf4[q];
            const float logf = fminf(gf, 0.f) - log1pf(__expf(-fabsf(gf)));
            float bs = logf;
#pragma unroll
            for (int o = 1; o < 64; o <<= 1) { const float t = shup(bs, o, lane); if (lane >= o) bs += t; }
            const float u = gi - bs; float cm = u;
#pragma unroll
            for (int o = 1; o < 64; o <<= 1) { const float t = shup(cm, o, lane); if (lane >= o) cm = fmaxf(cm, t); }
            *(LAS float*)(lds + GS_BS + (cj * 64 + lane) * 4) = bs; *(LAS float*)(lds + GS_U + (cj * 64 + lane) * 4) = u; *(LAS float*)(lds + GS_CM + (cj * 64 + lane) * 4) = cm;
            if (lane == 63) { *(LAS float*)(lds + GS_G + cj * 4) = bs; *(LAS float*)(lds + GS_G + 128 + cj * 4) = cm; } } }
    }
    v4u kreg[2], qreg[2], vreg[4];
    const int lrow_kq = dir ? 63 - (tid >> 4) : (tid >> 4), lrow_v = dir ? 63 - (tid >> 5) : (tid >> 5);
    const int off_kq = lrow_kq * NP + 8 * (tid & 15), off_v = lrow_v * NP + 8 * (tid & 31);
    const int step_kq = (dir ? -32 : 32) * NP, step_v = (dir ? -16 : 16) * NP;
#define ML_PREFETCH_Q(ci) do { const int base_ = ml_chunk_base(seg, dir, b, ci); const bf16* pb_ = P + (size_t)base_ * NP; \
        if (with_out) { _Pragma("unroll") for (int i = 0; i < 2; ++i) qreg[i] = *(const GAS v4u*)(pb_ + (OFF_AQ + h * 128 + i * step_kq) + off_kq); } } while (0)
#define ML_PREFETCH(ci) do { const int base_ = ml_chunk_base(seg, dir, b, ci); const bf16* pb_ = P + (size_t)base_ * NP; \
        _Pragma("unroll") for (int i = 0; i < 2; ++i) { kreg[i] = *(const GAS v4u*)(pb_ + (OFF_AK + h * 128 + i * step_kq) + off_kq); } \
        _Pragma("unroll") for (int i = 0; i < 4; ++i) vreg[i] = *(const GAS v4u*)(pb_ + (OFF_AV + h * 256 + i * step_v) + off_v); } while (0)
    ML_PREFETCH(0);
    ML_PREFETCH_Q(0);
    for (int ci = 0; ci < nch; ++ci) {
        const int base = ml_chunk_base(seg, dir, b, ci);
        LBAR();
        const float g = *(LAS float*)(lds + GS_G + ci * 4), cm63 = *(LAS float*)(lds + GS_G + 128 + ci * 4);
        const float m_new = fmaxf(g + m, g + cm63);
        const float w_prev = __expf(g + m - m_new);
#pragma unroll
        for (int i = 0; i < 2; ++i) { const int idx = tid + 512 * i, srow = idx >> 4, ch = idx & 15; const float wt = __expf(g + *(LAS float*)(lds + GS_U + (ci * 64 + srow) * 4) - m_new);
            *(LAS v4u*)(lds + ML_KW + srow * KW_STR + ch * 16) = scale_bf8(kreg[i], wt);
            if (with_out) { *(LAS v4u*)(lds + ML_KT + srow * KT_STR + ch * 16) = kreg[i]; *(LAS v4u*)(lds + ML_QT + srow * KT_STR + ch * 16) = qreg[i]; } }
#pragma unroll
        for (int i = 0; i < 4; ++i) { const int idx = tid + 512 * i, srow = idx >> 5, ch = idx & 31; *(LAS v4u*)(lds + ML_VT + srow * VT_STR + ch * 16) = vreg[i]; }
        LBAR();
        if (with_out) {
            const int jt16 = wave >> 1, l15 = lane & 15, l4 = lane >> 4;
            const int j = 16 * jt16 + l15; const float Mjj = fmaxf(m, *(LAS float*)(lds + GS_CM + (ci * 64 + j) * 4));
            bf16x8 qb[4];
#pragma unroll
            for (int ks = 0; ks < 4; ++ks) qb[ks] = *(LAS bf16x8*)(lds + ML_QT + (16 * jt16 + l15) * KT_STR + (32 * ks + 8 * l4) * 2);
#pragma unroll
            for (int tt = 0; tt < 2; ++tt) { const int st16 = 2 * (wave & 1) + tt; f32x4 sacc = {0.f, 0.f, 0.f, 0.f};
                bf16x8 ka[4];
#pragma unroll
                for (int ks = 0; ks < 4; ++ks) ka[ks] = *(LAS bf16x8*)(lds + ML_KT + (16 * st16 + l15) * KT_STR + (32 * ks + 8 * l4) * 2);
                const int s0 = 16 * st16 + 4 * l4; const f32x4 uv = *(LAS f32x4*)(lds + GS_U + (ci * 64 + s0) * 4);
#pragma unroll
                for (int ks = 0; ks < 4; ++ks) sacc = MFMA16(ka[ks], qb[ks], sacc);
                float pv[4];
#pragma unroll
                for (int e = 0; e < 4; ++e) pv[e] = (s0 + e <= j) ? sacc[e] * __expf(uv[e] - Mjj) : 0.f;
                v2u w; w.x = pkh(pv[0], pv[1]); w.y = pkh(pv[2], pv[3]);
                *(LAS v2u*)(lds + ML_PT + j * PT_STR + s0 * 2) = w; }
            { const int jq = tid >> 3, part = tid & 7; const v4u q0 = *(LAS v4u*)(lds + ML_QT + jq * KT_STR + part * 32), q1 = *(LAS v4u*)(lds + ML_QT + jq * KT_STR + part * 32 + 16);
                const LAS f32x4* np = (const LAS f32x4*)(nl + nb * 128 + part * 16); const f32x4 n0 = np[0], n1 = np[1], n2 = np[2], n3 = np[3];
                float s = bflo(q0.x) * n0.x + bfhi(q0.x) * n0.y + bflo(q0.y) * n0.z + bfhi(q0.y) * n0.w + bflo(q0.z) * n1.x + bfhi(q0.z) * n1.y + bflo(q0.w) * n1.z + bfhi(q0.w) * n1.w
                        + bflo(q1.x) * n2.x + bfhi(q1.x) * n2.y + bflo(q1.y) * n2.z + bfhi(q1.y) * n2.w + bflo(q1.z) * n3.x + bfhi(q1.z) * n3.y + bflo(q1.w) * n3.z + bfhi(q1.w) * n3.w;
                s += shx(s, 1, lane); s += shx(s, 2, lane); s += shx(s, 4, lane);
                if (part == 0) *(LAS float*)(lds + ML_SC + SC_NQ + 4 * jq) = s; }
            LBAR();
        }
        if (ci + 1 < nch) ML_PREFETCH(ci + 1);
        bf16x8 vf[4];
#pragma unroll
        for (int ks = 0; ks < 4; ++ks) { const LAS unsigned char* vp = lds + ML_VT + (16 * ks + 8 * hh + q4) * VT_STR + (32 * wave + 16 * blk + 4 * p4) * 2;
            vf[ks] = cat8(tr_read(vp), tr_read(vp + 4 * VT_STR)); }
        if (with_out) {
#pragma unroll 1
            for (int jt = 0; jt < 2; ++jt) {
                f32x16 acc; float rs = 0.f;
#pragma unroll
                for (int e = 0; e < 16; ++e) acc[e] = 0.f;
                const int j = 32 * jt + r;
                const float Mj = fmaxf(m, *(LAS float*)(lds + GS_CM + (ci * 64 + j) * 4)), bsj = *(LAS float*)(lds + GS_BS + (ci * 64 + j) * 4);
                const float wint = __expf(m - Mj), thr = __expf(-(bsj + Mj)), nq = *(LAS float*)(lds + ML_SC + SC_NQ + 4 * j);
                v4u pw[4];
#pragma unroll
                for (int ih = 0; ih < 2; ++ih) { bf16x8 qfr[4];
#pragma unroll
                    for (int ii = 0; ii < 2; ++ii)
#pragma unroll
                        for (int s2 = 0; s2 < 2; ++s2) { const int i = 2 * ih + ii; const LAS unsigned char* qp = lds + ML_QT + (32 * jt + r) * KT_STR + (32 * i + 16 * s2 + 4 * hh) * 2; qfr[2 * ii + s2] = cat8(*(LAS s16x4*)qp, *(LAS s16x4*)(qp + 16)); }
#pragma unroll
                    for (int ii = 0; ii < 2; ++ii)
#pragma unroll
                        for (int s2 = 0; s2 < 2; ++s2) acc = MFMA32(pack_acc8(C[2 * ih + ii], s2), qfr[2 * ii + s2], acc);
                }
#pragma unroll
                for (int ks = 0; ks < 4; ++ks) pw[ks] = *(LAS v4u*)(lds + ML_PT + (32 * jt + r) * PT_STR + (16 * ks + 8 * hh) * 2);
#pragma unroll
                for (int e = 0; e < 16; ++e) acc[e] *= wint;
#pragma unroll
                for (int ks = 0; ks < 4; ++ks) { rs += (bflo(pw[ks].x) + bfhi(pw[ks].x)) + (bflo(pw[ks].y) + bfhi(pw[ks].y)) + (bflo(pw[ks].z) + bfhi(pw[ks].z)) + (bflo(pw[ks].w) + bfhi(pw[ks].w));
                    acc = MFMA32(vf[ks], __builtin_bit_cast(bf16x8, pw[ks]), acc); }
                rs += shx(rs, 32, lane);
                const float den = rs + wint * nq; const float inv = __builtin_amdgcn_rcpf(fmaxf(fabsf(den), thr));
                bf16* op = HOUT + (size_t)base * 2048 + (h * 256 + 32 * wave) + ((dir ? 63 - j : j) * 2048 + 8 * hh);
#pragma unroll
                for (int gp = 0; gp < 2; ++gp) { const int ga = 8 * gp, gb = 8 * gp + 4; v2u wa, wb;
                    wa.x = pkh(acc[ga + 0] * inv, acc[ga + 1] * inv); wa.y = pkh(acc[ga + 2] * inv, acc[ga + 3] * inv); wb.x = pkh(acc[gb + 0] * inv, acc[gb + 1] * inv); wb.y = pkh(acc[gb + 2] * inv, acc[gb + 3] * inv);
                    pair_swap(wa, wb);
                    *(GAS v4u*)(op + 16 * gp) = (v4u){wa.x, wa.y, wb.x, wb.y}; }
            }
            __builtin_amdgcn_sched_barrier(0);
        }
        if (ci + 1 < nch) ML_PREFETCH_Q(ci + 1);
#pragma unroll
        for (int i = 0; i < 4; ++i) {
            bf16x8 ka[4];
#pragma unroll
            for (int ks = 0; ks < 4; ++ks) { const LAS unsigned char* kp = lds + ML_KW + (16 * ks + 8 * hh + q4) * KW_STR + (32 * i + 16 * blk + 4 * p4) * 2; ka[ks] = cat8(tr_read(kp), tr_read(kp + 4 * KW_STR)); }
#pragma unroll
            for (int e = 0; e < 16; ++e) C[i][e] *= w_prev;
#pragma unroll
            for (int ks = 0; ks < 4; ++ks) C[i] = MFMA32(ka[ks], vf[ks], C[i]);
            if (wave == i) { f32x16 nacc;
#pragma unroll
                for (int e = 0; e < 16; ++e) nacc[e] = 0.f;
                const bf16x8 ones = {0x3F80, 0x3F80, 0x3F80, 0x3F80, 0x3F80, 0x3F80, 0x3F80, 0x3F80};
#pragma unroll
                for (int ks = 0; ks < 4; ++ks) nacc = MFMA32(ones, ka[ks], nacc);
                if (hh == 0) nl[(nb ^ 1) * 128 + 32 * i + r] = w_prev * nl[nb * 128 + 32 * i + r] + nacc[0]; }
            __builtin_amdgcn_sched_barrier(0);
        }
        m = m_new; Ftot += g; nb ^= 1;
    }
#undef ML_PREFETCH
#undef ML_PREFETCH_Q
    if (!init_comb) {
        const int tid2 = wave * 64 + fresh_lane();
        f32x4* dst = (f32x4*)((float*)(a.ws + WS_STC) + (size_t)sidx * 32768) + tid2;
#pragma unroll
        for (int i = 0; i < 4; ++i)
#pragma unroll
            for (int g4 = 0; g4 < 4; ++g4) dst[(4 * i + g4) * 512] = (f32x4){C[i][4 * g4 + 0], C[i][4 * g4 + 1], C[i][4 * g4 + 2], C[i][4 * g4 + 3]};
        __syncthreads();
        if (tid2 < 128) ((float*)(a.ws + WS_STN))[sidx * 128 + tid2] = ((LAS float*)(lds + ML_SC + SC_N))[nb * 128 + tid2];
        if (tid2 == 0) { ((float*)(a.ws + WS_STS))[sidx * 4] = m; ((float*)(a.ws + WS_STS))[sidx * 4 + 1] = Ftot; }
    }
}

template <int SUB>
__device__ __forceinline__ void mlstm_phase(const Args& a, LAS unsigned char* lds, int pass, bool need_ctx, int tid, int lane, int wave) {
    if (pass == 1) {
        if (SUB != 2) for (int uu = blockIdx.x; uu < 32; uu += gridDim.x) { const int b = uu >> 4, h = (uu >> 1) & 7, dir = uu & 1; mlstm_unit<true, false>(a, lds, b, h, dir, 0, tid, lane, wave); }
        int v0 = (int)blockIdx.x - 32; if (v0 < 0) v0 += gridDim.x;
        if (SUB != 1) for (int v = v0; v < 224; v += gridDim.x) { const int bhd = v / 7, seg = 1 + v % 7; const int b = bhd >> 4, h = (bhd >> 1) & 7, dir = bhd & 1; mlstm_unit<false, false>(a, lds, b, h, dir, seg, tid, lane, wave); }
    } else {
        for (int u0 = blockIdx.x; u0 < 256; u0 += gridDim.x) { const int uu = (gridDim.x == 256) ? ((u0 & 7) * 32 + (u0 >> 3)) : u0;     const int bhd = uu >> 3, seg = 1 + (uu & 7); const int b = bhd >> 4, h = (bhd >> 1) & 7, dir = bhd & 1; mlstm_unit<true, true>(a, lds, b, h, dir, seg, tid, lane, wave); }
    }
    __syncthreads();
}

__device__ __forceinline__ void post_rows(const Args& a, LAS unsigned char* lds, int l, int row0, int row1, int wrank, int nworkers, int tid, int lane, int wave) {
    unsigned char* ws = a.ws;
    const bf16* P = (const bf16*)(ws + WS_P); const bf16* HF = (const bf16*)(ws + WS_HF); const bf16* HB = (const bf16*)(ws + WS_HB); bf16* YA = (bf16*)(ws + WS_H);
    LAS float* gl = (LAS float*)lds;
    for (int idx = tid; idx < 2048; idx += 512) gl[idx] = a.in[9][(size_t)l * 2048 + idx];
    __syncthreads();
    v4u xh[4], yh[4], gzr[4];
#define POST_LOAD(row_) do { _Pragma("unroll") for (int c = 0; c < 4; ++c) { xh[c] = *(const GAS v4u*)(HF + (size_t)(row_) * 2048 + 32 * lane + 8 * c); yh[c] = *(const GAS v4u*)(HB + (size_t)(row_) * 2048 + 32 * lane + 8 * c); \
            gzr[c] = *(const GAS v4u*)(P + (size_t)(row_) * NP + OFF_AO + 32 * lane + 8 * c); } } while (0)
    if (row0 + wrank < row1) POST_LOAD(row0 + wrank);
    for (int row = row0 + wrank; row < row1; row += nworkers) {
        float hs[32]; float ss = 0.f; v4u gz[4];
#pragma unroll
        for (int c = 0; c < 4; ++c) { const v4u x = xh[c], y = yh[c]; gz[c] = gzr[c];
            hs[8 * c + 0] = bflo(x.x) + bflo(y.x); hs[8 * c + 1] = bfhi(x.x) + bfhi(y.x); hs[8 * c + 2] = bflo(x.y) + bflo(y.y); hs[8 * c + 3] = bfhi(x.y) + bfhi(y.y);
            hs[8 * c + 4] = bflo(x.z) + bflo(y.z); hs[8 * c + 5] = bfhi(x.z) + bfhi(y.z); hs[8 * c + 6] = bflo(x.w) + bflo(y.w); hs[8 * c + 7] = bfhi(x.w) + bfhi(y.w); }
        if (row + nworkers < row1) POST_LOAD(row + nworkers);
#pragma unroll
        for (int e = 0; e < 32; ++e) ss += hs[e] * hs[e];
        ss += shx(ss, 1, lane); ss += shx(ss, 2, lane); ss += shx(ss, 4, lane);
        const float rstd = __builtin_amdgcn_rsqf(ss * (1.0f / 256.0f) + EPS);
#pragma unroll
        for (int c = 0; c < 4; ++c) {
            const f32x4 g0 = *(LAS f32x4*)(gl + 32 * lane + 8 * c), g1 = *(LAS f32x4*)(gl + 32 * lane + 8 * c + 4);
            float o[8];
            o[0] = hs[8 * c + 0] * rstd * g0.x * bflo(gz[c].x); o[1] = hs[8 * c + 1] * rstd * g0.y * bfhi(gz[c].x);
            o[2] = hs[8 * c + 2] * rstd * g0.z * bflo(gz[c].y); o[3] = hs[8 * c + 3] * rstd * g0.w * bfhi(gz[c].y);
            o[4] = hs[8 * c + 4] * rstd * g1.x * bflo(gz[c].z); o[5] = hs[8 * c + 5] * rstd * g1.y * bfhi(gz[c].z);
            o[6] = hs[8 * c + 6] * rstd * g1.z * bflo(gz[c].w); o[7] = hs[8 * c + 7] * rstd * g1.w * bfhi(gz[c].w);
#ifdef FAKEQ_YA
#pragma unroll
            for (int e = 0; e < 8; ++e) hs[8 * c + e] = o[e];
        }
        { float mx = 0.f;
#pragma unroll
            for (int e = 0; e < 32; ++e) mx = fmaxf(mx, __builtin_fabsf(hs[e]));
            mx = fmaxf(wave_max(mx, lane), 1e-30f); const float inv = 127.0f * __builtin_amdgcn_rcpf(mx), sc = mx * (1.0f / 127.0f);
#pragma unroll
            for (int e = 0; e < 32; ++e) hs[e] = ((hs[e] * inv + 12582912.0f) - 12582912.0f) * sc; }
#pragma unroll
        for (int c = 0; c < 4; ++c) { float o[8];
#pragma unroll
            for (int e = 0; e < 8; ++e) o[e] = hs[8 * c + e];
#endif
            v4u w; w.x = pkh(o[0], o[1]); w.y = pkh(o[2], o[3]); w.z = pkh(o[4], o[5]); w.w = pkh(o[6], o[7]);
            *(GAS v4u*)(YA + (size_t)row * 2048 + 32 * lane + 8 * c) = w; }
    }
#undef POST_LOAD
    __syncthreads();
}

constexpr int NA_KT0 = 0, NA_VT0 = 34816, NA_RK0 = 75776, NA_RPB = 76288, NA_FAC = 80128;
constexpr int NK_STR = 272, NV_STR = 320;
constexpr float NEG_BIG = -1e30f, LOG2E = 1.4426950408889634f, NA_THR = 8.0f;

template <bool LAT>
__device__ __forceinline__ void na_tile(const LAS unsigned char* kt, const LAS unsigned char* vt, const LAS float* rkl, int ko, const bf16x8 (&qf)[8], f32x16 (&O)[4], float& mrun, float& lsum,
                                        const LAS unsigned char* baddr, unsigned cmr, int r, int hh, int q4, int p4, int blk, int lane) {
    f32x16 sacc;
#pragma unroll
    for (int e = 0; e < 16; ++e) sacc[e] = 0.f;
    { bf16x8 kf[8];
#pragma unroll
        for (int ks = 0; ks < 8; ++ks) kf[ks] = *(const LAS bf16x8*)(kt + (ko + r) * NK_STR + (16 * ks + 8 * hh) * 2);
#pragma unroll
        for (int ks = 0; ks < 8; ++ks) sacc = MFMA32(kf[ks], qf[ks], sacc); }
    bf16x8 vf[8];
#pragma unroll
    for (int s2 = 0; s2 < 2; ++s2)
#pragma unroll
        for (int i = 0; i < 4; ++i) { const LAS unsigned char* vp = vt + (ko + 16 * s2 + 4 * hh + q4) * NV_STR + (32 * i + 16 * blk + 4 * p4) * 2; vf[4 * s2 + i] = cat8(tr_read(vp), tr_read(vp + 8 * NV_STR)); }
    float tmax = NEG_BIG;
#pragma unroll
    for (int g4 = 0; g4 < 4; ++g4) { const f32x4 rk4 = *(const LAS f32x4*)(rkl + ko + 8 * g4 + 4 * hh);
#pragma unroll
        for (int e = 0; e < 4; ++e) { const int reg = 4 * g4 + e; float s = sacc[reg] * rk4[e];
            if (LAT) { s += *(const LAS float*)(baddr + (8 * g4 + e) * 4); s = (cmr & (1u << reg)) ? s : NEG_BIG; }
            sacc[reg] = s; tmax = fmaxf(tmax, s); } }
    tmax = fmaxf(tmax, shx(tmax, 32, lane));
    if (__builtin_amdgcn_ballot_w64(tmax > mrun + NA_THR) != 0ull) {
        const float mnew = fmaxf(mrun, tmax); const float alpha = __builtin_amdgcn_exp2f(mrun - mnew); mrun = mnew; lsum *= alpha;
#pragma unroll
        for (int i = 0; i < 4; ++i)
#pragma unroll
            for (int e = 0; e < 16; ++e) O[i][e] *= alpha;
    }
    float psum = 0.f;
#pragma unroll
    for (int e = 0; e < 16; ++e) { sacc[e] = __builtin_amdgcn_exp2f(sacc[e] - mrun); psum += sacc[e]; }
    lsum += psum;
#pragma unroll
    for (int s2 = 0; s2 < 2; ++s2) { const bf16x8 pb = pack_acc8(sacc, s2);
#pragma unroll
        for (int i = 0; i < 4; ++i) O[i] = MFMA32(vf[4 * s2 + i], pb, O[i]); }
}

__device__ __forceinline__ void na_unit(const Args& a, LAS unsigned char* lds, int l, int b, int head, int r0, bool is_ctx, int& tab_head, int tid_, int lane_, int wave) {
    const int lane = fresh_lane(), tid = wave * 64 + lane;
    unsigned char* ws = a.ws;
    const bf16* P = (const bf16*)(ws + WS_P); const float* SSQ = (const float*)(ws + WS_SSQ); bf16* YB = (bf16*)(ws + WS_YB);
    const int r = lane & 31, hh = lane >> 5, q4 = (lane & 15) >> 2, p4 = lane & 3, blk = (lane >> 4) & 1;
    const int cb = wave & 3, pair = wave >> 2;
    const int qrow = r0 + 2 * pair + (r >> 4), qcol = 16 * cb + (r & 15);
    const size_t qtok = is_ctx ? (size_t)(MLAT + b * 256 + 32 * wave + r) : (size_t)(b * 16384 + qrow * 64 + qcol);
    const int ws_q = clampi(qcol - 8, 0, 48), rs_q = clampi(qrow - 4, 0, 248);
    const int cs = clampi(16 * cb - 8, 0, 32);
    const int rs_a = clampi(r0 + 2 * pair - 4, 0, 248), rs_b = clampi(r0 + 2 * pair + 1 - 4, 0, 248);
    const int kr_lo = clampi(r0 - 4, 0, 248), kr_hi = clampi(r0 + 3 - 4, 0, 248) + 8;
    const int nlat = is_ctx ? 0 : kr_hi - kr_lo, nsteps = 4 + nlat;
    unsigned cmask = 0u;
#pragma unroll
    for (int reg = 0; reg < 16; ++reg) { const int kc = cs + crow(reg, hh); cmask |= (kc >= ws_q && kc < ws_q + 16) ? (1u << reg) : 0u; }
    const int bidx0 = cs - qcol + 31 + 4 * hh;
    __syncthreads();
    if (head != tab_head) { const float* rp = a.in[14] + ((size_t)l * 16 + head) * 465; LAS float* rl = (LAS float*)(lds + NA_RPB);
        for (int idx = tid; idx < 960; idx += 512) { const int dr = idx >> 6, dc = (idx & 63) - 16; rl[idx] = (dc >= 0 && dc < 31) ? rp[dr * 31 + dc] * LOG2E : 0.f; }
        if (tid < 128) ((LAS float*)(lds + NA_FAC))[tid] = a.in[12][(size_t)l * 128 + tid] * a.in[13][(size_t)l * 128 + tid] * (0.08838834764831845f * LOG2E);
        tab_head = head;
        __syncthreads(); }
    bf16x8 qf[8];
    { const f32x4 sq = *(const GAS f32x4*)(SSQ + (qtok * 16 + head) * 4); const float rq = __builtin_amdgcn_rsqf(((sq.x + sq.y) + (sq.z + sq.w)) * (1.0f / 128.0f) + EPS);
        v4u xq[8];
#pragma unroll
        for (int ks = 0; ks < 8; ++ks) xq[ks] = *(const GAS v4u*)(P + qtok * NP + OFF_BQ + head * 128 + 16 * ks + 8 * hh);
#pragma unroll
        for (int ks = 0; ks < 8; ++ks) { const v4u x = xq[ks];
            const LAS f32x4* fp = (const LAS f32x4*)(lds + NA_FAC + (16 * ks + 8 * hh) * 4); const f32x4 f0 = fp[0] * rq, f1 = fp[1] * rq;
            v4u o; o.x = pkh(bflo(x.x) * f0.x, bfhi(x.x) * f0.y); o.y = pkh(bflo(x.y) * f0.z, bfhi(x.y) * f0.w); o.z = pkh(bflo(x.z) * f1.x, bfhi(x.z) * f1.y); o.w = pkh(bflo(x.w) * f1.z, bfhi(x.w) * f1.w);
            qf[ks] = __builtin_bit_cast(bf16x8, o); } }
    f32x16 O[4];
#pragma unroll
    for (int i = 0; i < 4; ++i)
#pragma unroll
        for (int e = 0; e < 16; ++e) O[i][e] = 0.f;
    float mrun = NEG_BIG, lsum = 0.f;
    v4u kreg[2], vreg[2]; f32x4 sreg = {0.f, 0.f, 0.f, 0.f};
    const int koff = (tid >> 4) * NP + 8 * (tid & 15);
#define NA_PREFETCH(st) do { const size_t row0_ = (st) < 4 ? (size_t)(MLAT + b * 256 + 64 * (st)) : (size_t)(b * 16384 + (kr_lo + (st) - 4) * 64); const bf16* pb_ = P + row0_ * NP + head * 128; \
        _Pragma("unroll") for (int i = 0; i < 2; ++i) { kreg[i] = *(const GAS v4u*)(pb_ + (OFF_BK + i * 32 * NP) + koff); vreg[i] = *(const GAS v4u*)(pb_ + (OFF_BV + i * 32 * NP) + koff); } \
        if (tid < 64) sreg = *(const GAS f32x4*)(SSQ + (((size_t)MALL + row0_ + tid) * 16 + head) * 4); } while (0)
#define NA_STAGE(st) do { \
        _Pragma("unroll") for (int i = 0; i < 2; ++i) { const int idx = tid + 512 * i, kk = idx >> 4, ch = idx & 15; \
            *(LAS v4u*)(kt + kk * NK_STR + ch * 16) = kreg[i]; *(LAS v4u*)(vt + kk * NV_STR + ch * 16) = vreg[i]; } \
        if (tid < 64) rkl[tid] = __builtin_amdgcn_rsqf(((sreg.x + sreg.y) + (sreg.z + sreg.w)) * (1.0f / 128.0f) + EPS); \
        if ((st) + 1 < nsteps) NA_PREFETCH((st) + 1); \
        LBAR(); } while (0)
    NA_PREFETCH(0);
#pragma unroll 1
    for (int st = 0; st < 4; ++st) {
        const int buf = st & 1;
        LAS unsigned char* kt = lds + NA_KT0 + buf * 17408; LAS unsigned char* vt = lds + NA_VT0 + buf * 20480; LAS float* rkl = (LAS float*)(lds + NA_RK0 + buf * 256);
        NA_STAGE(st);
#pragma unroll 1
        for (int tl = 0; tl < 2; ++tl) na_tile<false>(kt, vt, rkl, 32 * tl, qf, O, mrun, lsum, nullptr, 0u, r, hh, q4, p4, blk, lane);
    }
#pragma unroll 1
    for (int st = 4; st < nsteps; ++st) {
        const int buf = st & 1;
        LAS unsigned char* kt = lds + NA_KT0 + buf * 17408; LAS unsigned char* vt = lds + NA_VT0 + buf * 20480; LAS float* rkl = (LAS float*)(lds + NA_RK0 + buf * 256);
        NA_STAGE(st);
        const int kr = kr_lo + st - 4;
        const bool active = (kr >= rs_a && kr < rs_a + 8) || (kr >= rs_b && kr < rs_b + 8);
        if (active) {
            const bool rowok = kr >= rs_q && kr < rs_q + 8;
            const int dr = clampi(kr - qrow + 7, 0, 14);
            na_tile<true>(kt, vt, rkl, cs, qf, O, mrun, lsum, lds + NA_RPB + (dr * 64 + bidx0) * 4, rowok ? cmask : 0u, r, hh, q4, p4, blk, lane);
        }
    }
#undef NA_STAGE
#undef NA_PREFETCH
    lsum += shx(lsum, 32, lane);
    const float inv = __builtin_amdgcn_rcpf(lsum);
    v4u zq[4][2];
#pragma unroll
    for (int i = 0; i < 4; ++i)
#pragma unroll
        for (int gp = 0; gp < 2; ++gp) zq[i][gp] = *(const GAS v4u*)(P + qtok * NP + OFF_BZ + head * 128 + 32 * i + 16 * gp + 8 * hh);
#pragma unroll
    for (int i = 0; i < 4; ++i)
#pragma unroll
        for (int gp = 0; gp < 2; ++gp) {
            v2u za = {zq[i][gp].x, zq[i][gp].y}, zb = {zq[i][gp].z, zq[i][gp].w}; pair_swap(za, zb);
            const int ga = 4 * (2 * gp), gb = 4 * (2 * gp + 1);
            v2u wa, wb;
            wa.x = pkh(O[i][ga + 0] * inv * silu(bflo(za.x)), O[i][ga + 1] * inv * silu(bfhi(za.x))); wa.y = pkh(O[i][ga + 2] * inv * silu(bflo(za.y)), O[i][ga + 3] * inv * silu(bfhi(za.y)));
            wb.x = pkh(O[i][gb + 0] * inv * silu(bflo(zb.x)), O[i][gb + 1] * inv * silu(bfhi(zb.x))); wb.y = pkh(O[i][gb + 2] * inv * silu(bflo(zb.y)), O[i][gb + 3] * inv * silu(bfhi(zb.y)));
            pair_swap(wa, wb);
            *(GAS v4u*)(YB + qtok * 2048 + head * 128 + 32 * i + 16 * gp + 8 * hh) = (v4u){wa.x, wa.y, wb.x, wb.y}; }
}

__device__ __forceinline__ void na_phase(const Args& a, LAS unsigned char* lds, int l, bool need_ctx, int tid, int lane, int wave) {
    int tab_head = -1;
    const int nper = (2048 + (int)gridDim.x - 1) / (int)gridDim.x;
    const int vbx = (gridDim.x == 256) ? (((int)blockIdx.x & 7) * 32 + ((int)blockIdx.x >> 3)) : (int)blockIdx.x;
    for (int k = 0; k < nper; ++k) { const int uu = vbx * nper + k; if (uu >= 2048) break; const int b = uu >> 10, head = (uu >> 6) & 15, rq = uu & 63; na_unit(a, lds, l, b, head, 4 * rq, false, tab_head, tid, lane, wave); }
    if (need_ctx) for (int v = (int)blockIdx.x; v < 32; v += gridDim.x) na_unit(a, lds, l, v >> 4, v & 15, 0, true, tab_head, tid, lane, wave);
    __syncthreads();
}

constexpr int NPHASE = 1 + 9 * DEPTH;
#ifndef G23_ALIGN
#define G23_ALIGN true
#endif
#ifndef WGM_SMALL
#define WGM_SMALL 2
#endif
#ifndef G1_ALIGN
#define G1_ALIGN true
#endif
#ifndef G1_SP2
#define G1_SP2 true
#endif
#define PH_ON(x) (PHSEL < 0 || PHSEL == (x))
#ifndef REPEAT_PH
#define REPEAT_PH -1
#endif
#define REPS(k) ((REPEAT_PH == (k)) ? 2 : 1)
#ifdef REP_HALFK
#define G1_KEXT(r) (((r) == 0 && REPEAT_PH == 2) ? 1024 : 2048)
#else
#define G1_KEXT(r) 2048
#endif
template <int PHSEL>
__global__ void __launch_bounds__(NWAVES * 64, 2) fwd_kernel(Args args) {
    extern __shared__ __attribute__((aligned(16))) unsigned char lds_raw[];
    LAS unsigned char* lds = (LAS unsigned char*)lds_raw;
    int tid = threadIdx.x, lane = tid & 63, wave = __builtin_amdgcn_readfirstlane(tid >> 6);
#define FRESH_TID() do { lane = fresh_lane(); tid = wave * 64 + lane; } while (0)
    volatile LAS unsigned* MISC = (volatile LAS unsigned*)(lds + MISC_OFF);
    for (int u = tid; u < (LDS_BYTES - RING_BYTES) / 4; u += NWAVES * 64) ((LAS unsigned*)(lds + RING_BYTES))[u] = 0u;
    __syncthreads();
    unsigned char* ws = args.ws;
    gu32* ctl = (gu32*)(ws + WS_CTL);
    const bool use_bar = (args.ph_hi - args.ph_lo) > 1;
    XcdBarrier bar; bar.bar = (unsigned*)(ctl + CW_BAR); bar.x = 0; bar.st = nullptr;
    if (use_bar) bar = xcd_barrier_post((unsigned*)(ctl + CW_BAR), MISC + 8);
    const int lo = args.ph_lo, hi = args.ph_hi;
#define IN(k) (lo <= (k) && (k) < hi)
#define SEAM(k) do { if (IN(k) && IN((k) + 1)) xcd_barrier(bar); } while (0)

    if (PH_ON(0) && IN(0)) { for (int rep_ = 0; rep_ < REPS(0); ++rep_) { prologue(args, lds, tid, lane, wave, rep_); SEAM(0); } }
    for (int l = 0; l < DEPTH; ++l) {
        const int pb = 1 + 9 * l; const bool need_ctx = l < DEPTH - 1;
        const int mrows = need_ctx ? MALL : MLAT;
        const int mrows_ab = MLAT;
        const float* MODl = (const float*)(ws + WS_MOD) + (size_t)l * 3 * 6144;
        if (PH_ON(1) && IN(pb + 0)) { for (int rep_ = 0; rep_ < REPS(1); ++rep_) { FRESH_TID();
            norm_phase(args, lds, l, tid, lane, wave); SEAM(pb + 0); } }
        if (PH_ON(2) && IN(pb + 1)) { for (int rep_ = 0; rep_ < REPS(2); ++rep_) {
            pg8::StaticOrder S; S.init(MALL, NPAD, (int)gridDim.x, (int)blockIdx.x);
#if G1_I8
            const int nfirst = G1_STAGGER ? ((int)blockIdx.x & 7) % 5 : 0;
            pg8::Gemm gb{(const pg8::bf16_t*)(ws + WS_H), (const pg8::bf16_t*)(ws + WS_WIN) + (size_t)l * NPAD * 2048, MALL, NPAD, 2048, 2048};
            pg8::MapOrder SB; SB.base.init(MALL, (81 - I8_NT) * 256, (int)gridDim.x, (int)gridDim.x - 1 - (int)blockIdx.x); SB.mask = 0x3FFu & ~I8_MASK;
            pg8::EpiIn EB{(pg8::bf16_t*)(ws + WS_P), (float*)(ws + WS_G), (float*)(ws + WS_SSQ), (const float*)(ws + WS_PB) + (size_t)l * NPAD, (const float*)(ws + WS_ROPE), MALL};
            if (G1_STAGGER) { SB.i0 = 0; SB.i1 = nfirst; pg8::gemm_phase<pg8::EpiIn, pg8::MapOrder, G1_ALIGN, G1_SP2>(lds, gb, SB, EB, wave); }
            {
                pg8::Gemm g{(const pg8::bf16_t*)(ws + WS_HQ), (const pg8::bf16_t*)(ws + WS_WQ + (size_t)l * NPAD * 2048), MALL, NPAD, 1024, 1024};
                pg8::MapOrder SQ; SQ.base.init(MALL, I8_NT * 256, (int)gridDim.x, (int)blockIdx.x, G1_WGMQ); SQ.mask = I8_MASK;
#if G1_BAL
                { const int G = (int)gridDim.x, remq = (MALL / 256 * I8_NT) % G, remb = (MALL / 256 * (81 - I8_NT)) % G;
                  const int rest = G - remb; if (remq > rest && remq <= 2 * rest) { SQ.n2 = remq - rest; SQ.n1 = rest - SQ.n2; } }
#endif
                pg8::EpiInQ E{(pg8::bf16_t*)(ws + WS_P), (float*)(ws + WS_G), (float*)(ws + WS_SSQ), (const float*)(ws + WS_PB) + (size_t)l * NPAD, (const float*)(ws + WS_ROPE), MALL, (const float*)(ws + WS_RS), (const float*)(ws + WS_CS) + (size_t)l * NPAD};
                pg8::gemm_phase<pg8::EpiInQ, pg8::MapOrder, G1Q_ALIGN, G1Q_SP2, true>(lds, g, SQ, E, wave);
            }
            SB.i0 = nfirst; SB.i1 = 1 << 30; pg8::gemm_phase<pg8::EpiIn, pg8::MapOrder, G1_ALIGN, G1_SP2>(lds, gb, SB, EB, wave);
#else
            pg8::Gemm g{(const pg8::bf16_t*)(ws + WS_H), (const pg8::bf16_t*)(ws + WS_WIN) + (size_t)l * NPAD * 2048, MALL, NPAD, 2048, G1_KEXT(rep_)};
            pg8::EpiIn E{(pg8::bf16_t*)(ws + WS_P), (float*)(ws + WS_G), (float*)(ws + WS_SSQ), (const float*)(ws + WS_PB) + (size_t)l * NPAD, (const float*)(ws + WS_ROPE), MALL};
            pg8::gemm_phase<pg8::EpiIn, pg8::StaticOrder, G1_ALIGN, G1_SP2>(lds, g, S, E, wave);
#endif
            SEAM(pb + 1);
        } }
        if ((PH_ON(3) || PHSEL == 10) && IN(pb + 2)) { for (int rep_ = 0; rep_ < REPS(3); ++rep_) { FRESH_TID(); mlstm_phase<PHSEL == 3 ? 1 : (PHSEL == 10 ? 2 : 0)>(args, lds, 1, need_ctx, tid, lane, wave); if (PHSEL < 0) { FRESH_TID(); na_phase(args, lds, l, need_ctx, tid, lane, wave); } SEAM(pb + 2); } }
        if (PH_ON(4) && IN(pb + 3)) { for (int rep_ = 0; rep_ < REPS(4); ++rep_) { FRESH_TID(); mlstm_phase<0>(args, lds, 2, need_ctx, tid, lane, wave);
            if (need_ctx) { FRESH_TID(); post_rows(args, lds, l, MLAT, MALL, (int)blockIdx.x * NWAVES + wave, (int)gridDim.x * NWAVES, tid, lane, wave); }
            SEAM(pb + 3); } }
        if (PHSEL == 5 && IN(pb + 4)) { FRESH_TID(); na_phase(args, lds, l, need_ctx, tid, lane, wave); }
        if (PH_ON(6) && IN(pb + 5)) { for (int rep_ = 0; rep_ < REPS(6); ++rep_) {
            const int nctxw = need_ctx ? 32 : 0;
            if ((int)blockIdx.x < nctxw) {
                pg8::Gemm g{(const pg8::bf16_t*)(ws + WS_H), (const pg8::bf16_t*)(ws + WS_WAB) + (size_t)l * 2 * 2048 * 2048, 2 * MALL, 4096, 2048, 2048};
                pg8::PairOrder S; S.single = (int)blockIdx.x; S.base.init(256, 256, 1, 0);
                pg8::EpiMergePair E{(const pg8::bf16_t*)(ws + WS_P), (pg8::bf16_t*)(ws + WS_HF), (long)((WS_HB - WS_HF) / 2), 0};
                pg8::gemm_phase<pg8::EpiMergePair, pg8::PairOrder, G23_ALIGN, true>(lds, g, S, E, wave);
            } else { FRESH_TID(); post_rows(args, lds, l, 0, MLAT, ((int)blockIdx.x - nctxw) * NWAVES + wave, ((int)gridDim.x - nctxw) * NWAVES, tid, lane, wave); }
            SEAM(pb + 5); } }
        if (PH_ON(7) && IN(pb + 6)) { for (int rep_ = 0; rep_ < REPS(7); ++rep_) {
            pg8::Gemm g{(const pg8::bf16_t*)(ws + WS_H), (const pg8::bf16_t*)(ws + WS_WAB) + (size_t)l * 2 * 2048 * 2048, 2 * MALL, 4096, 2048, 2048};
            pg8::PairOrder S; S.single = -1; S.base.init(mrows_ab, 2048, (int)gridDim.x, (int)blockIdx.x, WGM_SMALL);
            pg8::EpiMergePair E{(const pg8::bf16_t*)(ws + WS_P), (pg8::bf16_t*)(ws + WS_HF), (long)((WS_HB - WS_HF) / 2), 1};
            if (need_ctx) {
                FRESH_TID(); const int gt = (int)blockIdx.x * 512 + tid, ngt = (int)gridDim.x * 512;
                for (int p = gt; p < MCTX * 256; p += ngt) { const size_t off = (size_t)MLAT * 2048 + (size_t)p * 8;
                    const v4u ta = *(const GAS v4u*)((const bf16*)(ws + WS_HF) + off), tb = *(const GAS v4u*)((const bf16*)(ws + WS_HB) + off);
                    v4u o; o.x = pkh(bflo(ta.x) + bflo(tb.x), bfhi(ta.x) + bfhi(tb.x)); o.y = pkh(bflo(ta.y) + bflo(tb.y), bfhi(ta.y) + bfhi(tb.y)); o.z = pkh(bflo(ta.z) + bflo(tb.z), bfhi(ta.z) + bfhi(tb.z)); o.w = pkh(bflo(ta.w) + bflo(tb.w), bfhi(ta.w) + bfhi(tb.w));
                    *(GAS v4u*)((bf16*)(ws + WS_HB) + off) = o; }
            }
            pg8::gemm_phase<pg8::EpiMergePair, pg8::PairOrder, G23_ALIGN, true>(lds, g, S, E, wave);
            SEAM(pb + 6);
        } }
        if (PH_ON(9) && IN(pb + 8)) {
            pg8::Gemm g{(const pg8::bf16_t*)(ws + WS_HB), (const pg8::bf16_t*)(ws + WS_WO) + (size_t)l * 2048 * 2048, MLAT, 2048, 2048, 2048};
            pg8::StaticOrder S; S.init(MLAT, 2048, (int)gridDim.x, (int)blockIdx.x, WGM_SMALL);
            pg8::EpiOut E{l == 0 ? args.in[0] : args.out, args.out, l == 0 ? args.in[2] : (const float*)(ws + WS_XC), (float*)(ws + WS_XC), MODl, args.in[16] + (size_t)l * 2048};
            pg8::gemm_phase<pg8::EpiOut, pg8::StaticOrder, true, true>(lds, g, S, E, wave);
            if (need_ctx) {
                const int ks = (int)blockIdx.x & 3;
                pg8::Gemm g2{(const pg8::bf16_t*)(ws + WS_HB) + 512 * ks, (const pg8::bf16_t*)(ws + WS_WO) + (size_t)l * 2048 * 2048 + 512 * ks, MALL, 2048, 2048, 512};
                pg8::SliceOrder S2; S2.c = (int)blockIdx.x;
                pg8::EpiPart E2{(float*)(ws + WS_PART) + (size_t)ks * 512 * 2048};
                pg8::gemm_phase<pg8::EpiPart, pg8::SliceOrder, true, true>(lds, g2, S2, E2, wave);
            }
            SEAM(pb + 8);
        }
    }
#undef IN
#undef SEAM
}

template <int PHSEL> static void launch_one(const Args& a, int grid, hipStream_t stream, bool first) {
    if (first) (void)hipFuncSetAttribute((const void*)fwd_kernel<PHSEL>, hipFuncAttributeMaxDynamicSharedMemorySize, LDS_BYTES);
    hipLaunchKernelGGL(fwd_kernel<PHSEL>, dim3(grid), dim3(NWAVES * 64), LDS_BYTES, stream, a);
}
extern "C" void kernel_launch(void* const* d_in, const int* in_sizes, int n_in, void* d_out, int out_size, void* d_ws, size_t ws_size, hipStream_t stream) {
    static int grid = 0; static bool first = true;
    if (grid == 0) {
        if (n_in != 17 || out_size != MLAT * DM || ws_size < WS_END) { fprintf(stderr, "kernel_launch: unexpected shapes / workspace (n_in %d out %d ws %zu need %zu)\n", n_in, out_size, ws_size, (size_t)WS_END); grid = -1; return; }
        int dev = 0, cus = 0;
        if (hipGetDevice(&dev) != hipSuccess || hipDeviceGetAttribute(&cus, hipDeviceAttributeMultiprocessorCount, dev) != hipSuccess) { grid = -1; return; }
        grid = cus;
    }
    if (grid < 0) return;
    if (hipMemsetAsync((char*)d_ws + WS_CTL, 0, CTL_ZERO_BYTES, stream) != hipSuccess) return;
    Args a{};
    for (int i = 0; i < 17; ++i) a.in[i] = (const float*)d_in[i];
    a.out = (float*)d_out; a.ws = (unsigned char*)d_ws;
#if N_LAUNCH_MODE == 1
#ifdef PROBE_EXTRA_HI
    a.ph_lo = PROBE_EXTRA_LO; a.ph_hi = PROBE_EXTRA_HI; launch_one<-1>(a, grid, stream, first);
    if (hipMemsetAsync((char*)d_ws + WS_CTL, 0, CTL_ZERO_BYTES, stream) != hipSuccess) return;
#endif
    a.ph_lo = 0; a.ph_hi = NPHASE;
    launch_one<-1>(a, grid, stream, first);
#else
    a.ph_lo = 0; a.ph_hi = 1; launch_one<0>(a, grid, stream, first);
    for (int l = 0; l < DEPTH; ++l) { const int pb = 1 + 9 * l;
        a.ph_lo = pb + 0; a.ph_hi = pb + 1; launch_one<1>(a, grid, stream, first);
        a.ph_lo = pb + 1; a.ph_hi = pb + 2; launch_one<2>(a, grid, stream, first);
        a.ph_lo = pb + 2; a.ph_hi = pb + 3; launch_one<3>(a, grid, stream, first); launch_one<10>(a, grid, stream, first);
        a.ph_lo = pb + 3; a.ph_hi = pb + 4; launch_one<4>(a, grid, stream, first);
        a.ph_lo = pb + 4; a.ph_hi = pb + 5; launch_one<5>(a, grid, stream, first);
        a.ph_lo = pb + 5; a.ph_hi = pb + 6; launch_one<6>(a, grid, stream, first);
        a.ph_lo = pb + 6; a.ph_hi = pb + 7; launch_one<7>(a, grid, stream, first);
        a.ph_lo = pb + 7; a.ph_hi = pb + 8; launch_one<8>(a, grid, stream, first);
        a.ph_lo = pb + 8; a.ph_hi = pb + 9; launch_one<9>(a, grid, stream, first);
    }
#endif
    first = false;
}
```

```cpp
#include <hip/hip_runtime.h>
#include <cstdio>
#include <cstdint>
#ifndef N_LAUNCH_MODE
#define N_LAUNCH_MODE 1
#endif
namespace pg8 {
#define PG8_LAS __attribute__((address_space(3)))
typedef unsigned short bf16_t;
typedef short bf16x8 __attribute__((ext_vector_type(8)));
typedef float f32x4 __attribute__((ext_vector_type(4)));
typedef unsigned u32x4 __attribute__((ext_vector_type(4)));
typedef int i32x4 __attribute__((ext_vector_type(4)));
constexpr int BM = 256, BK = 64, HALF = 128, HTB = HALF * BK * 2  , STAGE_BYTES = 8 * HTB, NXCD = 8, WGM = 5;

__host__ __device__ __forceinline__ int lds_byte(int r, int c) { const int st = (r >> 4) * 2 + (c >> 5), rr = r & 15, cc = c & 31, ob = rr * 64 + cc * 2; return st * 1024 + (ob ^ (((ob >> 9) & 1) << 5)); }
__host__ __device__ __forceinline__ void stage_rc(int b, int& R, int& C) { const int st = b / 1024, sb = b % 1024, swz = sb ^ (((sb >> 9) & 1) << 5); R = (st >> 1) * 16 + swz / 64; C = (st & 1) * 32 + (swz % 64) / 2; }
__host__ __device__ __forceinline__ int perm32(int rho) { const int n = rho >> 4, i = rho & 15; return 8 * (i >> 2) + 4 * n + (i & 3); }

struct Unit { int pm, pn; };
struct Gemm { const bf16_t* A; const bf16_t* Bt; int M, N, K, kext; };

struct StaticOrder {
    int nM, nN, nwg, G, c, wgm;
    __host__ __device__ void init(int M, int N, int G_, int c_, int wgm_ = WGM) { nM = M / BM; nN = N / BM; nwg = nM * nN; G = G_; c = c_; wgm = wgm_; }
    __host__ __device__ bool next(int i, Unit& u) const { return at((long)i * G + c, u); }
    __host__ __device__ bool at(const long L, Unit& u) const {
        if (L >= nwg) return false;
        int wgid = (int)L; { const int q = nwg / NXCD, r = nwg % NXCD, xcd = wgid % NXCD, off = wgid / NXCD; wgid = (xcd < r ? xcd * (q + 1) : r * (q + 1) + (xcd - r) * q) + off; }
        const int nig = wgm * nN, gid = wgid / nig, fm = gid * wgm, gsz = (nM - fm) < wgm ? (nM - fm) : wgm;
        u.pm = fm + ((wgid % nig) % gsz); u.pn = (wgid % nig) / gsz; return true;
    }
    __device__ __forceinline__ void a_ready(const Unit&) const {}
    __device__ __forceinline__ void done(const Unit&) const {}
};


__device__ __forceinline__ unsigned cvt_pk_bf16(float lo, float hi) { unsigned r; asm volatile("v_cvt_pk_bf16_f32 %0, %1, %2" : "=v"(r) : "v"(lo), "v"(hi)); return r; }
__device__ __forceinline__ float bf_lo(unsigned w) { return __builtin_bit_cast(float, w << 16); }
__device__ __forceinline__ float bf_hi(unsigned w) { return __builtin_bit_cast(float, w & 0xffff0000u); }
__device__ __forceinline__ float sigmoid_f(float x) { return __builtin_amdgcn_rcpf(1.0f + __builtin_amdgcn_exp2f(-1.4426950408889634f * x)); }

constexpr int E_MLAT = 32768, E_NP = 20608;

template <bool I8> struct EpiInT {
    static constexpr bool PERM = true, AFTER_DRAIN = false;
    bf16_t* P; float* G; float* SSQ; const float* bias; const float* rope; int mall; const float* rs; const float* cs;
    __device__ __forceinline__ void operator()(const f32x4 (&acc)[2][2][4][2], const Unit& u, int wr, int wc, int fr, int fq) const {
        asm volatile("" : "+v"(fr), "+v"(fq));
        const int pn = u.pn; const int row0 = u.pm * BM + wr * 64 + fr;
        if constexpr (I8) {
            f32x4 (&A)[2][2][4][2] = const_cast<f32x4 (&)[2][2][4][2]>(acc);
            f32x4 cv[2][2]; float rsv[2][4];
#pragma unroll
            for (int bj = 0; bj < 2; ++bj)
#pragma unroll
                for (int n = 0; n < 2; ++n) cv[bj][n] = *(const f32x4*)(cs + pn * BM + bj * HALF + wc * 32 + 8 * fq + 4 * n);
#pragma unroll
            for (int ai = 0; ai < 2; ++ai)
#pragma unroll
                for (int m = 0; m < 4; ++m) rsv[ai][m] = rs[row0 + ai * HALF + m * 16];
#pragma unroll
            for (int ai = 0; ai < 2; ++ai)
#pragma unroll
                for (int m = 0; m < 4; ++m)
#pragma unroll
                    for (int bj = 0; bj < 2; ++bj)
#pragma unroll
                        for (int n = 0; n < 2; ++n) A[ai][bj][m][n] = __builtin_convertvector(__builtin_bit_cast(i32x4, A[ai][bj][m][n]), f32x4) * (cv[bj][n] * rsv[ai][m]);
        }
        if (pn == 80) {
            if (wc == 0) {
#pragma unroll
                for (int ai = 0; ai < 2; ++ai)
#pragma unroll
                    for (int m = 0; m < 4; ++m) { const int row = row0 + ai * HALF + m * 16;
#pragma unroll
                        for (int n = 0; n < 2; ++n) { const f32x4 bv = *(const f32x4*)(bias + 8192 + 8 * fq + 4 * n);
                            *(f32x4*)(G + (size_t)row * 32 + 8 * fq + 4 * n) = acc[ai][0][m][n] + bv; } }
            }
            return;
        }
        const int colt = pn * BM; const int ocolt = colt < 8192 ? colt : colt + 32; const int cw = wc * 32 + 8 * fq;
        f32x4 bv[2][2];
#pragma unroll
        for (int bj = 0; bj < 2; ++bj)
#pragma unroll
            for (int n = 0; n < 2; ++n) bv[bj][n] = *(const f32x4*)(bias + ocolt + bj * HALF + cw + 4 * n);
        const bool is_rope = pn < 8;
        if (is_rope) {
#pragma unroll
            for (int bj = 0; bj < 2; ++bj) { const float* bh = bias + colt + bj * HALF + 64 * (wc >> 1) + 16 * (wc & 1) + 4 * fq;
                const f32x4 b1 = *(const f32x4*)bh, b2 = *(const f32x4*)(bh + 32);
                bv[bj][0] = (f32x4){b1[0], b2[0], b1[1], b2[1]}; bv[bj][1] = (f32x4){b1[2], b2[2], b1[3], b2[3]}; }
        } const float ksc = (pn >= 4 && pn < 8) ? 0.08838834764831845f : 1.0f;
        const bool is_gz = (pn >= 16 && pn < 32);
        if (is_gz) {
#pragma unroll
            for (int bj = 0; bj < 2; ++bj) { const int cb = 128 * (pn - 16) + 64 * bj + 16 * wc + 4 * fq;
                const f32x4 b1 = *(const f32x4*)(bias + 4096 + cb), b2 = *(const f32x4*)(bias + 6144 + cb);
                bv[bj][0] = (f32x4){b1[0], b2[0], b1[1], b2[1]}; bv[bj][1] = (f32x4){b1[2], b2[2], b1[3], b2[3]}; }
        }
        const bool is_ssq = (pn >= 32 && pn < 48); const int which = pn >= 40 ? 1 : 0; const int hd0 = 2 * (pn - 32 - 8 * which);
        const int blk = wc >> 1, i0 = 16 * (wc & 1) + 4 * fq;
        if (is_rope) {
            const bool latrows = u.pm * BM < E_MLAT;
#pragma unroll
            for (int ah = 0; ah < 4; ++ah) { const int ai = ah >> 1, mh = ah & 1; f32x4 csA[2], csB[2];
#pragma unroll
                for (int mm = 0; mm < 2; ++mm) { const int m = 2 * mh + mm; const int row = row0 + ai * HALF + m * 16; csA[mm] = (f32x4){1.f, 0.f, 1.f, 0.f}; csB[mm] = csA[mm];
                    if (latrows) { const int t = row & 16383; const int pos = blk ? (t & 63) : (t >> 6); csA[mm] = *(const f32x4*)(rope + (size_t)(pos * 32 + i0) * 2); csB[mm] = *(const f32x4*)(rope + (size_t)(pos * 32 + i0) * 2 + 4); } }
#pragma unroll
                for (int mm = 0; mm < 2; ++mm) { const int m = 2 * mh + mm; const int row = row0 + ai * HALF + m * 16; bf16_t* rowp = P + (size_t)row * E_NP + colt + cw; const f32x4 cs0 = csA[mm], cs1 = csB[mm];
#pragma unroll
                    for (int bj = 0; bj < 2; ++bj) { const f32x4 v0 = acc[ai][bj][m][0] + bv[bj][0], v1 = acc[ai][bj][m][1] + bv[bj][1];
                        f32x4 r0, r1;
                        r0[0] = v0[0] * cs0[0] - v0[1] * cs0[1]; r0[1] = v0[0] * cs0[1] + v0[1] * cs0[0]; r0[2] = v0[2] * cs0[2] - v0[3] * cs0[3]; r0[3] = v0[2] * cs0[3] + v0[3] * cs0[2];
                        r1[0] = v1[0] * cs1[0] - v1[1] * cs1[1]; r1[1] = v1[0] * cs1[1] + v1[1] * cs1[0]; r1[2] = v1[2] * cs1[2] - v1[3] * cs1[3]; r1[3] = v1[2] * cs1[3] + v1[3] * cs1[2];
                        r0 = r0 * ksc; r1 = r1 * ksc;
                        u32x4 w; w.x = cvt_pk_bf16(r0[0], r0[1]); w.y = cvt_pk_bf16(r0[2], r0[3]); w.z = cvt_pk_bf16(r1[0], r1[1]); w.w = cvt_pk_bf16(r1[2], r1[3]);
                        *(u32x4*)(rowp + bj * HALF) = w; } } }
            return;
        }
#pragma unroll
        for (int ai = 0; ai < 2; ++ai)
#pragma unroll
            for (int m = 0; m < 4; ++m) { const int row = row0 + ai * HALF + m * 16; bf16_t* rowp = P + (size_t)row * E_NP + colt + cw;
                const f32x4 cs0 = (f32x4){1.f, 0.f, 1.f, 0.f}, cs1 = cs0;
#pragma unroll
                for (int bj = 0; bj < 2; ++bj) { f32x4 v0 = acc[ai][bj][m][0] + bv[bj][0], v1 = acc[ai][bj][m][1] + bv[bj][1];
                    if (is_gz) { const int cb = 128 * (pn - 16) + 64 * bj + 16 * wc + 4 * fq;
                        const float g0 = sigmoid_f(v0[0]) * v0[1] * sigmoid_f(v0[1]), g1 = sigmoid_f(v0[2]) * v0[3] * sigmoid_f(v0[3]), g2 = sigmoid_f(v1[0]) * v1[1] * sigmoid_f(v1[1]), g3 = sigmoid_f(v1[2]) * v1[3] * sigmoid_f(v1[3]);
                        typedef unsigned u32x2e __attribute__((ext_vector_type(2))); u32x2e wz; wz.x = cvt_pk_bf16(g0, g1); wz.y = cvt_pk_bf16(g2, g3);
                        *(u32x2e*)(P + (size_t)row * E_NP + 4096 + cb) = wz; continue; }
                    if (is_rope) {
                        f32x4 r0, r1;
                        r0[0] = v0[0] * cs0[0] - v0[1] * cs0[1]; r0[1] = v0[0] * cs0[1] + v0[1] * cs0[0]; r0[2] = v0[2] * cs0[2] - v0[3] * cs0[3]; r0[3] = v0[2] * cs0[3] + v0[3] * cs0[2];
                        r1[0] = v1[0] * cs1[0] - v1[1] * cs1[1]; r1[1] = v1[0] * cs1[1] + v1[1] * cs1[0]; r1[2] = v1[2] * cs1[2] - v1[3] * cs1[3]; r1[3] = v1[2] * cs1[3] + v1[3] * cs1[2];
                        v0 = r0 * ksc; v1 = r1 * ksc;
                    }
                    if (is_ssq) { float s = (v0[0] * v0[0] + v0[1] * v0[1]) + (v0[2] * v0[2] + v0[3] * v0[3]) + (v1[0] * v1[0] + v1[1] * v1[1]) + (v1[2] * v1[2] + v1[3] * v1[3]);
                        const int ln = fq * 16 + fr; s += __builtin_bit_cast(float, __builtin_amdgcn_ds_bpermute((ln ^ 16) << 2, __builtin_bit_cast(int, s))); s += __builtin_bit_cast(float, __builtin_amdgcn_ds_bpermute((ln ^ 32) << 2, __builtin_bit_cast(int, s)));
                        if (fq == 0) SSQ[(((size_t)which * mall + row) * 16 + hd0 + bj) * 4 + wc] = s; }
                    u32x4 w; w.x = cvt_pk_bf16(v0[0], v0[1]); w.y = cvt_pk_bf16(v0[2], v0[3]); w.z = cvt_pk_bf16(v1[0], v1[1]); w.w = cvt_pk_bf16(v1[2], v1[3]);
                    *(u32x4*)(rowp + bj * HALF) = w; } }
    }
};
typedef EpiInT<false> EpiIn;
typedef EpiInT<true> EpiInQ;

template <int SECOND> struct EpiMerge {
    static constexpr bool PERM = true, AFTER_DRAIN = false;
    const bf16_t* P; int goff; const bf16_t* Tin; bf16_t* O;
    __device__ __forceinline__ void operator()(const f32x4 (&acc)[2][2][4][2], const Unit& u, int wr, int wc, int fr, int fq) const {
        const int row0 = u.pm * BM + wr * 64 + fr; const int col0 = u.pn * BM + wc * 32 + 8 * fq;
#pragma unroll
        for (int ai = 0; ai < 2; ++ai)
#pragma unroll
            for (int m = 0; m < 4; ++m) { const int row = row0 + ai * HALF + m * 16;
#pragma unroll
                for (int bj = 0; bj < 2; ++bj) { const int col = col0 + bj * HALF;
                    const u32x4 gw = *(const u32x4*)(P + (size_t)row * E_NP + goff + col);
                    f32x4 v0 = acc[ai][bj][m][0], v1 = acc[ai][bj][m][1];
                    v0[0] *= sigmoid_f(bf_lo(gw.x)); v0[1] *= sigmoid_f(bf_hi(gw.x)); v0[2] *= sigmoid_f(bf_lo(gw.y)); v0[3] *= sigmoid_f(bf_hi(gw.y));
                    v1[0] *= sigmoid_f(bf_lo(gw.z)); v1[1] *= sigmoid_f(bf_hi(gw.z)); v1[2] *= sigmoid_f(bf_lo(gw.w)); v1[3] *= sigmoid_f(bf_hi(gw.w));
                    if (SECOND) { const u32x4 tw = *(const u32x4*)(Tin + (size_t)row * 2048 + col);
                        v0[0] += bf_lo(tw.x); v0[1] += bf_hi(tw.x); v0[2] += bf_lo(tw.y); v0[3] += bf_hi(tw.y); v1[0] += bf_lo(tw.z); v1[1] += bf_hi(tw.z); v1[2] += bf_lo(tw.w); v1[3] += bf_hi(tw.w); }
                    u32x4 w; w.x = cvt_pk_bf16(v0[0], v0[1]); w.y = cvt_pk_bf16(v0[2], v0[3]); w.z = cvt_pk_bf16(v1[0], v1[1]); w.w = cvt_pk_bf16(v1[2], v1[3]);
                    *(u32x4*)(O + (size_t)row * 2048 + col) = w; } }
    }
};

struct PairOrder {
    StaticOrder base; int single;
    __device__ bool next(int i, Unit& u) const {
        if (single >= 0) { if (i >= 1) return false; const int t = single & 15, br = single >> 4; u.pm = 128 + (t >> 3) + 130 * br; u.pn = (t & 7) + 8 * br; return true; }
        if (!base.next(i >> 1, u)) return false;
        if (i & 1) { u.pm += 130; u.pn += 8; }
        return true; }
    __device__ __forceinline__ void a_ready(const Unit&) const {}
    __device__ __forceinline__ void done(const Unit&) const {}
};
struct MapOrder {
    StaticOrder base; unsigned mask; int i0 = 0, i1 = 1 << 30, n2 = 0, n1 = 0;
    __device__ bool next(int i, Unit& u) const {
        i += i0; if (i >= i1) return false;
        if (n2 > 0 && i >= base.nwg / base.G) {
            const int j = i - base.nwg / base.G, c = base.c; long L = (long)(base.nwg / base.G) * base.G;
            if (c < n2) { if (j >= 2) return false; L += 2 * c + j; } else if (c < n2 + n1) { if (j >= 1) return false; L += 2 * n2 + (c - n2); } else return false;
            if (!base.at(L, u)) return false;
        } else
        if (!base.next(i, u)) return false;
        const int g = u.pn >> 3; int pos = 10, cnt = 0;
#pragma unroll
        for (int b = 0; b < 10; ++b) if ((mask >> b) & 1u) { if (cnt == g) pos = b; ++cnt; }
        u.pn = pos * 8 + (u.pn & 7);
        return true; }
    __device__ __forceinline__ void a_ready(const Unit&) const {}
    __device__ __forceinline__ void done(const Unit&) const {}
};
struct EpiMergePair {
    static constexpr bool PERM = true, AFTER_DRAIN = false;
    const bf16_t* P; bf16_t* T; long yoff; int add_t;
    __device__ __forceinline__ void operator()(const f32x4 (&acc)[2][2][4][2], const Unit& u, int wr, int wc, int fr, int fq) const {
        const bool second = u.pn >= 8; const int pm = second ? u.pm - 130 : u.pm, pn = second ? u.pn - 8 : u.pn; const int goff = second ? 18432 : 16384;
        const int row0 = pm * BM + wr * 64 + fr; const int col0 = pn * BM + wc * 32 + 8 * fq;
        const bool addt = second && add_t;
#pragma unroll
        for (int ai = 0; ai < 2; ++ai) {
            u32x4 gw[4][2], tw[4][2];
#pragma unroll
            for (int m = 0; m < 4; ++m)
#pragma unroll
                for (int bj = 0; bj < 2; ++bj) { const int row = row0 + ai * HALF + m * 16, col = col0 + bj * HALF;
                    gw[m][bj] = *(const u32x4*)(P + (size_t)row * E_NP + goff + col);
                    tw[m][bj] = addt ? *(const u32x4*)(T + (size_t)row * 2048 + col) : (u32x4){0u, 0u, 0u, 0u}; }
#pragma unroll
            for (int m = 0; m < 4; ++m)
#pragma unroll
                for (int bj = 0; bj < 2; ++bj) { const int row = row0 + ai * HALF + m * 16, col = col0 + bj * HALF;
                    const u32x4 g = gw[m][bj], t = tw[m][bj];
                    f32x4 v0 = acc[ai][bj][m][0], v1 = acc[ai][bj][m][1];
                    v0[0] = v0[0] * sigmoid_f(bf_lo(g.x)) + bf_lo(t.x); v0[1] = v0[1] * sigmoid_f(bf_hi(g.x)) + bf_hi(t.x); v0[2] = v0[2] * sigmoid_f(bf_lo(g.y)) + bf_lo(t.y); v0[3] = v0[3] * sigmoid_f(bf_hi(g.y)) + bf_hi(t.y);
                    v1[0] = v1[0] * sigmoid_f(bf_lo(g.z)) + bf_lo(t.z); v1[1] = v1[1] * sigmoid_f(bf_hi(g.z)) + bf_hi(t.z); v1[2] = v1[2] * sigmoid_f(bf_lo(g.w)) + bf_lo(t.w); v1[3] = v1[3] * sigmoid_f(bf_hi(g.w)) + bf_hi(t.w);
                    u32x4 w; w.x = cvt_pk_bf16(v0[0], v0[1]); w.y = cvt_pk_bf16(v0[2], v0[3]); w.z = cvt_pk_bf16(v1[0], v1[1]); w.w = cvt_pk_bf16(v1[2], v1[3]);
                    *(u32x4*)(T + (second ? yoff : 0l) + (size_t)row * 2048 + col) = w; }
        }
        if (!second) asm volatile("s_waitcnt vmcnt(0)" ::: "memory");
    }
};

struct SliceOrder {
    int c;
    __device__ bool next(int i, Unit& u) const { if (i >= 1 || c >= 64) return false; const int t = c >> 2; u.pm = 128 + (t >> 3); u.pn = t & 7; return true; }
    __device__ __forceinline__ void a_ready(const Unit&) const {}
    __device__ __forceinline__ void done(const Unit&) const {}
};
struct EpiPart {
    static constexpr bool PERM = true, AFTER_DRAIN = false;
    float* part;
    __device__ __forceinline__ void operator()(const f32x4 (&acc)[2][2][4][2], const Unit& u, int wr, int wc, int fr, int fq) const {
        const int row0 = (u.pm - 128) * BM + wr * 64 + fr; const int col0 = u.pn * BM + wc * 32 + 8 * fq;
#pragma unroll
        for (int ai = 0; ai < 2; ++ai)
#pragma unroll
            for (int m = 0; m < 4; ++m)
#pragma unroll
                for (int bj = 0; bj < 2; ++bj)
#pragma unroll
                    for (int n = 0; n < 2; ++n) *(f32x4*)(part + (size_t)(row0 + ai * HALF + m * 16) * 2048 + col0 + bj * HALF + 4 * n) = acc[ai][bj][m][n];
    }
};

struct EpiOut {
    static constexpr bool PERM = true, AFTER_DRAIN = false;
    const float* xin_lat; float* xout_lat; const float* xin_ctx; float* xout_ctx; const float* mod; const float* bout;
    __device__ __forceinline__ void operator()(const f32x4 (&acc)[2][2][4][2], const Unit& u, int wr, int wc, int fr, int fq) const {
        const int row0 = u.pm * BM + wr * 64 + fr; const int col0 = u.pn * BM + wc * 32 + 8 * fq;
        const bool lat = u.pm * BM < E_MLAT; const int jb = lat ? ((u.pm * BM) >> 14) : 2;
        const float* gt = mod + jb * 6144 + 4096;
        f32x4 gv[2][2], bo[2][2];
#pragma unroll
        for (int bj = 0; bj < 2; ++bj)
#pragma unroll
            for (int n = 0; n < 2; ++n) { const int col = col0 + bj * HALF + 4 * n; gv[bj][n] = *(const f32x4*)(gt + col); bo[bj][n] = *(const f32x4*)(bout + col); }
#pragma unroll
        for (int ai = 0; ai < 2; ++ai)
#pragma unroll
            for (int mh = 0; mh < 2; ++mh) {
                f32x4 xv[2][2][2];
#pragma unroll
                for (int mm = 0; mm < 2; ++mm) { const int row = row0 + ai * HALF + (2 * mh + mm) * 16;
                    const float* xi = lat ? xin_lat + (size_t)row * 2048 : xin_ctx + (size_t)(row - E_MLAT) * 2048;
#pragma unroll
                    for (int bj = 0; bj < 2; ++bj)
#pragma unroll
                        for (int n = 0; n < 2; ++n) xv[mm][bj][n] = *(const f32x4*)(xi + col0 + bj * HALF + 4 * n); }
#pragma unroll
                for (int mm = 0; mm < 2; ++mm) { const int m = 2 * mh + mm, row = row0 + ai * HALF + m * 16;
                    float* xo = lat ? xout_lat + (size_t)row * 2048 : xout_ctx + (size_t)(row - E_MLAT) * 2048;
#pragma unroll
                    for (int bj = 0; bj < 2; ++bj)
#pragma unroll
                        for (int n = 0; n < 2; ++n) {
#if defined(DBG_MODE) && DBG_MODE == 1
                            *(f32x4*)(xo + col0 + bj * HALF + 4 * n) = xv[mm][bj][n];
#else
                            *(f32x4*)(xo + col0 + bj * HALF + 4 * n) = xv[mm][bj][n] + gv[bj][n] * (acc[ai][bj][m][n] + bo[bj][n]);
#endif
                        } }
            }
    }
};
template <class Epi, class Sched, bool ALIGN_EPI = false, bool SP2 = false, bool I8 = false>
__device__ __forceinline__ void gemm_phase(PG8_LAS unsigned char* lds, const Gemm g, const Sched& S, const Epi& E, const int wid_in) {
    int lane_o; asm volatile("v_mbcnt_lo_u32_b32 %0, -1, 0\n\tv_mbcnt_hi_u32_b32 %0, -1, %0" : "=v"(lane_o)); const int tid = wid_in * 64 + lane_o;
    const int wid = wid_in, lane = lane_o, wr = wid >> 2, wc = wid & 3, fr = lane & 15, fq = lane >> 4;
    const int K = g.K, nt = g.kext / BK;
    unsigned voffA[2], voffB[2];
#pragma unroll
    for (int i = 0; i < 2; ++i) { int R, C; stage_rc(tid * 16 + i * 8192, R, C); const int Rb = Epi::PERM ? ((R & ~31) + perm32(R & 31)) : R;
        voffA[i] = (unsigned)(R * K + C) * 2u; voffB[i] = (unsigned)(Rb * K + C) * 2u; }
    const size_t kstep = (size_t)(BK * 2);
    const size_t hstep = (size_t)HALF * K * 2;
    const size_t tstep = 2 * hstep;
    const unsigned ldsw = (unsigned)wid * 1024u;
    const int aoff = lds_byte(wr * 64 + fr, fq * 8), boff = lds_byte(wc * 32 + fr, fq * 8);
#define PG8_SA(b, h) (((b) * 2 + (h)) * HTB)
#define PG8_SB(b, h) ((4 + (b) * 2 + (h)) * HTB)
#define PG8_STAGE(bufoff, gbase, voff) do { _Pragma("unroll") for (int _i = 0; _i < 2; ++_i) \
        __builtin_amdgcn_global_load_lds((const unsigned*)((const char*)(gbase) + (voff)[_i]), (PG8_LAS unsigned*)(lds + (bufoff) + ldsw + _i * 8192), 16, 0, 0); } while (0)
#define PG8_LDA(dst, b, h) do { _Pragma("unroll") for (int m = 0; m < 4; ++m) _Pragma("unroll") for (int k = 0; k < 2; ++k) dst[m][k] = *(const PG8_LAS bf16x8*)(lds + PG8_SA(b, h) + aoff + m * 2048 + k * 1024); } while (0)
#define PG8_LDB(dst, b, h) do { _Pragma("unroll") for (int n = 0; n < 2; ++n) _Pragma("unroll") for (int k = 0; k < 2; ++k) dst[n][k] = *(const PG8_LAS bf16x8*)(lds + PG8_SB(b, h) + boff + n * 2048 + k * 1024); } while (0)
#define PG8_MMA(ai, bj, At, Bt) do { __builtin_amdgcn_s_setprio(1); _Pragma("unroll") for (int m = 0; m < 4; ++m) _Pragma("unroll") for (int n = 0; n < 2; ++n) _Pragma("unroll") for (int k = 0; k < 2; ++k) \
        { if constexpr (I8) acc[ai][bj][m][n] = __builtin_bit_cast(f32x4, __builtin_amdgcn_mfma_i32_16x16x64_i8(__builtin_bit_cast(i32x4, Bt[n][k]), __builtin_bit_cast(i32x4, At[m][k]), __builtin_bit_cast(i32x4, acc[ai][bj][m][n]), 0, 0, 0)); \
          else acc[ai][bj][m][n] = __builtin_amdgcn_mfma_f32_16x16x32_bf16(Bt[n][k], At[m][k], acc[ai][bj][m][n], 0, 0, 0); } __builtin_amdgcn_s_setprio(0); } while (0)
#define PG8_WAIT_V(n) asm volatile("s_waitcnt vmcnt(" #n ")" ::: "memory")
#define PG8_WAIT_L(n) asm volatile("s_waitcnt lgkmcnt(" #n ")" ::: "memory")
#define PG8_BAR __builtin_amdgcn_s_barrier()
#define PG8_SCHED __builtin_amdgcn_sched_barrier(0)
    Unit cur, nxt; int ui = 0;
    if (!S.next(0, cur)) return;
    f32x4 acc[2][2][4][2];
#pragma unroll
    for (int a = 0; a < 2; ++a)
#pragma unroll
        for (int b = 0; b < 2; ++b)
#pragma unroll
            for (int m = 0; m < 4; ++m)
#pragma unroll
                for (int n = 0; n < 2; ++n) acc[a][b][m][n] = (f32x4){0.f, 0.f, 0.f, 0.f};
    bf16x8 At[4][2], B0[2][2], B1[2][2];
    const char* cA = (const char*)g.A + (size_t)cur.pm * tstep; const char* cB = (const char*)g.Bt + (size_t)cur.pn * tstep;
    S.a_ready(cur);
    if constexpr (SP2) {
        PG8_STAGE(PG8_SB(0, 0), cB, voffB); PG8_STAGE(PG8_SB(0, 1), cB + hstep, voffB); PG8_STAGE(PG8_SA(0, 0), cA, voffA); PG8_STAGE(PG8_SA(0, 1), cA + hstep, voffA);
        if (wr == 1) PG8_BAR;
        PG8_WAIT_V(2); PG8_BAR;
        PG8_STAGE(PG8_SB(1, 0), cB + kstep, voffB); PG8_STAGE(PG8_SA(1, 0), cA + kstep, voffA); PG8_STAGE(PG8_SB(1, 1), cB + hstep + kstep, voffB);
        PG8_WAIT_V(6); PG8_BAR;
    } else {
        PG8_STAGE(PG8_SB(0, 0), cB, voffB); PG8_STAGE(PG8_SA(0, 0), cA, voffA); PG8_STAGE(PG8_SB(0, 1), cB + hstep, voffB); PG8_STAGE(PG8_SA(0, 1), cA + hstep, voffA);
        if (wr == 1) PG8_BAR;
        PG8_WAIT_V(4); PG8_BAR;
        PG8_STAGE(PG8_SB(1, 0), cB + kstep, voffB); PG8_STAGE(PG8_SA(1, 0), cA + kstep, voffA); PG8_STAGE(PG8_SB(1, 1), cB + hstep + kstep, voffB);
        PG8_WAIT_V(6); PG8_BAR;
    }
    for (;;) {
        const bool has_next = S.next(ui + 1, nxt);
        const char* nA = has_next ? (const char*)g.A + (size_t)nxt.pm * tstep : cA; const char* nB = has_next ? (const char*)g.Bt + (size_t)nxt.pn * tstep : cB;
        for (int t = 0; t < nt; t += 2) {
            const bool last = (t == nt - 2);
            const char* a1 = cA + (size_t)(t + 1) * kstep;
            const char* a2 = last ? nA : cA + (size_t)(t + 2) * kstep; const char* b2 = last ? nB : cB + (size_t)(t + 2) * kstep;
            const char* a3 = a2 + kstep; const char* b3 = b2 + kstep;
            if (last && has_next) S.a_ready(nxt);
            if constexpr (SP2) {
            PG8_LDB(B0, 0, 0); PG8_LDB(B1, 0, 1); PG8_SCHED; PG8_LDA(At, 0, 0); PG8_STAGE(PG8_SA(1, 1), a1 + hstep, voffA);
            PG8_WAIT_V(8); PG8_WAIT_L(0); PG8_BAR; PG8_MMA(0, 0, At, B0); PG8_MMA(0, 1, At, B1); PG8_BAR; PG8_SCHED;
            PG8_LDA(At, 0, 1); PG8_STAGE(PG8_SB(0, 0), b2, voffB); PG8_STAGE(PG8_SB(0, 1), b2 + hstep, voffB); PG8_STAGE(PG8_SA(0, 0), a2, voffA);
            PG8_WAIT_V(8); PG8_WAIT_L(0); PG8_BAR; PG8_MMA(1, 0, At, B0); PG8_MMA(1, 1, At, B1); PG8_BAR; PG8_SCHED;
            PG8_LDB(B0, 1, 0); PG8_LDB(B1, 1, 1); PG8_SCHED; PG8_LDA(At, 1, 0); PG8_STAGE(PG8_SA(0, 1), a2 + hstep, voffA);
            PG8_WAIT_V(8); PG8_WAIT_L(0); PG8_BAR; PG8_MMA(0, 0, At, B0); PG8_MMA(0, 1, At, B1); PG8_BAR; PG8_SCHED;
            PG8_LDA(At, 1, 1); PG8_STAGE(PG8_SB(1, 0), b3, voffB); PG8_STAGE(PG8_SB(1, 1), b3 + hstep, voffB); PG8_STAGE(PG8_SA(1, 0), a3, voffA);
            PG8_WAIT_V(8); PG8_WAIT_L(0); PG8_BAR; PG8_MMA(1, 0, At, B0); PG8_MMA(1, 1, At, B1); PG8_BAR; PG8_SCHED;
            } else {
            PG8_LDB(B0, 0, 0); PG8_SCHED; PG8_LDA(At, 0, 0); PG8_STAGE(PG8_SA(1, 1), a1 + hstep, voffA);
            PG8_WAIT_L(8); PG8_BAR; PG8_WAIT_L(0); PG8_MMA(0, 0, At, B0); PG8_BAR; PG8_SCHED;
            PG8_LDB(B1, 0, 1); PG8_STAGE(PG8_SB(0, 0), b2, voffB);
            PG8_BAR; PG8_WAIT_L(0); PG8_MMA(0, 1, At, B1); PG8_BAR;
            PG8_LDA(At, 0, 1); PG8_STAGE(PG8_SA(0, 0), a2, voffA);
            PG8_BAR; PG8_WAIT_L(0); PG8_MMA(1, 0, At, B0); PG8_BAR; PG8_SCHED;
            PG8_STAGE(PG8_SB(0, 1), b2 + hstep, voffB);
            PG8_WAIT_V(6); PG8_BAR; PG8_MMA(1, 1, At, B1); PG8_BAR;
            PG8_LDB(B0, 1, 0); PG8_SCHED; PG8_LDA(At, 1, 0); PG8_STAGE(PG8_SA(0, 1), a2 + hstep, voffA);
            PG8_WAIT_L(8); PG8_BAR; PG8_WAIT_L(0); PG8_MMA(0, 0, At, B0); PG8_BAR; PG8_SCHED;
            PG8_LDB(B1, 1, 1); PG8_STAGE(PG8_SB(1, 0), b3, voffB);
            PG8_BAR; PG8_WAIT_L(0); PG8_MMA(0, 1, At, B1); PG8_BAR;
            PG8_LDA(At, 1, 1); PG8_STAGE(PG8_SA(1, 0), a3, voffA);
            PG8_BAR; PG8_WAIT_L(0); PG8_MMA(1, 0, At, B0); PG8_BAR; PG8_SCHED;
            PG8_STAGE(PG8_SB(1, 1), b3 + hstep, voffB);
            PG8_WAIT_V(6); PG8_BAR; PG8_MMA(1, 1, At, B1); PG8_BAR;
            }
        }
        if constexpr (ALIGN_EPI) { if (wr == 0) PG8_BAR; }
        if constexpr (!Epi::AFTER_DRAIN) { E(acc, cur, wr, wc, fr, fq); S.done(cur); }
        if (!has_next) break;
#pragma unroll
        for (int a = 0; a < 2; ++a)
#pragma unroll
            for (int b = 0; b < 2; ++b)
#pragma unroll
                for (int m = 0; m < 4; ++m)
#pragma unroll
                    for (int n = 0; n < 2; ++n) acc[a][b][m][n] = (f32x4){0.f, 0.f, 0.f, 0.f};
        cur = nxt; cA = nA; cB = nB; ++ui;
        if constexpr (ALIGN_EPI) { if (wr == 1) PG8_BAR; }
    }
    PG8_WAIT_V(0);
    if constexpr (!ALIGN_EPI) { if (wr == 0) PG8_BAR; }
    PG8_BAR;
    if constexpr (Epi::AFTER_DRAIN) { E.fused(acc, cur, wr, wc, fr, fq, lds, wid, lane); S.done(cur); }
#undef PG8_SA
#undef PG8_SB
#undef PG8_STAGE
#undef PG8_LDA
#undef PG8_LDB
#undef PG8_MMA
#undef PG8_WAIT_V
#undef PG8_WAIT_L
#undef PG8_BAR
#undef PG8_SCHED
}
}
#define GAS __attribute__((address_space(1)))
#define LAS __attribute__((address_space(3)))
typedef unsigned short bf16;
typedef unsigned v4u __attribute__((ext_vector_type(4)));
typedef float f32x4 __attribute__((ext_vector_type(4)));
typedef short bf16x8 __attribute__((ext_vector_type(8)));
typedef GAS unsigned gu32;
typedef GAS unsigned long long gu64;
#define RLX_AGENT __ATOMIC_RELAXED, __HIP_MEMORY_SCOPE_AGENT
#define LDS_WAIT() asm volatile("s_waitcnt lgkmcnt(0)" ::: "memory")
#define VM_WAIT() asm volatile("s_waitcnt vmcnt(0)" ::: "memory")
__device__ __forceinline__ unsigned long long rt() { return __builtin_amdgcn_s_memrealtime(); }
__device__ __forceinline__ unsigned f2bf(float f) { unsigned u = __builtin_bit_cast(unsigned, f); return (u + 0x7fffu + ((u >> 16) & 1u)) >> 16; }
__device__ __forceinline__ unsigned pk2(float lo, float hi) { return f2bf(lo) | (f2bf(hi) << 16); }

#define XB_TMO      128
#define XB_XCNT(j)  (256  + 64 * (j))
#define XB_XSUB(j)  (1280 + 64 * (j))
#define XB_XGEN(j)  (2304 + 64 * (j))
#define XB_TOP      3328
#define XB_TOPGEN   3392
#define XCD_BAR_WORDS 3456
#define XB_SPIN_CAP (1u << 18)

__device__ __forceinline__ unsigned xb_ld(unsigned* p)              { return __hip_atomic_load(p, __ATOMIC_RELAXED, __HIP_MEMORY_SCOPE_AGENT); }
__device__ __forceinline__ unsigned xb_add(unsigned* p, unsigned v) { return __hip_atomic_fetch_add(p, v, __ATOMIC_RELAXED, __HIP_MEMORY_SCOPE_AGENT); }
__device__ __forceinline__ unsigned xb_xcc_id() { return (unsigned)__builtin_amdgcn_s_getreg((3 << 11) | 20) & 0xFu; }
#define XB_SPIN(cond, bar) do { unsigned _sp = 0; while (cond) { __builtin_amdgcn_s_sleep(1); \
    if ((++_sp & 255u) == 0u) { if (xb_ld(&(bar)[XB_TMO])) break; if (_sp > XB_SPIN_CAP) { atomicAdd(&(bar)[XB_TMO], 1u); break; } } } } while (0)

struct XcdBarrier {
    unsigned* bar; unsigned x;
    volatile LAS unsigned* st;
};

__device__ __forceinline__ XcdBarrier xcd_barrier_post(unsigned* bar, volatile LAS unsigned* st) {
    XcdBarrier b; b.bar = bar; b.x = xb_xcc_id(); b.st = st;
    if (threadIdx.x == 0) (void)xb_add(&bar[XB_XCNT(b.x)], 1u);
    return b;
}
__device__ __forceinline__ void xcd_barrier_complete(unsigned* bar, unsigned x, unsigned& nloc, unsigned& nx) {
    const unsigned G = gridDim.x * gridDim.y * gridDim.z;
    unsigned sum, cnt, mine, sp = 0u;
    for (;;) {
        sum = 0u; cnt = 0u; mine = 0u;
#pragma unroll
        for (unsigned j = 0; j < 16; ++j) { const unsigned c = xb_ld(&bar[XB_XCNT(j)]); sum += c; cnt += (c > 0u) ? 1u : 0u; mine = (j == x) ? c : mine; }
        if (sum == G) break;
        __builtin_amdgcn_s_sleep(1);
        if ((++sp & 255u) == 0u) { if (xb_ld(&bar[XB_TMO])) break; if (sp > XB_SPIN_CAP) { atomicAdd(&bar[XB_TMO], 1u); break; } }
    }
    nloc = mine > 0u ? mine : 1u; nx = cnt > 0u ? cnt : 1u;
}

__device__ __forceinline__ void xcd_barrier(const XcdBarrier& b) {
    asm volatile("s_waitcnt vmcnt(0)" ::: "memory");
    __syncthreads();
    if (threadIdx.x == 0) {
        unsigned* bar = b.bar;
        __builtin_amdgcn_s_waitcnt(0);
        unsigned nloc = b.st[0], nx = b.st[1];
        if (nloc == 0u) { xcd_barrier_complete(bar, b.x, nloc, nx); b.st[0] = nloc; b.st[1] = nx; }
        const unsigned old = xb_add(&bar[XB_XSUB(b.x)], 1u);
        const unsigned gen = old / nloc;
        if (old + 1u == (gen + 1u) * nloc) {
            __builtin_amdgcn_fence(__ATOMIC_RELEASE, "agent");
            asm volatile("s_waitcnt vmcnt(0)" ::: "memory");
            const unsigned og = xb_add(&bar[XB_TOP], 1u);
            const unsigned tg = og / nx;
            if (og + 1u == (tg + 1u) * nx) xb_add(&bar[XB_TOPGEN], 1u);
            else XB_SPIN(xb_ld(&bar[XB_TOPGEN]) == tg, bar);
            __builtin_amdgcn_fence(__ATOMIC_ACQUIRE, "agent");
            xb_add(&bar[XB_XGEN(b.x)], 1u);
            asm volatile("s_waitcnt vmcnt(0)" ::: "memory");
        } else {
            XB_SPIN(xb_ld(&bar[XB_XGEN(b.x)]) == gen, bar);
            __builtin_amdgcn_fence(__ATOMIC_ACQUIRE, "agent");
            asm volatile("s_waitcnt vmcnt(0)" ::: "memory");
        }
    }
    __syncthreads();
}


#ifndef G1_I8
#define G1_I8 1
#endif
#ifndef I8_MASK
#define I8_MASK 0x3FEu
#endif
#ifndef G1_WGMQ
#define G1_WGMQ 5
#endif
#ifndef G1_BAL
#define G1_BAL 0
#endif
#ifndef G1_STAGGER
#define G1_STAGGER 0
#endif
#define I8_TILE(pn) ((pn) < 80 && ((I8_MASK >> ((pn) >> 3)) & 1u))
#define I8_NT (8 * __builtin_popcount(I8_MASK))
constexpr int NWAVES = 8;
constexpr int DM = 2048, NBATCH = 2, SEQ = 16384, CTXL = 256, DEPTH = 4;
constexpr int MLAT = NBATCH * SEQ, MCTX = NBATCH * CTXL, MALL = MLAT + MCTX;
constexpr int NIN = 20512, NP = 20608, NPAD = 20736;
constexpr int OFF_AQ = 0, OFF_AK = 1024, OFF_AV = 2048, OFF_AO = 4096, OFF_AZ = 6144, OFF_BQ = 8192, OFF_BK = 10240, OFF_BV = 12288, OFF_BZ = 14336, OFF_GA = 16384, OFF_GB = 18432;
constexpr float EPS = 1e-6f;
static_assert(MALL % 256 == 0 && NPAD % 256 == 0 && pg8::E_MLAT == MLAT && pg8::E_NP == NP, "shapes");

constexpr size_t MiB = 1u << 20;
constexpr size_t WS_CTL = 0, CTL_ZERO_BYTES = 1 * MiB;
constexpr size_t WS_MOD = 1 * MiB;
constexpr size_t WS_ROPE = 1 * MiB + 512 * 1024;
constexpr size_t WS_XC = 2 * MiB;
constexpr size_t WS_G = 6 * MiB;
constexpr size_t WS_SSQ = 11 * MiB;
constexpr size_t WS_STC = 28 * MiB;
constexpr size_t WS_STN = 64 * MiB;
constexpr size_t WS_STS = 64 * MiB + 256 * 1024;
constexpr size_t WS_WIN = 65 * MiB;
constexpr size_t WS_WAB = 389 * MiB;
constexpr size_t WS_WO = 453 * MiB;
constexpr size_t WS_H = 485 * MiB;
constexpr size_t WS_YB = 615 * MiB;
constexpr size_t WS_HF = 745 * MiB;
constexpr size_t WS_HB = 875 * MiB;
constexpr size_t WS_P = 1005 * MiB;
constexpr size_t WS_PART = 2320 * MiB;
constexpr size_t WS_WQ = 2336 * MiB;
constexpr size_t WS_CS = 2498 * MiB;
constexpr size_t WS_RS = 2498 * MiB + 512 * 1024;
constexpr size_t WS_HQ = WS_YB;
constexpr size_t WS_END = 2499 * MiB;
static_assert(WS_WQ + (size_t)4 * NPAD * 2048 <= WS_CS && WS_CS + (size_t)4 * NPAD * 4 <= WS_RS && WS_RS + (size_t)MALL * 4 <= WS_END, "ws map 3");
static_assert(WS_G + (size_t)MALL * 32 * 4 <= WS_SSQ && WS_SSQ + (size_t)2 * MALL * 64 * 4 <= WS_STC && WS_STC + (size_t)288 * 131072 <= WS_STN, "ws map 1");
static_assert(WS_WIN + (size_t)4 * NPAD * 2048 * 2 <= WS_WAB && WS_H + (size_t)MALL * 2048 * 2 <= WS_YB && WS_P + (size_t)MALL * NP * 2 <= WS_END, "ws map 2");
constexpr int CW_BAR = 4096;

constexpr int RING_BYTES = 131072;
constexpr int MISC_OFF = RING_BYTES + 320;
constexpr int LDS_BYTES = 147456;

typedef short s16x4 __attribute__((ext_vector_type(4)));
typedef float f32x16 __attribute__((ext_vector_type(16)));
typedef unsigned v2u __attribute__((ext_vector_type(2)));
typedef float f32x2 __attribute__((ext_vector_type(2)));
typedef __bf16 bf16x2_t __attribute__((ext_vector_type(2)));
__device__ __forceinline__ unsigned pkh(float lo, float hi) { f32x2 v = {lo, hi}; bf16x2_t b = __builtin_convertvector(v, bf16x2_t); return __builtin_bit_cast(unsigned, b); }
#define MFMA32(a, b, c) __builtin_amdgcn_mfma_f32_32x32x16_bf16((a), (b), (c), 0, 0, 0)
#define MFMA16(a, b, c) __builtin_amdgcn_mfma_f32_16x16x32_bf16((a), (b), (c), 0, 0, 0)

__device__ __forceinline__ float bf2f(unsigned short x) { return __builtin_bit_cast(float, (unsigned)x << 16); }
__device__ __forceinline__ float bflo(unsigned w) { return __builtin_bit_cast(float, w << 16); }
__device__ __forceinline__ float bfhi(unsigned w) { return __builtin_bit_cast(float, w & 0xffff0000u); }
__device__ __forceinline__ float sigm(float x) { return __builtin_amdgcn_rcpf(1.0f + __builtin_amdgcn_exp2f(-1.4426950408889634f * x)); }
__device__ __forceinline__ float silu(float x) { return x * __builtin_amdgcn_rcpf(1.0f + __builtin_amdgcn_exp2f(-1.4426950408889634f * x)); }
__device__ __forceinline__ int crow(int reg, int h) { return (reg & 3) + 8 * (reg >> 2) + 4 * h; }
__device__ __forceinline__ float shx(float v, int mask, int lane) { return __builtin_bit_cast(float, __builtin_amdgcn_ds_bpermute((lane ^ mask) << 2, __builtin_bit_cast(int, v))); }
__device__ __forceinline__ float shi(float v, int src, int lane) { (void)lane; return __builtin_bit_cast(float, __builtin_amdgcn_ds_bpermute(src << 2, __builtin_bit_cast(int, v))); }
__device__ __forceinline__ float shup(float v, int d, int lane) { return __builtin_bit_cast(float, __builtin_amdgcn_ds_bpermute((lane >= d ? lane - d : lane) << 2, __builtin_bit_cast(int, v))); }
__device__ __forceinline__ float wave_sum(float v, int lane) {
#pragma unroll
    for (int o = 1; o < 64; o <<= 1) v += shx(v, o, lane);
    return v;
}
__device__ __forceinline__ s16x4 tr_read(const LAS unsigned char* p) { return __builtin_bit_cast(s16x4, __builtin_amdgcn_ds_read_tr16_b64_v4i16((LAS s16x4*)p)); }
__device__ __forceinline__ bf16x8 cat8(s16x4 lo, s16x4 hi) { return __builtin_shufflevector(lo, hi, 0, 1, 2, 3, 4, 5, 6, 7); }
__device__ __forceinline__ int fresh_lane() { int l; asm volatile("v_mbcnt_lo_u32_b32 %0, -1, 0\n\tv_mbcnt_hi_u32_b32 %0, -1, %0" : "=v"(l)); return l; }
#define LBAR() asm volatile("s_waitcnt lgkmcnt(0)\n\ts_barrier" ::: "memory")
__device__ __forceinline__ void pair_swap(v2u& a, v2u& b) {
    auto r0 = __builtin_amdgcn_permlane32_swap(a.x, b.x, false, false); a.x = r0[0]; b.x = r0[1];
    auto r1 = __builtin_amdgcn_permlane32_swap(a.y, b.y, false, false); a.y = r1[0]; b.y = r1[1];
}
__device__ __forceinline__ int clampi(int v, int lo, int hi) { return v < lo ? lo : (v > hi ? hi : v); }

struct Args { const float* in[17]; float* out; unsigned char* ws; int ph_lo, ph_hi; };

__device__ __forceinline__ void transpose_item(const float* W, int K, int N, bf16* WT, int dst_row0, int rstride, int k0, int n0, LAS float* scr, int lane) {
    { f32x4 v[8];
#pragma unroll
        for (int i = 0; i < 8; ++i) v[i] = *(const GAS f32x4*)(W + (size_t)(k0 + 8 * i + (lane >> 3)) * N + n0 + 4 * (lane & 7));
#pragma unroll
        for (int i = 0; i < 8; ++i) { LAS float* d = scr + (8 * i + (lane >> 3)) * 33 + 4 * (lane & 7); d[0] = v[i].x; d[1] = v[i].y; d[2] = v[i].z; d[3] = v[i].w; } }
    LDS_WAIT(); asm volatile("" ::: "memory");
    const int c = lane & 7;
#pragma unroll
    for (int j = 0; j < 4; ++j) { const int n = (lane >> 3) + 8 * j; const LAS float* s = scr + (8 * c) * 33 + n;
        v4u o; o.x = pkh(s[0 * 33], s[1 * 33]); o.y = pkh(s[2 * 33], s[3 * 33]); o.z = pkh(s[4 * 33], s[5 * 33]); o.w = pkh(s[6 * 33], s[7 * 33]);
        *(GAS v4u*)(WT + (size_t)(dst_row0 + n * rstride) * K + k0 + 8 * c) = o; }
    LDS_WAIT(); asm volatile("" ::: "memory");
}

__constant__ float ROPE_INV[32] = {
1.000000000e+00f, 7.498942614e-01f, 5.623413324e-01f, 4.216965139e-01f, 3.162277639e-01f, 2.371373773e-01f, 1.778279394e-01f, 1.333521307e-01f, 1.000000015e-01f, 7.498941571e-02f, 5.623413250e-02f, 4.216965288e-02f, 3.162277490e-02f, 2.371373773e-02f, 1.778279431e-02f, 1.333521493e-02f, 9.999999776e-03f, 7.498941850e-03f, 5.623413250e-03f, 4.216964822e-03f, 3.162277630e-03f, 2.371373586e-03f, 1.778279431e-03f, 1.333521446e-03f, 1.000000047e-03f, 7.498942432e-04f, 5.623413017e-04f, 4.216965172e-04f, 3.162277571e-04f, 2.371373703e-04f, 1.778279402e-04f, 1.333521504e-04f
};

__device__ __forceinline__ float wave_max(float v, int lane) {
#pragma unroll
    for (int o = 1; o < 64; o <<= 1) v = fmaxf(v, shx(v, o, lane));
    return v;
}
__device__ __forceinline__ unsigned pack_i8(float a, float b, float c, float d) {
    const unsigned ua = __builtin_bit_cast(unsigned, a + 12582912.0f), ub = __builtin_bit_cast(unsigned, b + 12582912.0f), uc = __builtin_bit_cast(unsigned, c + 12582912.0f), ud = __builtin_bit_cast(unsigned, d + 12582912.0f);
    return (ua & 0xffu) | ((ub & 0xffu) << 8) | ((uc & 0xffu) << 16) | (ud << 24);
}
constexpr int SLAB_RS = 4104, SLAB_WMAX = 132096, SLAB_SLOT = 133120, CW_SLAB = 64;
__device__ __forceinline__ void win_slab_item(const Args& a, LAS unsigned char* lds, int l, int nb, int tid, int lane, int wave) {
    unsigned char* ws = a.ws;
    const float* W = a.in[7] + (size_t)l * 2048 * NIN + 32 * nb;
    LAS float* wmax = (LAS float*)(lds + SLAB_WMAX);
    const int cg = tid & 7, kr2 = tid >> 3;
    f32x4 mxv = {0.f, 0.f, 0.f, 0.f};
    for (int s0 = 0; s0 < 16; s0 += 8) {
        f32x4 v0[8], v1[8];
#pragma unroll
        for (int s = 0; s < 8; ++s) { const int k = 2 * kr2 + 128 * (s0 + s); v0[s] = *(const GAS f32x4*)(W + (size_t)k * NIN + 4 * cg); v1[s] = *(const GAS f32x4*)(W + (size_t)(k + 1) * NIN + 4 * cg); }
#pragma unroll
        for (int s = 0; s < 8; ++s) { const int k = 2 * kr2 + 128 * (s0 + s);
            LAS unsigned char* d = lds + (4 * cg) * SLAB_RS + 2 * k;
            const unsigned p0 = pkh(v0[s].x, v1[s].x), p1 = pkh(v0[s].y, v1[s].y), p2 = pkh(v0[s].z, v1[s].z), p3 = pkh(v0[s].w, v1[s].w);
            *(LAS unsigned*)(d) = p0; *(LAS unsigned*)(d + SLAB_RS) = p1; *(LAS unsigned*)(d + 2 * SLAB_RS) = p2; *(LAS unsigned*)(d + 3 * SLAB_RS) = p3;
            mxv.x = fmaxf(mxv.x, fmaxf(__builtin_fabsf(bflo(p0)), __builtin_fabsf(bfhi(p0)))); mxv.y = fmaxf(mxv.y, fmaxf(__builtin_fabsf(bflo(p1)), __builtin_fabsf(bfhi(p1))));
            mxv.z = fmaxf(mxv.z, fmaxf(__builtin_fabsf(bflo(p2)), __builtin_fabsf(bfhi(p2)))); mxv.w = fmaxf(mxv.w, fmaxf(__builtin_fabsf(bflo(p3)), __builtin_fabsf(bfhi(p3)))); }
    }
#pragma unroll
    for (int o = 8; o < 64; o <<= 1) { mxv.x = fmaxf(mxv.x, shx(mxv.x, o, lane)); mxv.y = fmaxf(mxv.y, shx(mxv.y, o, lane)); mxv.z = fmaxf(mxv.z, shx(mxv.z, o, lane)); mxv.w = fmaxf(mxv.w, shx(mxv.w, o, lane)); }
    if (lane < 8) *(LAS f32x4*)(wmax + wave * 32 + 4 * lane) = mxv;
    __syncthreads();
    int dst = nb < 256 ? 32 * nb : (nb == 256 ? 20480 : 32 * nb - 32), rstr = 1;
    if (nb < 64) { const int n0 = 32 * nb, w0 = n0 & 127; dst = (n0 & ~127) + 64 * (w0 >> 6) + ((w0 >> 5) & 1); rstr = 2; }
    else if (nb >= 128 && nb < 192) { dst = 4096 + 2 * (32 * nb - 4096); rstr = 2; }
    else if (nb >= 192 && nb < 256) { dst = 4096 + 2 * (32 * nb - 6144) + 1; rstr = 2; }
#pragma unroll 1
    for (int cc = 0; cc < 4; ++cc) { const int col = 4 * wave + cc, drow = dst + col * rstr;
        float mx = 0.f;
#pragma unroll
        for (int w = 0; w < 8; ++w) mx = fmaxf(mx, wmax[w * 32 + col]);
        const LAS unsigned char* src = lds + col * SLAB_RS + 8 * lane;
        v2u p[8];
#pragma unroll
        for (int i = 0; i < 8; ++i) p[i] = *(const LAS v2u*)(src + 512 * i);
        if (I8_TILE(drow >> 8)) {
            mx = fmaxf(mx, 1e-30f); const float inv = 127.0f * __builtin_amdgcn_rcpf(mx);
            GAS unsigned* o = (GAS unsigned*)(ws + WS_WQ + ((size_t)l * NPAD + drow) * 2048) + lane;
#pragma unroll
            for (int i = 0; i < 8; ++i) o[64 * i] = pack_i8(bflo(p[i].x) * inv, bfhi(p[i].x) * inv, bflo(p[i].y) * inv, bfhi(p[i].y) * inv);
            if (lane == 0) ((float*)(ws + WS_CS))[(size_t)l * NPAD + drow] = mx * (1.0f / 127.0f);
        } else {
            GAS v2u* o = (GAS v2u*)(ws + WS_WIN + ((size_t)l * NPAD + drow) * 4096) + lane;
#pragma unroll
            for (int i = 0; i < 8; ++i) o[64 * i] = p[i];
        }
    }
}

__device__ __forceinline__ void prologue(const Args& a, LAS unsigned char* lds, int tid, int lane, int wave, int rep = 0) {
    unsigned char* ws = a.ws;
    const int G = gridDim.x, bx = blockIdx.x;
    {
        const float* c = a.in[1]; const float* cctx = a.in[3]; const float* wmod = a.in[4]; const float* bmod = a.in[5];
        float* MOD = (float*)(ws + WS_MOD);
        LAS float* red = (LAS float*)lds;
        for (int uu = bx; uu < 96; uu += G) {
            const int l = uu / 24, nc = uu % 24;
            f32x4 a0 = {0.f, 0.f, 0.f, 0.f}, a1 = a0, a2 = a0;
            const float* wp = wmod + ((size_t)l * 2048 + wave * 256) * 6144 + nc * 256 + 4 * lane;
#pragma unroll 16
            for (int k = 0; k < 256; ++k) { const int kk = wave * 256 + k;
                const f32x4 wv = *(const f32x4*)(wp + (size_t)k * 6144);
                const float s0 = silu(c[kk]), s1 = silu(c[2048 + kk]), s2 = silu(cctx[kk]);
                a0 += wv * s0; a1 += wv * s1; a2 += wv * s2; }
            *(LAS f32x4*)(red + (wave * 3 + 0) * 256 + 4 * lane) = a0; *(LAS f32x4*)(red + (wave * 3 + 1) * 256 + 4 * lane) = a1; *(LAS f32x4*)(red + (wave * 3 + 2) * 256 + 4 * lane) = a2;
            __syncthreads();
            for (int o = tid; o < 768; o += 512) { const int j = o >> 8, ci = o & 255; float s = 0.f;
#pragma unroll
                for (int w = 0; w < 8; ++w) s += red[(w * 3 + j) * 256 + ci];
                MOD[(size_t)(l * 3 + j) * 6144 + nc * 256 + ci] = s + bmod[(size_t)l * 6144 + nc * 256 + ci]; }
            __syncthreads();
        }
    }
    {
        float* ROPE = (float*)(ws + WS_ROPE);
        const int gid = bx * 512 + tid;
        if (gid < 8192) { const int pos = gid >> 5, i = gid & 31;
            const float ang = (float)pos * ROPE_INV[i]; const double x = (double)ang;
            const double kq = __builtin_rint(x * 0.63661977236758134308); double r = __builtin_fma(-kq, 1.57079632679489655800, x); r = __builtin_fma(-kq, 6.12323399573676603587e-17, r);
            const int q = ((int)kq) & 3; const double r2 = r * r;
            const double sn = r * (1.0 + r2 * (-1.0 / 6 + r2 * (1.0 / 120 + r2 * (-1.0 / 5040 + r2 * (1.0 / 362880 + r2 * (-1.0 / 39916800 + r2 * (1.0 / 6227020800.0)))))));
            const double cs = 1.0 + r2 * (-0.5 + r2 * (1.0 / 24 + r2 * (-1.0 / 720 + r2 * (1.0 / 40320 + r2 * (-1.0 / 3628800 + r2 * (1.0 / 479001600.0 + r2 * (-1.0 / 87178291200.0)))))));
            const double co = q == 0 ? cs : (q == 1 ? -sn : (q == 2 ? -cs : sn)); const double si = q == 0 ? sn : (q == 1 ? cs : (q == 2 ? -sn : -cs));
            ROPE[gid * 2] = (float)co; ROPE[gid * 2 + 1] = (float)si; }
    }
    {
        LAS float* scr = (LAS float*)(lds + wave * 8448);
        const int gw = bx * NWAVES + wave, NGW = G * NWAVES;
        constexpr int I_SQ = 32 * 64;
        for (int r0 = gw; r0 < 12 * I_SQ; r0 += NGW) {
            const int mat = r0 / (4 * I_SQ), r1 = r0 % (4 * I_SQ), l = r1 / I_SQ, r = r1 % I_SQ, kb = r / 64, nb = r % 64;
            const float* src = (mat == 0 ? a.in[10] : (mat == 1 ? a.in[11] : a.in[15])) + (size_t)l * 2048 * 2048;
            bf16* dstp = mat == 2 ? (bf16*)(ws + WS_WO) + (size_t)l * 2048 * 2048 : (bf16*)(ws + WS_WAB) + ((size_t)l * 2 + mat) * 2048 * 2048;
            transpose_item(src, 2048, 2048, dstp, 32 * nb, 1, 64 * kb, 32 * nb, scr, lane);
        }
        const int gt = bx * 512 + tid, NGT = G * 512;
        for (int p = gt; p < 4 * 57344; p += NGT) { const int l = p / 57344, q = p % 57344;
            *(GAS v4u*)((unsigned char*)(ws + WS_WIN) + ((size_t)l * NPAD + 20512) * 4096 + (size_t)q * 16) = (v4u){0u, 0u, 0u, 0u}; }
    }
    {
        volatile LAS int* slot = (volatile LAS int*)(lds + SLAB_SLOT);
        for (;;) {
            __syncthreads();
            if (tid == 0) *slot = (int)__hip_atomic_fetch_add((unsigned*)(ws + WS_CTL) + CW_SLAB + rep, 1u, __ATOMIC_RELAXED, __HIP_MEMORY_SCOPE_AGENT);
            __syncthreads();
            const int it = __builtin_amdgcn_readfirstlane(*slot);
            if (it >= 4 * 641) break;
            win_slab_item(a, lds, it / 641, it % 641, tid, lane, wave);
        }
    }
}

__device__ __forceinline__ void wquant_rows(unsigned char* ws, int lane, int wave) {
    const int gw = blockIdx.x * NWAVES + wave, NGW = gridDim.x * NWAVES;
    for (int r = gw; r < 4 * NPAD; r += NGW) {
        { const int pn = (r % NPAD) >> 8; if (!I8_TILE(pn)) continue; }
        const GAS v4u* src = (const GAS v4u*)(ws + WS_WIN + (size_t)r * 4096) + lane;
        v4u p[4];
#pragma unroll
        for (int i = 0; i < 4; ++i) p[i] = src[64 * i];
        float mx = 0.f;
#pragma unroll
        for (int i = 0; i < 4; ++i) { mx = fmaxf(mx, fmaxf(fmaxf(__builtin_fabsf(bflo(p[i].x)), __builtin_fabsf(bfhi(p[i].x))), fmaxf(__builtin_fabsf(bflo(p[i].y)), __builtin_fabsf(bfhi(p[i].y)))));
            mx = fmaxf(mx, fmaxf(fmaxf(__builtin_fabsf(bflo(p[i].z)), __builtin_fabsf(bfhi(p[i].z))), fmaxf(__builtin_fabsf(bflo(p[i].w)), __builtin_fabsf(bfhi(p[i].w))))); }
        mx = fmaxf(wave_max(mx, lane), 1e-30f);
        const float inv = 127.0f * __builtin_amdgcn_rcpf(mx);
        GAS v2u* dst = (GAS v2u*)(ws + WS_WQ + (size_t)r * 2048) + lane;
#pragma unroll
        for (int i = 0; i < 4; ++i) { v2u o; o.x = pack_i8(bflo(p[i].x) * inv, bfhi(p[i].x) * inv, bflo(p[i].y) * inv, bfhi(p[i].y) * inv); o.y = pack_i8(bflo(p[i].z) * inv, bfhi(p[i].z) * inv, bflo(p[i].w) * inv, bfhi(p[i].w) * inv);
            dst[64 * i] = o; }
        if (lane == 0) ((float*)(ws + WS_CS))[r] = mx * (1.0f / 127.0f);
    }
}

__device__ __forceinline__ void norm_phase(const Args& a, LAS unsigned char* lds, int l, int tid, int lane, int wave) {
    unsigned char* ws = a.ws;
    const float* MOD = (const float*)(ws + WS_MOD) + (size_t)l * 3 * 6144;
    const float* g = a.in[6] + (size_t)l * 2048;
    LAS float* Al = (LAS float*)lds; LAS float* Sl = Al + 3 * 2048;
    for (int idx = tid; idx < 3 * 2048; idx += 512) { const int j = idx >> 11, col = idx & 2047;
        Al[idx] = g[col] * (1.0f + MOD[j * 6144 + 2048 + col]); Sl[idx] = MOD[j * 6144 + col]; }
    __syncthreads();
    const float* xlat = l == 0 ? a.in[0] : a.out; const float* xctx = l <= 1 ? a.in[2] : (const float*)(ws + WS_XC);
    bf16* H = (bf16*)(ws + WS_H);
    const int gw = blockIdx.x * NWAVES + wave, NGW = gridDim.x * NWAVES;
    f32x4 vn[8];
#define NORM_LOAD(row_, dst) do { const bool lat_ = (row_) < MLAT; const float* xr_ = lat_ ? xlat + (size_t)(row_) * 2048 : xctx + (size_t)((row_) - MLAT) * 2048; \
        _Pragma("unroll") for (int jj = 0; jj < 8; ++jj) dst[jj] = *(const GAS f32x4*)(xr_ + 4 * lane + 256 * jj); } while (0)
    if (gw < MALL) NORM_LOAD(gw, vn);
    for (int row = gw; row < MALL; row += NGW) {
        const bool lat = row < MLAT; const int j = lat ? (row >> 14) : 2;
        f32x4 v[8]; float ss = 0.f;
#pragma unroll
        for (int jj = 0; jj < 8; ++jj) v[jj] = vn[jj];
        if (row + NGW < MALL) NORM_LOAD(row + NGW, vn);
        if (!lat && l > 0) {
            const float* part = (const float*)(ws + WS_PART) + (size_t)(row - MLAT) * 2048; const float* gt = (const float*)(ws + WS_MOD) + (size_t)(l - 1) * 3 * 6144 + 2 * 6144 + 4096; const float* bo = a.in[16] + (size_t)(l - 1) * 2048;
            float* xw = (float*)(ws + WS_XC) + (size_t)(row - MLAT) * 2048;
#pragma unroll
            for (int jj = 0; jj < 8; ++jj) { const int col = 4 * lane + 256 * jj;
                const f32x4 p0 = *(const GAS f32x4*)(part + col), p1 = *(const GAS f32x4*)(part + (size_t)512 * 2048 + col), p2 = *(const GAS f32x4*)(part + (size_t)2 * 512 * 2048 + col), p3 = *(const GAS f32x4*)(part + (size_t)3 * 512 * 2048 + col);
                v[jj] = v[jj] + *(const GAS f32x4*)(gt + col) * (((p0 + p1) + (p2 + p3)) + *(const GAS f32x4*)(bo + col));
                *(GAS f32x4*)(xw + col) = v[jj]; }
        }
#pragma unroll
        for (int jj = 0; jj < 8; ++jj) ss += (v[jj].x * v[jj].x + v[jj].y * v[jj].y) + (v[jj].z * v[jj].z + v[jj].w * v[jj].w);
        const float rstd = __builtin_amdgcn_rsqf(wave_sum(ss, lane) * (1.0f / 2048.0f) + EPS);
#if G1_I8
        float mx = 0.f;
        GAS unsigned long long* o8 = (GAS unsigned long long*)(H + (size_t)row * 2048) + lane;
#pragma unroll
        for (int jj = 0; jj < 8; ++jj) { const f32x4 av = *(LAS f32x4*)(Al + j * 2048 + 4 * lane + 256 * jj), sv = *(LAS f32x4*)(Sl + j * 2048 + 4 * lane + 256 * jj);
            v[jj] = v[jj] * rstd * av + sv;
            o8[64 * jj] = (unsigned long long)pkh(v[jj].x, v[jj].y) | ((unsigned long long)pkh(v[jj].z, v[jj].w) << 32);
            mx = fmaxf(mx, fmaxf(fmaxf(__builtin_fabsf(v[jj].x), __builtin_fabsf(v[jj].y)), fmaxf(__builtin_fabsf(v[jj].z), __builtin_fabsf(v[jj].w)))); }
        mx = fmaxf(wave_max(mx, lane), 1e-30f);
        const float inv = 127.0f * __builtin_amdgcn_rcpf(mx);
        GAS unsigned* o4 = (GAS unsigned*)(ws + WS_HQ + (size_t)row * 2048) + lane;
#pragma unroll
        for (int jj = 0; jj < 8; ++jj) o4[64 * jj] = pack_i8(v[jj].x * inv, v[jj].y * inv, v[jj].z * inv, v[jj].w * inv);
        if (lane == 0) ((float*)(ws + WS_RS))[row] = mx * (1.0f / 127.0f);
#else
        GAS unsigned long long* o8 = (GAS unsigned long long*)(H + (size_t)row * 2048) + lane;
#pragma unroll
        for (int jj = 0; jj < 8; ++jj) { const f32x4 av = *(LAS f32x4*)(Al + j * 2048 + 4 * lane + 256 * jj), sv = *(LAS f32x4*)(Sl + j * 2048 + 4 * lane + 256 * jj);
            const f32x4 o = v[jj] * rstd * av + sv;
            o8[64 * jj] = (unsigned long long)pkh(o.x, o.y) | ((unsigned long long)pkh(o.z, o.w) << 32); }
#endif
    }
#undef NORM_LOAD
    __syncthreads();
}

constexpr int ML_KT = 0, ML_QT = 17408, ML_KW = 34816, ML_VT = 55296, ML_PT = 92160, ML_SC = 101376;
constexpr int KT_STR = 272, KW_STR = 320, VT_STR = 576, PT_STR = 144;
constexpr int SC_U = 0, SC_MJ = 256, SC_WI = 512, SC_TH = 768, SC_NQ = 1024, SC_N = 1280;
constexpr int GS_BS = 103680, GS_U = 111872, GS_CM = 120064, GS_G = 128256;
__device__ __forceinline__ v4u scale_bf8(v4u x, float s) {
    v4u o; o.x = pkh(bflo(x.x) * s, bfhi(x.x) * s); o.y = pkh(bflo(x.y) * s, bfhi(x.y) * s); o.z = pkh(bflo(x.z) * s, bfhi(x.z) * s); o.w = pkh(bflo(x.w) * s, bfhi(x.w) * s); return o;
}
__device__ __forceinline__ bf16x8 pack_acc8(const f32x16& x, int s) {
    v4u p; p.x = pkh(x[8 * s + 0], x[8 * s + 1]); p.y = pkh(x[8 * s + 2], x[8 * s + 3]); p.z = pkh(x[8 * s + 4], x[8 * s + 5]); p.w = pkh(x[8 * s + 6], x[8 * s + 7]);
    return __builtin_bit_cast(bf16x8, p);
}

__device__ __forceinline__ int ml_chunk_base(int seg, int dir, int b, int ci) {
    if (seg == 0) { const int c = dir ? 3 - ci : ci; return MLAT + b * 256 + 64 * c; }
    const int cc = 32 * (seg - 1) + ci; const int c = dir ? 255 - cc : cc; return b * 16384 + 64 * c;
}
template <bool with_out, bool init_comb>
__device__ __forceinline__ void mlstm_unit(const Args& a, LAS unsigned char* lds, int b, int h, int dir, int seg, int tid_, int lane_, int wave) {
    const int lane = fresh_lane(), tid = wave * 64 + lane;
    unsigned char* ws = a.ws;
    const bf16* P = (const bf16*)(ws + WS_P); const float* Gt = (const float*)(ws + WS_G);
    bf16* HOUT = (bf16*)(ws + (dir ? WS_HB : WS_HF));
    float* STC = (float*)(ws + WS_STC); float* STN = (float*)(ws + WS_STN); float* STS = (float*)(ws + WS_STS);
    const int r = lane & 31, hh = lane >> 5, q4 = (lane & 15) >> 2, p4 = lane & 3, blk = (lane >> 4) & 1;
    const int sidx0 = ((b * 8 + h) * 2 + dir) * 9, sidx = sidx0 + seg;
    LAS float* nl = (LAS float*)(lds + ML_SC + SC_N);
    f32x16 C[4];
#pragma unroll
    for (int i = 0; i < 4; ++i)
#pragma unroll
        for (int e = 0; e < 16; ++e) C[i][e] = 0.f;
    float m = -1e30f, Ftot = 0.f; int nb = 0;
    __syncthreads();
    if (!init_comb) { if (tid < 128) nl[tid] = 0.f; }
    else {
        float run = 0.f, m_in = -3e38f;
        for (int k = seg - 1; k >= 0; --k) { const float mk = STS[(sidx0 + k) * 4], fk = STS[(sidx0 + k) * 4 + 1]; m_in = fmaxf(m_in, mk + run); run += fk; }
        run = 0.f; float nacc = 0.f;
        for (int k = seg - 1; k >= 0; --k) { const float mk = STS[(sidx0 + k) * 4], fk = STS[(sidx0 + k) * 4 + 1]; const float cf = __expf(mk + run - m_in); run += fk;
            const f32x4* src = (const f32x4*)(STC + (size_t)(sidx0 + k) * 32768) + tid;
#pragma unroll
            for (int i = 0; i < 4; ++i)
#pragma unroll
                for (int g4 = 0; g4 < 4; ++g4) { const f32x4 v = src[(4 * i + g4) * 512];
                    C[i][4 * g4 + 0] += cf * v.x; C[i][4 * g4 + 1] += cf * v.y; C[i][4 * g4 + 2] += cf * v.z; C[i][4 * g4 + 3] += cf * v.w; }
            if (tid < 128) nacc += cf * STN[(sidx0 + k) * 128 + tid];
        }
        if (tid < 128) nl[tid] = nacc;
        m = m_in;
    }
    const int nch = seg == 0 ? 4 : 32;
    {
        const int lrow_g = dir ? 63 - lane : lane; const int off_g = lrow_g * 32 + 16 * dir + h;
        float gi4[4], gf4[4];
#pragma unroll
        for (int q = 0; q < 4; ++q) { const int cj = wave + 8 * q; gi4[q] = 0.f; gf4[q] = 0.f;
            if (cj < nch) { const float* gb_ = Gt + (size_t)ml_chunk_base(seg, dir, b, cj) * 32; gi4[q] = gb_[off_g]; gf4[q] = gb_[off_g + 8]; } }
#pragma unroll
        for (int q = 0; q < 4; ++q) { const int cj = wave + 8 * q;
            if (cj < nch) { const float gi = gi4[q], gf = gf4[q];
            const float logf = fminf(gf, 0.f) - log1pf(__expf(-fabsf(gf)));
            float bs = logf;
#pragma unroll
            for (int o = 1; o < 64; o <<= 1) { const float t = shup(bs, o, lane); if (lane >= o) bs += t; }
            const float u = gi - bs; float cm = u;
#pragma unroll
            for (int o = 1; o < 64; o <<= 1) { const float t = shup(cm, o, lane); if (lane >= o) cm = fmaxf(cm, t); }
            *(LAS float*)(lds + GS_BS + (cj * 64 + lane) * 4) = bs; *(LAS float*)(lds + GS_U + (cj * 64 + lane) * 4) = u; *(LAS float*)(lds + GS_CM + (cj * 64 + lane) * 4) = cm;
            if (lane == 63) { *(LAS float*)(lds + GS_G + cj * 4) = bs; *(LAS float*)(lds + GS_G + 128 + cj * 4) = cm; } } }
    }
    v4u kreg[2], qreg[2], vreg[4];
    const int lrow_kq = dir ? 63 - (tid >> 4) : (tid >> 4), lrow_v = dir ? 63 - (tid >> 5) : (tid >> 5);
    const int off_kq = lrow_kq * NP + 8 * (tid & 15), off_v = lrow_v * NP + 8 * (tid & 31);
    const int step_kq = (dir ? -32 : 32) * NP, step_v = (dir ? -16 : 16) * NP;
#define ML_PREFETCH_Q(ci) do { const int base_ = ml_chunk_base(seg, dir, b, ci); const bf16* pb_ = P + (size_t)base_ * NP; \
        if (with_out) { _Pragma("unroll") for (int i = 0; i < 2; ++i) qreg[i] = *(const GAS v4u*)(pb_ + (OFF_AQ + h * 128 + i * step_kq) + off_kq); } } while (0)
#define ML_PREFETCH(ci) do { const int base_ = ml_chunk_base(seg, dir, b, ci); const bf16* pb_ = P + (size_t)base_ * NP; \
        _Pragma("unroll") for (int i = 0; i < 2; ++i) { kreg[i] = *(const GAS v4u*)(pb_ + (OFF_AK + h * 128 + i * step_kq) + off_kq); } \
        _Pragma("unroll") for (int i = 0; i < 4; ++i) vreg[i] = *(const GAS v4u*)(pb_ + (OFF_AV + h * 256 + i * step_v) + off_v); } while (0)
    ML_PREFETCH(0);
    ML_PREFETCH_Q(0);
    for (int ci = 0; ci < nch; ++ci) {
        const int base = ml_chunk_base(seg, dir, b, ci);
        LBAR();
        const float g = *(LAS float*)(lds + GS_G + ci * 4), cm63 = *(LAS float*)(lds + GS_G + 128 + ci * 4);
        const float m_new = fmaxf(g + m, g + cm63);
        const float w_prev = __expf(g + m - m_new);
#pragma unroll
        for (int i = 0; i < 2; ++i) { const int idx = tid + 512 * i, srow = idx >> 4, ch = idx & 15; const float wt = __expf(g + *(LAS float*)(lds + GS_U + (ci * 64 + srow) * 4) - m_new);
            *(LAS v4u*)(lds + ML_KW + srow * KW_STR + ch * 16) = scale_bf8(kreg[i], wt);
            if (with_out) { *(LAS v4u*)(lds + ML_KT + srow * KT_STR + ch * 16) = kreg[i]; *(LAS v4u*)(lds + ML_QT + srow * KT_STR + ch * 16) = qreg[i]; } }
#pragma unroll
        for (int i = 0; i < 4; ++i) { const int idx = tid + 512 * i, srow = idx >> 5, ch = idx & 31; *(LAS v4u*)(lds + ML_VT + srow * VT_STR + ch * 16) = vreg[i]; }
        LBAR();
        if (with_out) {
            const int jt16 = wave >> 1, l15 = lane & 15, l4 = lane >> 4;
            const int j = 16 * jt16 + l15; const float Mjj = fmaxf(m, *(LAS float*)(lds + GS_CM + (ci * 64 + j) * 4));
            bf16x8 qb[4];
#pragma unroll
            for (int ks = 0; ks < 4; ++ks) qb[ks] = *(LAS bf16x8*)(lds + ML_QT + (16 * jt16 + l15) * KT_STR + (32 * ks + 8 * l4) * 2);
#pragma unroll
            for (int tt = 0; tt < 2; ++tt) { const int st16 = 2 * (wave & 1) + tt; f32x4 sacc = {0.f, 0.f, 0.f, 0.f};
                bf16x8 ka[4];
#pragma unroll
                for (int ks = 0; ks < 4; ++ks) ka[ks] = *(LAS bf16x8*)(lds + ML_KT + (16 * st16 + l15) * KT_STR + (32 * ks + 8 * l4) * 2);
                const int s0 = 16 * st16 + 4 * l4; const f32x4 uv = *(LAS f32x4*)(lds + GS_U + (ci * 64 + s0) * 4);
#pragma unroll
                for (int ks = 0; ks < 4; ++ks) sacc = MFMA16(ka[ks], qb[ks], sacc);
                float pv[4];
#pragma unroll
                for (int e = 0; e < 4; ++e) pv[e] = (s0 + e <= j) ? sacc[e] * __expf(uv[e] - Mjj) : 0.f;
                v2u w; w.x = pkh(pv[0], pv[1]); w.y = pkh(pv[2], pv[3]);
                *(LAS v2u*)(lds + ML_PT + j * PT_STR + s0 * 2) = w; }
            { const int jq = tid >> 3, part = tid & 7; const v4u q0 = *(LAS v4u*)(lds + ML_QT + jq * KT_STR + part * 32), q1 = *(LAS v4u*)(lds + ML_QT + jq * KT_STR + part * 32 + 16);
                const LAS f32x4* np = (const LAS f32x4*)(nl + nb * 128 + part * 16); const f32x4 n0 = np[0], n1 = np[1], n2 = np[2], n3 = np[3];
                float s = bflo(q0.x) * n0.x + bfhi(q0.x) * n0.y + bflo(q0.y) * n0.z + bfhi(q0.y) * n0.w + bflo(q0.z) * n1.x + bfhi(q0.z) * n1.y + bflo(q0.w) * n1.z + bfhi(q0.w) * n1.w
                        + bflo(q1.x) * n2.x + bfhi(q1.x) * n2.y + bflo(q1.y) * n2.z + bfhi(q1.y) * n2.w + bflo(q1.z) * n3.x + bfhi(q1.z) * n3.y + bflo(q1.w) * n3.z + bfhi(q1.w) * n3.w;
                s += shx(s, 1, lane); s += shx(s, 2, lane); s += shx(s, 4, lane);
                if (part == 0) *(LAS float*)(lds + ML_SC + SC_NQ + 4 * jq) = s; }
            LBAR();
        }
        if (ci + 1 < nch) ML_PREFETCH(ci + 1);
        bf16x8 vf[4];
#pragma unroll
        for (int ks = 0; ks < 4; ++ks) { const LAS unsigned char* vp = lds + ML_VT + (16 * ks + 8 * hh + q4) * VT_STR + (32 * wave + 16 * blk + 4 * p4) * 2;
            vf[ks] = cat8(tr_read(vp), tr_read(vp + 4 * VT_STR)); }
        if (with_out) {
#pragma unroll 1
            for (int jt = 0; jt < 2; ++jt) {
                f32x16 acc; float rs = 0.f;
#pragma unroll
                for (int e = 0; e < 16; ++e) acc[e] = 0.f;
                const int j = 32 * jt + r;
                const float Mj = fmaxf(m, *(LAS float*)(lds + GS_CM + (ci * 64 + j) * 4)), bsj = *(LAS float*)(lds + GS_BS + (ci * 64 + j) * 4);
                const float wint = __expf(m - Mj), thr = __expf(-(bsj + Mj)), nq = *(LAS float*)(lds + ML_SC + SC_NQ + 4 * j);
                v4u pw[4];
#pragma unroll
                for (int ih = 0; ih < 2; ++ih) { bf16x8 qfr[4];
#pragma unroll
                    for (int ii = 0; ii < 2; ++ii)
#pragma unroll
                        for (int s2 = 0; s2 < 2; ++s2) { const int i = 2 * ih + ii; const LAS unsigned char* qp = lds + ML_QT + (32 * jt + r) * KT_STR + (32 * i + 16 * s2 + 4 * hh) * 2; qfr[2 * ii + s2] = cat8(*(LAS s16x4*)qp, *(LAS s16x4*)(qp + 16)); }
#pragma unroll
                    for (int ii = 0; ii < 2; ++ii)
#pragma unroll
                        for (int s2 = 0; s2 < 2; ++s2) acc = MFMA32(pack_acc8(C[2 * ih + ii], s2), qfr[2 * ii + s2], acc);
                }
#pragma unroll
                for (int ks = 0; ks < 4; ++ks) pw[ks] = *(LAS v4u*)(lds + ML_PT + (32 * jt + r) * PT_STR + (16 * ks + 8 * hh) * 2);
#pragma unroll
                for (int e = 0; e < 16; ++e) acc[e] *= wint;
#pragma unroll
                for (int ks = 0; ks < 4; ++ks) { rs += (bflo(pw[ks].x) + bfhi(pw[ks].x)) + (bflo(pw[ks].y) + bfhi(pw[ks].y)) + (bflo(pw[ks].z) + bfhi(pw[ks].z)) + (bflo(pw[ks].w) + bfhi(pw[ks].w));
                    acc = MFMA32(vf[ks], __builtin_bit_cast(bf16x8, pw[ks]), acc); }
                rs += shx(rs, 32, lane);
                const float den = rs + wint * nq; const float inv = __builtin_amdgcn_rcpf(fmaxf(fabsf(den), thr));
                bf16* op = HOUT + (size_t)base * 2048 + (h * 256 + 32 * wave) + ((dir ? 63 - j : j) * 2048 + 8 * hh);
#pragma unroll
                for (int gp = 0; gp < 2; ++gp) { const int ga = 8 * gp, gb = 8 * gp + 4; v2u wa, wb;
                    wa.x = pkh(acc[ga + 0] * inv, acc[ga + 1] * inv); wa.y = pkh(acc[ga + 2] * inv, acc[ga + 3] * inv); wb.x = pkh(acc[gb + 0] * inv, acc[gb + 1] * inv); wb.y = pkh(acc[gb + 2] * inv, acc[gb + 3] * inv);
                    pair_swap(wa, wb);
                    *(GAS v4u*)(op + 16 * gp) = (v4u){wa.x, wa.y, wb.x, wb.y}; }
            }
            __builtin_amdgcn_sched_barrier(0);
        }
        if (ci + 1 < nch) ML_PREFETCH_Q(ci + 1);
#pragma unroll
        for (int i = 0; i < 4; ++i) {
            bf16x8 ka[4];
#pragma unroll
            for (int ks = 0; ks < 4; ++ks) { const LAS unsigned char* kp = lds + ML_KW + (16 * ks + 8 * hh + q4) * KW_STR + (32 * i + 16 * blk + 4 * p4) * 2; ka[ks] = cat8(tr_read(kp), tr_read(kp + 4 * KW_STR)); }
#pragma unroll
            for (int e = 0; e < 16; ++e) C[i][e] *= w_prev;
#pragma unroll
            for (int ks = 0; ks < 4; ++ks) C[i] = MFMA32(ka[ks], vf[ks], C[i]);
            if (wave == i) { f32x16 nacc;
#pragma unroll
                for (int e = 0; e < 16; ++e) nacc[e] = 0.f;
                const bf16x8 ones = {0x3F80, 0x3F80, 0x3F80, 0x3F80, 0x3F80, 0x3F80, 0x3F80, 0x3F80};
#pragma unroll
                for (int ks = 0; ks < 4; ++ks) nacc = MFMA32(ones, ka[ks], nacc);
                if (hh == 0) nl[(nb ^ 1) * 128 + 32 * i + r] = w_prev * nl[nb * 128 + 32 * i + r] + nacc[0]; }
            __builtin_amdgcn_sched_barrier(0);
        }
        m = m_new; Ftot += g; nb ^= 1;
    }
#undef ML_PREFETCH
#undef ML_PREFETCH_Q
    if (!init_comb) {
        const int tid2 = wave * 64 + fresh_lane();
        f32x4* dst = (f32x4*)((float*)(a.ws + WS_STC) + (size_t)sidx * 32768) + tid2;
#pragma unroll
        for (int i = 0; i < 4; ++i)
#pragma unroll
            for (int g4 = 0; g4 < 4; ++g4) dst[(4 * i + g4) * 512] = (f32x4){C[i][4 * g4 + 0], C[i][4 * g4 + 1], C[i][4 * g4 + 2], C[i][4 * g4 + 3]};
        __syncthreads();
        if (tid2 < 128) ((float*)(a.ws + WS_STN))[sidx * 128 + tid2] = ((LAS float*)(lds + ML_SC + SC_N))[nb * 128 + tid2];
        if (tid2 == 0) { ((float*)(a.ws + WS_STS))[sidx * 4] = m; ((float*)(a.ws + WS_STS))[sidx * 4 + 1] = Ftot; }
    }
}

template <int SUB>
__device__ __forceinline__ void mlstm_phase(const Args& a, LAS unsigned char* lds, int pass, bool need_ctx, int tid, int lane, int wave) {
    if (pass == 1) {
        if (SUB != 2) for (int uu = blockIdx.x; uu < 32; uu += gridDim.x) { const int b = uu >> 4, h = (uu >> 1) & 7, dir = uu & 1; mlstm_unit<true, false>(a, lds, b, h, dir, 0, tid, lane, wave); }
        int v0 = (int)blockIdx.x - 32; if (v0 < 0) v0 += gridDim.x;
        if (SUB != 1) for (int v = v0; v < 224; v += gridDim.x) { const int bhd = v / 7, seg = 1 + v % 7; const int b = bhd >> 4, h = (bhd >> 1) & 7, dir = bhd & 1; mlstm_unit<false, false>(a, lds, b, h, dir, seg, tid, lane, wave); }
    } else {
        for (int u0 = blockIdx.x; u0 < 256; u0 += gridDim.x) { const int uu = (gridDim.x == 256) ? ((u0 & 7) * 32 + (u0 >> 3)) : u0;     const int bhd = uu >> 3, seg = 1 + (uu & 7); const int b = bhd >> 4, h = (bhd >> 1) & 7, dir = bhd & 1; mlstm_unit<true, true>(a, lds, b, h, dir, seg, tid, lane, wave); }
    }
    __syncthreads();
}

__device__ __forceinline__ void post_rows(const Args& a, LAS unsigned char* lds, int l, int row0, int row1, int wrank, int nworkers, int tid, int lane, int wave) {
    unsigned char* ws = a.ws;
    const bf16* P = (const bf16*)(ws + WS_P); const bf16* HF = (const bf16*)(ws + WS_HF); const bf16* HB = (const bf16*)(ws + WS_HB); bf16* YA = (bf16*)(ws + WS_H);
    LAS float* gl = (LAS float*)lds;
    for (int idx = tid; idx < 2048; idx += 512) gl[idx] = a.in[9][(size_t)l * 2048 + idx];
    __syncthreads();
    v4u xh[4], yh[4], gzr[4];
#define POST_LOAD(row_) do { _Pragma("unroll") for (int c = 0; c < 4; ++c) { xh[c] = *(const GAS v4u*)(HF + (size_t)(row_) * 2048 + 32 * lane + 8 * c); yh[c] = *(const GAS v4u*)(HB + (size_t)(row_) * 2048 + 32 * lane + 8 * c); \
            gzr[c] = *(const GAS v4u*)(P + (size_t)(row_) * NP + OFF_AO + 32 * lane + 8 * c); } } while (0)
    if (row0 + wrank < row1) POST_LOAD(row0 + wrank);
    for (int row = row0 + wrank; row < row1; row += nworkers) {
        float hs[32]; float ss = 0.f; v4u gz[4];
#pragma unroll
        for (int c = 0; c < 4; ++c) { const v4u x = xh[c], y = yh[c]; gz[c] = gzr[c];
            hs[8 * c + 0] = bflo(x.x) + bflo(y.x); hs[8 * c + 1] = bfhi(x.x) + bfhi(y.x); hs[8 * c + 2] = bflo(x.y) + bflo(y.y); hs[8 * c + 3] = bfhi(x.y) + bfhi(y.y);
            hs[8 * c + 4] = bflo(x.z) + bflo(y.z); hs[8 * c + 5] = bfhi(x.z) + bfhi(y.z); hs[8 * c + 6] = bflo(x.w) + bflo(y.w); hs[8 * c + 7] = bfhi(x.w) + bfhi(y.w); }
        if (row + nworkers < row1) POST_LOAD(row + nworkers);
#pragma unroll
        for (int e = 0; e < 32; ++e) ss += hs[e] * hs[e];
        ss += shx(ss, 1, lane); ss += shx(ss, 2, lane); ss += shx(ss, 4, lane);
        const float rstd = __builtin_amdgcn_rsqf(ss * (1.0f / 256.0f) + EPS);
#pragma unroll
        for (int c = 0; c < 4; ++c) {
            const f32x4 g0 = *(LAS f32x4*)(gl + 32 * lane + 8 * c), g1 = *(LAS f32x4*)(gl + 32 * lane + 8 * c + 4);
            float o[8];
            o[0] = hs[8 * c + 0] * rstd * g0.x * bflo(gz[c].x); o[1] = hs[8 * c + 1] * rstd * g0.y * bfhi(gz[c].x);
            o[2] = hs[8 * c + 2] * rstd * g0.z * bflo(gz[c].y); o[3] = hs[8 * c + 3] * rstd * g0.w * bfhi(gz[c].y);
            o[4] = hs[8 * c + 4] * rstd * g1.x * bflo(gz[c].z); o[5] = hs[8 * c + 5] * rstd * g1.y * bfhi(gz[c].z);
            o[6] = hs[8 * c + 6] * rstd * g1.z * bflo(gz[c].w); o[7] = hs[8 * c + 7] * rstd * g1.w * bfhi(gz[c].w);
#ifdef FAKEQ_YA
#pragma unroll
            for (int e = 0; e < 8; ++e) hs[8 * c + e] = o[e];
        }
        { float mx = 0.f;
#pragma unroll
            for (int e = 0; e < 32; ++e) mx = fmaxf(mx, __builtin_fabsf(hs[e]));
            mx = fmaxf(wave_max(mx, lane), 1e-30f); const float inv = 127.0f * __builtin_amdgcn_rcpf(mx), sc = mx * (1.0f / 127.0f);
#pragma unroll
            for (int e = 0; e < 32; ++e) hs[e] = ((hs[e] * inv + 12582912.0f) - 12582912.0f) * sc; }
#pragma unroll
        for (int c = 0; c < 4; ++c) { float o[8];
#pragma unroll
            for (int e = 0; e < 8; ++e) o[e] = hs[8 * c + e];
#endif
            v4u w; w.x = pkh(o[0], o[1]); w.y = pkh(o[2], o[3]); w.z = pkh(o[4], o[5]); w.w = pkh(o[6], o[7]);
            *(GAS v4u*)(YA + (size_t)row * 2048 + 32 * lane + 8 * c) = w; }
    }
#undef POST_LOAD
    __syncthreads();
}

constexpr int NA_KT0 = 0, NA_VT0 = 34816, NA_RK0 = 75776, NA_RPB = 76288, NA_FAC = 80128;
constexpr int NK_STR = 272, NV_STR = 320;
constexpr float NEG_BIG = -1e30f, LOG2E = 1.4426950408889634f, NA_THR = 8.0f;

template <bool LAT>
__device__ __forceinline__ void na_tile(const LAS unsigned char* kt, const LAS unsigned char* vt, const LAS float* rkl, int ko, const bf16x8 (&qf)[8], f32x16 (&O)[4], float& mrun, float& lsum,
                                        const LAS unsigned char* baddr, unsigned cmr, int r, int hh, int q4, int p4, int blk, int lane) {
    f32x16 sacc;
#pragma unroll
    for (int e = 0; e < 16; ++e) sacc[e] = 0.f;
    { bf16x8 kf[8];
#pragma unroll
        for (int ks = 0; ks < 8; ++ks) kf[ks] = *(const LAS bf16x8*)(kt + (ko + r) * NK_STR + (16 * ks + 8 * hh) * 2);
#pragma unroll
        for (int ks = 0; ks < 8; ++ks) sacc = MFMA32(kf[ks], qf[ks], sacc); }
    bf16x8 vf[8];
#pragma unroll
    for (int s2 = 0; s2 < 2; ++s2)
#pragma unroll
        for (int i = 0; i < 4; ++i) { const LAS unsigned char* vp = vt + (ko + 16 * s2 + 4 * hh + q4) * NV_STR + (32 * i + 16 * blk + 4 * p4) * 2; vf[4 * s2 + i] = cat8(tr_read(vp), tr_read(vp + 8 * NV_STR)); }
    float tmax = NEG_BIG;
#pragma unroll
    for (int g4 = 0; g4 < 4; ++g4) { const f32x4 rk4 = *(const LAS f32x4*)(rkl + ko + 8 * g4 + 4 * hh);
#pragma unroll
        for (int e = 0; e < 4; ++e) { const int reg = 4 * g4 + e; float s = sacc[reg] * rk4[e];
            if (LAT) { s += *(const LAS float*)(baddr + (8 * g4 + e) * 4); s = (cmr & (1u << reg)) ? s : NEG_BIG; }
            sacc[reg] = s; tmax = fmaxf(tmax, s); } }
    tmax = fmaxf(tmax, shx(tmax, 32, lane));
    if (__builtin_amdgcn_ballot_w64(tmax > mrun + NA_THR) != 0ull) {
        const float mnew = fmaxf(mrun, tmax); const float alpha = __builtin_amdgcn_exp2f(mrun - mnew); mrun = mnew; lsum *= alpha;
#pragma unroll
        for (int i = 0; i < 4; ++i)
#pragma unroll
            for (int e = 0; e < 16; ++e) O[i][e] *= alpha;
    }
    float psum = 0.f;
#pragma unroll
    for (int e = 0; e < 16; ++e) { sacc[e] = __builtin_amdgcn_exp2f(sacc[e] - mrun); psum += sacc[e]; }
    lsum += psum;
#pragma unroll
    for (int s2 = 0; s2 < 2; ++s2) { const bf16x8 pb = pack_acc8(sacc, s2);
#pragma unroll
        for (int i = 0; i < 4; ++i) O[i] = MFMA32(vf[4 * s2 + i], pb, O[i]); }
}

__device__ __forceinline__ void na_unit(const Args& a, LAS unsigned char* lds, int l, int b, int head, int r0, bool is_ctx, int& tab_head, int tid_, int lane_, int wave) {
    const int lane = fresh_lane(), tid = wave * 64 + lane;
    unsigned char* ws = a.ws;
    const bf16* P = (const bf16*)(ws + WS_P); const float* SSQ = (const float*)(ws + WS_SSQ); bf16* YB = (bf16*)(ws + WS_YB);
    const int r = lane & 31, hh = lane >> 5, q4 = (lane & 15) >> 2, p4 = lane & 3, blk = (lane >> 4) & 1;
    const int cb = wave & 3, pair = wave >> 2;
    const int qrow = r0 + 2 * pair + (r >> 4), qcol = 16 * cb + (r & 15);
    const size_t qtok = is_ctx ? (size_t)(MLAT + b * 256 + 32 * wave + r) : (size_t)(b * 16384 + qrow * 64 + qcol);
    const int ws_q = clampi(qcol - 8, 0, 48), rs_q = clampi(qrow - 4, 0, 248);
    const int cs = clampi(16 * cb - 8, 0, 32);
    const int rs_a = clampi(r0 + 2 * pair - 4, 0, 248), rs_b = clampi(r0 + 2 * pair + 1 - 4, 0, 248);
    const int kr_lo = clampi(r0 - 4, 0, 248), kr_hi = clampi(r0 + 3 - 4, 0, 248) + 8;
    const int nlat = is_ctx ? 0 : kr_hi - kr_lo, nsteps = 4 + nlat;
    unsigned cmask = 0u;
#pragma unroll
    for (int reg = 0; reg < 16; ++reg) { const int kc = cs + crow(reg, hh); cmask |= (kc >= ws_q && kc < ws_q + 16) ? (1u << reg) : 0u; }
    const int bidx0 = cs - qcol + 31 + 4 * hh;
    __syncthreads();
    if (head != tab_head) { const float* rp = a.in[14] + ((size_t)l * 16 + head) * 465; LAS float* rl = (LAS float*)(lds + NA_RPB);
        for (int idx = tid; idx < 960; idx += 512) { const int dr = idx >> 6, dc = (idx & 63) - 16; rl[idx] = (dc >= 0 && dc < 31) ? rp[dr * 31 + dc] * LOG2E : 0.f; }
        if (tid < 128) ((LAS float*)(lds + NA_FAC))[tid] = a.in[12][(size_t)l * 128 + tid] * a.in[13][(size_t)l * 128 + tid] * (0.08838834764831845f * LOG2E);
        tab_head = head;
        __syncthreads(); }
    bf16x8 qf[8];
    { const f32x4 sq = *(const GAS f32x4*)(SSQ + (qtok * 16 + head) * 4); const float rq = __builtin_amdgcn_rsqf(((sq.x + sq.y) + (sq.z + sq.w)) * (1.0f / 128.0f) + EPS);
        v4u xq[8];
#pragma unroll
        for (int ks = 0; ks < 8; ++ks) xq[ks] = *(const GAS v4u*)(P + qtok * NP + OFF_BQ + head * 128 + 16 * ks + 8 * hh);
#pragma unroll
        for (int ks = 0; ks < 8; ++ks) { const v4u x = xq[ks];
            const LAS f32x4* fp = (const LAS f32x4*)(lds + NA_FAC + (16 * ks + 8 * hh) * 4); const f32x4 f0 = fp[0] * rq, f1 = fp[1] * rq;
            v4u o; o.x = pkh(bflo(x.x) * f0.x, bfhi(x.x) * f0.y); o.y = pkh(bflo(x.y) * f0.z, bfhi(x.y) * f0.w); o.z = pkh(bflo(x.z) * f1.x, bfhi(x.z) * f1.y); o.w = pkh(bflo(x.w) * f1.z, bfhi(x.w) * f1.w);
            qf[ks] = __builtin_bit_cast(bf16x8, o); } }
    f32x16 O[4];
#pragma unroll
    for (int i = 0; i < 4; ++i)
#pragma unroll
        for (int e = 0; e < 16; ++e) O[i][e] = 0.f;
    float mrun = NEG_BIG, lsum = 0.f;
    v4u kreg[2], vreg[2]; f32x4 sreg = {0.f, 0.f, 0.f, 0.f};
    const int koff = (tid >> 4) * NP + 8 * (tid & 15);
#define NA_PREFETCH(st) do { const size_t row0_ = (st) < 4 ? (size_t)(MLAT + b * 256 + 64 * (st)) : (size_t)(b * 16384 + (kr_lo + (st) - 4) * 64); const bf16* pb_ = P + row0_ * NP + head * 128; \
        _Pragma("unroll") for (int i = 0; i < 2; ++i) { kreg[i] = *(const GAS v4u*)(pb_ + (OFF_BK + i * 32 * NP) + koff); vreg[i] = *(const GAS v4u*)(pb_ + (OFF_BV + i * 32 * NP) + koff); } \
        if (tid < 64) sreg = *(const GAS f32x4*)(SSQ + (((size_t)MALL + row0_ + tid) * 16 + head) * 4); } while (0)
#define NA_STAGE(st) do { \
        _Pragma("unroll") for (int i = 0; i < 2; ++i) { const int idx = tid + 512 * i, kk = idx >> 4, ch = idx & 15; \
            *(LAS v4u*)(kt + kk * NK_STR + ch * 16) = kreg[i]; *(LAS v4u*)(vt + kk * NV_STR + ch * 16) = vreg[i]; } \
        if (tid < 64) rkl[tid] = __builtin_amdgcn_rsqf(((sreg.x + sreg.y) + (sreg.z + sreg.w)) * (1.0f / 128.0f) + EPS); \
        if ((st) + 1 < nsteps) NA_PREFETCH((st) + 1); \
        LBAR(); } while (0)
    NA_PREFETCH(0);
#pragma unroll 1
    for (int st = 0; st < 4; ++st) {
        const int buf = st & 1;
        LAS unsigned char* kt = lds + NA_KT0 + buf * 17408; LAS unsigned char* vt = lds + NA_VT0 + buf * 20480; LAS float* rkl = (LAS float*)(lds + NA_RK0 + buf * 256);
        NA_STAGE(st);
#pragma unroll 1
        for (int tl = 0; tl < 2; ++tl) na_tile<false>(kt, vt, rkl, 32 * tl, qf, O, mrun, lsum, nullptr, 0u, r, hh, q4, p4, blk, lane);
    }
#pragma unroll 1
    for (int st = 4; st < nsteps; ++st) {
        const int buf = st & 1;
        LAS unsigned char* kt = lds + NA_KT0 + buf * 17408; LAS unsigned char* vt = lds + NA_VT0 + buf * 20480; LAS float* rkl = (LAS float*)(lds + NA_RK0 + buf * 256);
        NA_STAGE(st);
        const int kr = kr_lo + st - 4;
        const bool active = (kr >= rs_a && kr < rs_a + 8) || (kr >= rs_b && kr < rs_b + 8);
        if (active) {
            const bool rowok = kr >= rs_q && kr < rs_q + 8;
            const int dr = clampi(kr - qrow + 7, 0, 14);
            na_tile<true>(kt, vt, rkl, cs, qf, O, mrun, lsum, lds + NA_RPB + (dr * 64 + bidx0) * 4, rowok ? cmask : 0u, r, hh, q4, p4, blk, lane);
        }
    }
#undef NA_STAGE
#undef NA_PREFETCH
    lsum += shx(lsum, 32, lane);
    const float inv = __builtin_amdgcn_rcpf(lsum);
    v4u zq[4][2];
#pragma unroll
    for (int i = 0; i < 4; ++i)
#pragma unroll
        for (int gp = 0; gp < 2; ++gp) zq[i][gp] = *(const GAS v4u*)(P + qtok * NP + OFF_BZ + head * 128 + 32 * i + 16 * gp + 8 * hh);
#pragma unroll
    for (int i = 0; i < 4; ++i)
#pragma unroll
        for (int gp = 0; gp < 2; ++gp) {
            v2u za = {zq[i][gp].x, zq[i][gp].y}, zb = {zq[i][gp].z, zq[i][gp].w}; pair_swap(za, zb);
            const int ga = 4 * (2 * gp), gb = 4 * (2 * gp + 1);
            v2u wa, wb;
            wa.x = pkh(O[i][ga + 0] * inv * silu(bflo(za.x)), O[i][ga + 1] * inv * silu(bfhi(za.x))); wa.y = pkh(O[i][ga + 2] * inv * silu(bflo(za.y)), O[i][ga + 3] * inv * silu(bfhi(za.y)));
            wb.x = pkh(O[i][gb + 0] * inv * silu(bflo(zb.x)), O[i][gb + 1] * inv * silu(bfhi(zb.x))); wb.y = pkh(O[i][gb + 2] * inv * silu(bflo(zb.y)), O[i][gb + 3] * inv * silu(bfhi(zb.y)));
            pair_swap(wa, wb);
            *(GAS v4u*)(YB + qtok * 2048 + head * 128 + 32 * i + 16 * gp + 8 * hh) = (v4u){wa.x, wa.y, wb.x, wb.y}; }
}

__device__ __forceinline__ void na_phase(const Args& a, LAS unsigned char* lds, int l, bool need_ctx, int tid, int lane, int wave) {
    int tab_head = -1;
    const int nper = (2048 + (int)gridDim.x - 1) / (int)gridDim.x;
    const int vbx = (gridDim.x == 256) ? (((int)blockIdx.x & 7) * 32 + ((int)blockIdx.x >> 3)) : (int)blockIdx.x;
    for (int k = 0; k < nper; ++k) { const int uu = vbx * nper + k; if (uu >= 2048) break; const int b = uu >> 10, head = (uu >> 6) & 15, rq = uu & 63; na_unit(a, lds, l, b, head, 4 * rq, false, tab_head, tid, lane, wave); }
    if (need_ctx) for (int v = (int)blockIdx.x; v < 32; v += gridDim.x) na_unit(a, lds, l, v >> 4, v & 15, 0, true, tab_head, tid, lane, wave);
    __syncthreads();
}

constexpr int NPHASE = 1 + 9 * DEPTH;
#ifndef G23_ALIGN
#define G23_ALIGN true
#endif
#ifndef WGM_SMALL
#define WGM_SMALL 2
#endif
#ifndef G1_ALIGN
#define G1_ALIGN true
#endif
#ifndef G1_SP2
#define G1_SP2 true
#endif
#define PH_ON(x) (PHSEL < 0 || PHSEL == (x))
#ifndef REPEAT_PH
#define REPEAT_PH -1
#endif
#define REPS(k) ((REPEAT_PH == (k)) ? 2 : 1)
#ifdef REP_HALFK
#define G1_KEXT(r) (((r) == 0 && REPEAT_PH == 2) ? 1024 : 2048)
#else
#define G1_KEXT(r) 2048
#endif
template <int PHSEL>
__global__ void __launch_bounds__(NWAVES * 64, 2) fwd_kernel(Args args) {
    extern __shared__ __attribute__((aligned(16))) unsigned char lds_raw[];
    LAS unsigned char* lds = (LAS unsigned char*)lds_raw;
    int tid = threadIdx.x, lane = tid & 63, wave = __builtin_amdgcn_readfirstlane(tid >> 6);
#define FRESH_TID() do { lane = fresh_lane(); tid = wave * 64 + lane; } while (0)
    volatile LAS unsigned* MISC = (volatile LAS unsigned*)(lds + MISC_OFF);
    for (int u = tid; u < (LDS_BYTES - RING_BYTES) / 4; u += NWAVES * 64) ((LAS unsigned*)(lds + RING_BYTES))[u] = 0u;
    __syncthreads();
    unsigned char* ws = args.ws;
    gu32* ctl = (gu32*)(ws + WS_CTL);
    const bool use_bar = (args.ph_hi - args.ph_lo) > 1;
    XcdBarrier bar; bar.bar = (unsigned*)(ctl + CW_BAR); bar.x = 0; bar.st = nullptr;
    if (use_bar) bar = xcd_barrier_post((unsigned*)(ctl + CW_BAR), MISC + 8);
    const int lo = args.ph_lo, hi = args.ph_hi;
#define IN(k) (lo <= (k) && (k) < hi)
#define SEAM(k) do { if (IN(k) && IN((k) + 1)) xcd_barrier(bar); } while (0)

    if (PH_ON(0) && IN(0)) { for (int rep_ = 0; rep_ < REPS(0); ++rep_) { prologue(args, lds, tid, lane, wave, rep_); SEAM(0); } }
    for (int l = 0; l < DEPTH; ++l) {
        const int pb = 1 + 9 * l; const bool need_ctx = l < DEPTH - 1;
        const int mrows = need_ctx ? MALL : MLAT;
        const int mrows_ab = MLAT;
        const float* MODl = (const float*)(ws + WS_MOD) + (size_t)l * 3 * 6144;
        if (PH_ON(1) && IN(pb + 0)) { for (int rep_ = 0; rep_ < REPS(1); ++rep_) { FRESH_TID();
            norm_phase(args, lds, l, tid, lane, wave); SEAM(pb + 0); } }
        if (PH_ON(2) && IN(pb + 1)) { for (int rep_ = 0; rep_ < REPS(2); ++rep_) {
            pg8::StaticOrder S; S.init(MALL, NPAD, (int)gridDim.x, (int)blockIdx.x);
#if G1_I8
            const int nfirst = G1_STAGGER ? ((int)blockIdx.x & 7) % 5 : 0;
            pg8::Gemm gb{(const pg8::bf16_t*)(ws + WS_H), (const pg8::bf16_t*)(ws + WS_WIN) + (size_t)l * NPAD * 2048, MALL, NPAD, 2048, 2048};
            pg8::MapOrder SB; SB.base.init(MALL, (81 - I8_NT) * 256, (int)gridDim.x, (int)gridDim.x - 1 - (int)blockIdx.x); SB.mask = 0x3FFu & ~I8_MASK;
            pg8::EpiIn EB{(pg8::bf16_t*)(ws + WS_P), (float*)(ws + WS_G), (float*)(ws + WS_SSQ), args.in[8] + (size_t)l * NIN, (const float*)(ws + WS_ROPE), MALL};
            if (G1_STAGGER) { SB.i0 = 0; SB.i1 = nfirst; pg8::gemm_phase<pg8::EpiIn, pg8::MapOrder, G1_ALIGN, G1_SP2>(lds, gb, SB, EB, wave); }
            {
                pg8::Gemm g{(const pg8::bf16_t*)(ws + WS_HQ), (const pg8::bf16_t*)(ws + WS_WQ + (size_t)l * NPAD * 2048), MALL, NPAD, 1024, 1024};
                pg8::MapOrder SQ; SQ.base.init(MALL, I8_NT * 256, (int)gridDim.x, (int)blockIdx.x, G1_WGMQ); SQ.mask = I8_MASK;
#if G1_BAL
                { const int G = (int)gridDim.x, remq = (MALL / 256 * I8_NT) % G, remb = (MALL / 256 * (81 - I8_NT)) % G;
                  const int rest = G - remb; if (remq > rest && remq <= 2 * rest) { SQ.n2 = remq - rest; SQ.n1 = rest - SQ.n2; } }
#endif
                pg8::EpiInQ E{(pg8::bf16_t*)(ws + WS_P), (float*)(ws + WS_G), (float*)(ws + WS_SSQ), args.in[8] + (size_t)l * NIN, (const float*)(ws + WS_ROPE), MALL, (const float*)(ws + WS_RS), (const float*)(ws + WS_CS) + (size_t)l * NPAD};
                pg8::gemm_phase<pg8::EpiInQ, pg8::MapOrder, G1_ALIGN, G1_SP2, true>(lds, g, SQ, E, wave);
            }
            SB.i0 = nfirst; SB.i1 = 1 << 30; pg8::gemm_phase<pg8::EpiIn, pg8::MapOrder, G1_ALIGN, G1_SP2>(lds, gb, SB, EB, wave);
#else
            pg8::Gemm g{(const pg8::bf16_t*)(ws + WS_H), (const pg8::bf16_t*)(ws + WS_WIN) + (size_t)l * NPAD * 2048, MALL, NPAD, 2048, G1_KEXT(rep_)};
            pg8::EpiIn E{(pg8::bf16_t*)(ws + WS_P), (float*)(ws + WS_G), (float*)(ws + WS_SSQ), args.in[8] + (size_t)l * NIN, (const float*)(ws + WS_ROPE), MALL};
            pg8::gemm_phase<pg8::EpiIn, pg8::StaticOrder, G1_ALIGN, G1_SP2>(lds, g, S, E, wave);
#endif
            SEAM(pb + 1);
        } }
        if ((PH_ON(3) || PHSEL == 10) && IN(pb + 2)) { for (int rep_ = 0; rep_ < REPS(3); ++rep_) { FRESH_TID(); mlstm_phase<PHSEL == 3 ? 1 : (PHSEL == 10 ? 2 : 0)>(args, lds, 1, need_ctx, tid, lane, wave); if (PHSEL < 0) { FRESH_TID(); na_phase(args, lds, l, need_ctx, tid, lane, wave); } SEAM(pb + 2); } }
        if (PH_ON(4) && IN(pb + 3)) { for (int rep_ = 0; rep_ < REPS(4); ++rep_) { FRESH_TID(); mlstm_phase<0>(args, lds, 2, need_ctx, tid, lane, wave);
            if (need_ctx) { FRESH_TID(); post_rows(args, lds, l, MLAT, MALL, (int)blockIdx.x * NWAVES + wave, (int)gridDim.x * NWAVES, tid, lane, wave); }
            SEAM(pb + 3); } }
        if (PHSEL == 5 && IN(pb + 4)) { FRESH_TID(); na_phase(args, lds, l, need_ctx, tid, lane, wave); }
        if (PH_ON(6) && IN(pb + 5)) { for (int rep_ = 0; rep_ < REPS(6); ++rep_) {
            const int nctxw = need_ctx ? 32 : 0;
            if ((int)blockIdx.x < nctxw) {
                pg8::Gemm g{(const pg8::bf16_t*)(ws + WS_H), (const pg8::bf16_t*)(ws + WS_WAB) + (size_t)l * 2 * 2048 * 2048, 2 * MALL, 4096, 2048, 2048};
                pg8::PairOrder S; S.single = (int)blockIdx.x; S.base.init(256, 256, 1, 0);
                pg8::EpiMergePair E{(const pg8::bf16_t*)(ws + WS_P), (pg8::bf16_t*)(ws + WS_HF), (long)((WS_HB - WS_HF) / 2), 0};
                pg8::gemm_phase<pg8::EpiMergePair, pg8::PairOrder, G23_ALIGN, true>(lds, g, S, E, wave);
            } else { FRESH_TID(); post_rows(args, lds, l, 0, MLAT, ((int)blockIdx.x - nctxw) * NWAVES + wave, ((int)gridDim.x - nctxw) * NWAVES, tid, lane, wave); }
            SEAM(pb + 5); } }
        if (PH_ON(7) && IN(pb + 6)) { for (int rep_ = 0; rep_ < REPS(7); ++rep_) {
            pg8::Gemm g{(const pg8::bf16_t*)(ws + WS_H), (const pg8::bf16_t*)(ws + WS_WAB) + (size_t)l * 2 * 2048 * 2048, 2 * MALL, 4096, 2048, 2048};
            pg8::PairOrder S; S.single = -1; S.base.init(mrows_ab, 2048, (int)gridDim.x, (int)blockIdx.x, WGM_SMALL);
            pg8::EpiMergePair E{(const pg8::bf16_t*)(ws + WS_P), (pg8::bf16_t*)(ws + WS_HF), (long)((WS_HB - WS_HF) / 2), 1};
            if (need_ctx) {
                FRESH_TID(); const int gt = (int)blockIdx.x * 512 + tid, ngt = (int)gridDim.x * 512;
                for (int p = gt; p < MCTX * 256; p += ngt) { const size_t off = (size_t)MLAT * 2048 + (size_t)p * 8;
                    const v4u ta = *(const GAS v4u*)((const bf16*)(ws + WS_HF) + off), tb = *(const GAS v4u*)((const bf16*)(ws + WS_HB) + off);
                    v4u o; o.x = pkh(bflo(ta.x) + bflo(tb.x), bfhi(ta.x) + bfhi(tb.x)); o.y = pkh(bflo(ta.y) + bflo(tb.y), bfhi(ta.y) + bfhi(tb.y)); o.z = pkh(bflo(ta.z) + bflo(tb.z), bfhi(ta.z) + bfhi(tb.z)); o.w = pkh(bflo(ta.w) + bflo(tb.w), bfhi(ta.w) + bfhi(tb.w));
                    *(GAS v4u*)((bf16*)(ws + WS_HB) + off) = o; }
            }
            pg8::gemm_phase<pg8::EpiMergePair, pg8::PairOrder, G23_ALIGN, true>(lds, g, S, E, wave);
            SEAM(pb + 6);
        } }
        if (PH_ON(9) && IN(pb + 8)) {
            pg8::Gemm g{(const pg8::bf16_t*)(ws + WS_HB), (const pg8::bf16_t*)(ws + WS_WO) + (size_t)l * 2048 * 2048, MLAT, 2048, 2048, 2048};
            pg8::StaticOrder S; S.init(MLAT, 2048, (int)gridDim.x, (int)blockIdx.x, WGM_SMALL);
            pg8::EpiOut E{l == 0 ? args.in[0] : args.out, args.out, l == 0 ? args.in[2] : (const float*)(ws + WS_XC), (float*)(ws + WS_XC), MODl, args.in[16] + (size_t)l * 2048};
            pg8::gemm_phase<pg8::EpiOut, pg8::StaticOrder, true, true>(lds, g, S, E, wave);
            if (need_ctx) {
                const int ks = (int)blockIdx.x & 3;
                pg8::Gemm g2{(const pg8::bf16_t*)(ws + WS_HB) + 512 * ks, (const pg8::bf16_t*)(ws + WS_WO) + (size_t)l * 2048 * 2048 + 512 * ks, MALL, 2048, 2048, 512};
                pg8::SliceOrder S2; S2.c = (int)blockIdx.x;
                pg8::EpiPart E2{(float*)(ws + WS_PART) + (size_t)ks * 512 * 2048};
                pg8::gemm_phase<pg8::EpiPart, pg8::SliceOrder, true, true>(lds, g2, S2, E2, wave);
            }
            SEAM(pb + 8);
        }
    }
#undef IN
#undef SEAM
}

template <int PHSEL> static void launch_one(const Args& a, int grid, hipStream_t stream, bool first) {
    if (first) (void)hipFuncSetAttribute((const void*)fwd_kernel<PHSEL>, hipFuncAttributeMaxDynamicSharedMemorySize, LDS_BYTES);
    hipLaunchKernelGGL(fwd_kernel<PHSEL>, dim3(grid), dim3(NWAVES * 64), LDS_BYTES, stream, a);
}
extern "C" void kernel_launch(void* const* d_in, const int* in_sizes, int n_in, void* d_out, int out_size, void* d_ws, size_t ws_size, hipStream_t stream) {
    static int grid = 0; static bool first = true;
    if (grid == 0) {
        if (n_in != 17 || out_size != MLAT * DM || ws_size < WS_END) { fprintf(stderr, "kernel_launch: unexpected shapes / workspace (n_in %d out %d ws %zu need %zu)\n", n_in, out_size, ws_size, (size_t)WS_END); grid = -1; return; }
        int dev = 0, cus = 0;
        if (hipGetDevice(&dev) != hipSuccess || hipDeviceGetAttribute(&cus, hipDeviceAttributeMultiprocessorCount, dev) != hipSuccess) { grid = -1; return; }
        grid = cus;
    }
    if (grid < 0) return;
    if (hipMemsetAsync((char*)d_ws + WS_CTL, 0, CTL_ZERO_BYTES, stream) != hipSuccess) return;
    Args a{};
    for (int i = 0; i < 17; ++i) a.in[i] = (const float*)d_in[i];
    a.out = (float*)d_out; a.ws = (unsigned char*)d_ws;
#if N_LAUNCH_MODE == 1
#ifdef PROBE_EXTRA_HI
    a.ph_lo = PROBE_EXTRA_LO; a.ph_hi = PROBE_EXTRA_HI; launch_one<-1>(a, grid, stream, first);
    if (hipMemsetAsync((char*)d_ws + WS_CTL, 0, CTL_ZERO_BYTES, stream) != hipSuccess) return;
#endif
    a.ph_lo = 0; a.ph_hi = NPHASE;
    launch_one<-1>(a, grid, stream, first);
#else
    a.ph_lo = 0; a.ph_hi = 1; launch_one<0>(a, grid, stream, first);
    for (int l = 0; l < DEPTH; ++l) { const int pb = 1 + 9 * l;
        a.ph_lo = pb + 0; a.ph_hi = pb + 1; launch_one<1>(a, grid, stream, first);
        a.ph_lo = pb + 1; a.ph_hi = pb + 2; launch_one<2>(a, grid, stream, first);
        a.ph_lo = pb + 2; a.ph_hi = pb + 3; launch_one<3>(a, grid, stream, first); launch_one<10>(a, grid, stream, first);
        a.ph_lo = pb + 3; a.ph_hi = pb + 4; launch_one<4>(a, grid, stream, first);
        a.ph_lo = pb + 4; a.ph_hi = pb + 5; launch_one<5>(a, grid, stream, first);
        a.ph_lo = pb + 5; a.ph_hi = pb + 6; launch_one<6>(a, grid, stream, first);
        a.ph_lo = pb + 6; a.ph_hi = pb + 7; launch_one<7>(a, grid, stream, first);
        a.ph_lo = pb + 7; a.ph_hi = pb + 8; launch_one<8>(a, grid, stream, first);
        a.ph_lo = pb + 8; a.ph_hi = pb + 9; launch_one<9>(a, grid, stream, first);
    }
#endif
    first = false;
}
```

```cpp
#include <hip/hip_runtime.h>
#include <cstdio>
#include <cstdint>
#ifndef N_LAUNCH_MODE
#define N_LAUNCH_MODE 1
#endif
namespace pg8 {
#define PG8_LAS __attribute__((address_space(3)))
typedef unsigned short bf16_t;
typedef short bf16x8 __attribute__((ext_vector_type(8)));
typedef float f32x4 __attribute__((ext_vector_type(4)));
typedef unsigned u32x4 __attribute__((ext_vector_type(4)));
typedef int i32x4 __attribute__((ext_vector_type(4)));
constexpr int BM = 256, BK = 64, HALF = 128, HTB = HALF * BK * 2  , STAGE_BYTES = 8 * HTB, NXCD = 8, WGM = 5;

__host__ __device__ __forceinline__ int lds_byte(int r, int c) { const int st = (r >> 4) * 2 + (c >> 5), rr = r & 15, cc = c & 31, ob = rr * 64 + cc * 2; return st * 1024 + (ob ^ (((ob >> 9) & 1) << 5)); }
__host__ __device__ __forceinline__ void stage_rc(int b, int& R, int& C) { const int st = b / 1024, sb = b % 1024, swz = sb ^ (((sb >> 9) & 1) << 5); R = (st >> 1) * 16 + swz / 64; C = (st & 1) * 32 + (swz % 64) / 2; }
__host__ __device__ __forceinline__ int perm32(int rho) { const int n = rho >> 4, i = rho & 15; return 8 * (i >> 2) + 4 * n + (i & 3); }

struct Unit { int pm, pn; };
struct Gemm { const bf16_t* A; const bf16_t* Bt; int M, N, K, kext; };

struct StaticOrder {
    int nM, nN, nwg, G, c, wgm;
    __host__ __device__ void init(int M, int N, int G_, int c_, int wgm_ = WGM) { nM = M / BM; nN = N / BM; nwg = nM * nN; G = G_; c = c_; wgm = wgm_; }
    __host__ __device__ bool next(int i, Unit& u) const { return at((long)i * G + c, u); }
    __host__ __device__ bool at(const long L, Unit& u) const {
        if (L >= nwg) return false;
        int wgid = (int)L; { const int q = nwg / NXCD, r = nwg % NXCD, xcd = wgid % NXCD, off = wgid / NXCD; wgid = (xcd < r ? xcd * (q + 1) : r * (q + 1) + (xcd - r) * q) + off; }
        const int nig = wgm * nN, gid = wgid / nig, fm = gid * wgm, gsz = (nM - fm) < wgm ? (nM - fm) : wgm;
        u.pm = fm + ((wgid % nig) % gsz); u.pn = (wgid % nig) / gsz; return true;
    }
    __device__ __forceinline__ void a_ready(const Unit&) const {}
    __device__ __forceinline__ void done(const Unit&) const {}
};


__device__ __forceinline__ unsigned cvt_pk_bf16(float lo, float hi) { unsigned r; asm volatile("v_cvt_pk_bf16_f32 %0, %1, %2" : "=v"(r) : "v"(lo), "v"(hi)); return r; }
__device__ __forceinline__ float bf_lo(unsigned w) { return __builtin_bit_cast(float, w << 16); }
__device__ __forceinline__ float bf_hi(unsigned w) { return __builtin_bit_cast(float, w & 0xffff0000u); }
__device__ __forceinline__ float sigmoid_f(float x) { return __builtin_amdgcn_rcpf(1.0f + __builtin_amdgcn_exp2f(-1.4426950408889634f * x)); }
__device__ __forceinline__ float gate_sz(float o, float z) { return z * __builtin_amdgcn_rcpf((1.0f + __builtin_amdgcn_exp2f(-1.4426950408889634f * o)) * (1.0f + __builtin_amdgcn_exp2f(-1.4426950408889634f * z))); }

constexpr int E_MLAT = 32768, E_NP = 20608;

template <bool I8> struct EpiInT {
    static constexpr bool PERM = true, AFTER_DRAIN = false;
    bf16_t* P; float* G; float* SSQ; const float* bias; const float* rope; int mall; const float* rs; const float* cs;
    __device__ __forceinline__ void operator()(const f32x4 (&acc)[2][2][4][2], const Unit& u, int wr, int wc, int fr, int fq) const {
        asm volatile("" : "+v"(fr), "+v"(fq));
        const int pn = u.pn; const int row0 = u.pm * BM + wr * 64 + fr;
        if constexpr (I8) {
            f32x4 (&A)[2][2][4][2] = const_cast<f32x4 (&)[2][2][4][2]>(acc);
            f32x4 cv[2][2]; float rsv[2][4];
#pragma unroll
            for (int bj = 0; bj < 2; ++bj)
#pragma unroll
                for (int n = 0; n < 2; ++n) cv[bj][n] = *(const f32x4*)(cs + pn * BM + bj * HALF + wc * 32 + 8 * fq + 4 * n);
#pragma unroll
            for (int ai = 0; ai < 2; ++ai)
#pragma unroll
                for (int m = 0; m < 4; ++m) rsv[ai][m] = rs[row0 + ai * HALF + m * 16];
#pragma unroll
            for (int ai = 0; ai < 2; ++ai)
#pragma unroll
                for (int m = 0; m < 4; ++m)
#pragma unroll
                    for (int bj = 0; bj < 2; ++bj)
#pragma unroll
                        for (int n = 0; n < 2; ++n) A[ai][bj][m][n] = __builtin_convertvector(__builtin_bit_cast(i32x4, A[ai][bj][m][n]), f32x4) * (cv[bj][n] * rsv[ai][m]);
        }
        if (pn == 80) {
            if (wc == 0) {
#pragma unroll
                for (int ai = 0; ai < 2; ++ai)
#pragma unroll
                    for (int m = 0; m < 4; ++m) { const int row = row0 + ai * HALF + m * 16;
#pragma unroll
                        for (int n = 0; n < 2; ++n) { const f32x4 bv = *(const f32x4*)(bias + 8192 + 8 * fq + 4 * n);
                            *(f32x4*)(G + (size_t)row * 32 + 8 * fq + 4 * n) = acc[ai][0][m][n] + bv; } }
            }
            return;
        }
        const int colt = pn * BM; const int ocolt = colt < 8192 ? colt : colt + 32; const int cw = wc * 32 + 8 * fq;
        f32x4 bv[2][2];
#pragma unroll
        for (int bj = 0; bj < 2; ++bj)
#pragma unroll
            for (int n = 0; n < 2; ++n) bv[bj][n] = *(const f32x4*)(bias + ocolt + bj * HALF + cw + 4 * n);
        const bool is_rope = pn < 8;
        if (is_rope) {
#pragma unroll
            for (int bj = 0; bj < 2; ++bj) { const float* bh = bias + colt + bj * HALF + 64 * (wc >> 1) + 16 * (wc & 1) + 4 * fq;
                const f32x4 b1 = *(const f32x4*)bh, b2 = *(const f32x4*)(bh + 32);
                bv[bj][0] = (f32x4){b1[0], b2[0], b1[1], b2[1]}; bv[bj][1] = (f32x4){b1[2], b2[2], b1[3], b2[3]}; }
        } const float ksc = (pn >= 4 && pn < 8) ? 0.08838834764831845f : 1.0f;
        const bool is_gz = (pn >= 16 && pn < 32);
        if (is_gz) {
#pragma unroll
            for (int bj = 0; bj < 2; ++bj) { const int cb = 128 * (pn - 16) + 64 * bj + 16 * wc + 4 * fq;
                const f32x4 b1 = *(const f32x4*)(bias + 4096 + cb), b2 = *(const f32x4*)(bias + 6144 + cb);
                bv[bj][0] = (f32x4){b1[0], b2[0], b1[1], b2[1]}; bv[bj][1] = (f32x4){b1[2], b2[2], b1[3], b2[3]}; }
        }
        const bool is_ssq = (pn >= 32 && pn < 48); const int which = pn >= 40 ? 1 : 0; const int hd0 = 2 * (pn - 32 - 8 * which);
        const int blk = wc >> 1, i0 = 16 * (wc & 1) + 4 * fq;
        if (is_rope) {
            const bool latrows = u.pm * BM < E_MLAT;
#pragma unroll
            for (int ah = 0; ah < 4; ++ah) { const int ai = ah >> 1, mh = ah & 1; f32x4 csA[2], csB[2];
#pragma unroll
                for (int mm = 0; mm < 2; ++mm) { const int m = 2 * mh + mm; const int row = row0 + ai * HALF + m * 16; csA[mm] = (f32x4){1.f, 0.f, 1.f, 0.f}; csB[mm] = csA[mm];
                    if (latrows) { const int t = row & 16383; const int pos = blk ? (t & 63) : (t >> 6); csA[mm] = *(const f32x4*)(rope + (size_t)(pos * 32 + i0) * 2); csB[mm] = *(const f32x4*)(rope + (size_t)(pos * 32 + i0) * 2 + 4); } }
#pragma unroll
                for (int mm = 0; mm < 2; ++mm) { const int m = 2 * mh + mm; const int row = row0 + ai * HALF + m * 16; bf16_t* rowp = P + (size_t)row * E_NP + colt + cw; const f32x4 cs0 = csA[mm], cs1 = csB[mm];
#pragma unroll
                    for (int bj = 0; bj < 2; ++bj) { const f32x4 v0 = acc[ai][bj][m][0] + bv[bj][0], v1 = acc[ai][bj][m][1] + bv[bj][1];
                        f32x4 r0, r1;
                        r0[0] = v0[0] * cs0[0] - v0[1] * cs0[1]; r0[1] = v0[0] * cs0[1] + v0[1] * cs0[0]; r0[2] = v0[2] * cs0[2] - v0[3] * cs0[3]; r0[3] = v0[2] * cs0[3] + v0[3] * cs0[2];
                        r1[0] = v1[0] * cs1[0] - v1[1] * cs1[1]; r1[1] = v1[0] * cs1[1] + v1[1] * cs1[0]; r1[2] = v1[2] * cs1[2] - v1[3] * cs1[3]; r1[3] = v1[2] * cs1[3] + v1[3] * cs1[2];
                        r0 = r0 * ksc; r1 = r1 * ksc;
                        u32x4 w; w.x = cvt_pk_bf16(r0[0], r0[1]); w.y = cvt_pk_bf16(r0[2], r0[3]); w.z = cvt_pk_bf16(r1[0], r1[1]); w.w = cvt_pk_bf16(r1[2], r1[3]);
                        *(u32x4*)(rowp + bj * HALF) = w; } } }
            return;
        }
#pragma unroll
        for (int ai = 0; ai < 2; ++ai)
#pragma unroll
            for (int m = 0; m < 4; ++m) { const int row = row0 + ai * HALF + m * 16; bf16_t* rowp = P + (size_t)row * E_NP + colt + cw;
                const f32x4 cs0 = (f32x4){1.f, 0.f, 1.f, 0.f}, cs1 = cs0;
#pragma unroll
                for (int bj = 0; bj < 2; ++bj) { f32x4 v0 = acc[ai][bj][m][0] + bv[bj][0], v1 = acc[ai][bj][m][1] + bv[bj][1];
                    if (is_gz) { const int cb = 128 * (pn - 16) + 64 * bj + 16 * wc + 4 * fq;
                        const float g0 = gate_sz(v0[0], v0[1]), g1 = gate_sz(v0[2], v0[3]), g2 = gate_sz(v1[0], v1[1]), g3 = gate_sz(v1[2], v1[3]);
                        typedef unsigned u32x2e __attribute__((ext_vector_type(2))); u32x2e wz; wz.x = cvt_pk_bf16(g0, g1); wz.y = cvt_pk_bf16(g2, g3);
                        *(u32x2e*)(P + (size_t)row * E_NP + 4096 + cb) = wz; continue; }
                    if (is_rope) {
                        f32x4 r0, r1;
                        r0[0] = v0[0] * cs0[0] - v0[1] * cs0[1]; r0[1] = v0[0] * cs0[1] + v0[1] * cs0[0]; r0[2] = v0[2] * cs0[2] - v0[3] * cs0[3]; r0[3] = v0[2] * cs0[3] + v0[3] * cs0[2];
                        r1[0] = v1[0] * cs1[0] - v1[1] * cs1[1]; r1[1] = v1[0] * cs1[1] + v1[1] * cs1[0]; r1[2] = v1[2] * cs1[2] - v1[3] * cs1[3]; r1[3] = v1[2] * cs1[3] + v1[3] * cs1[2];
                        v0 = r0 * ksc; v1 = r1 * ksc;
                    }
                    if (is_ssq) { float s = (v0[0] * v0[0] + v0[1] * v0[1]) + (v0[2] * v0[2] + v0[3] * v0[3]) + (v1[0] * v1[0] + v1[1] * v1[1]) + (v1[2] * v1[2] + v1[3] * v1[3]);
                        const int ln = fq * 16 + fr; s += __builtin_bit_cast(float, __builtin_amdgcn_ds_bpermute((ln ^ 16) << 2, __builtin_bit_cast(int, s))); s += __builtin_bit_cast(float, __builtin_amdgcn_ds_bpermute((ln ^ 32) << 2, __builtin_bit_cast(int, s)));
                        if (fq == 0) SSQ[(((size_t)which * mall + row) * 16 + hd0 + bj) * 4 + wc] = s; }
                    u32x4 w; w.x = cvt_pk_bf16(v0[0], v0[1]); w.y = cvt_pk_bf16(v0[2], v0[3]); w.z = cvt_pk_bf16(v1[0], v1[1]); w.w = cvt_pk_bf16(v1[2], v1[3]);
                    *(u32x4*)(rowp + bj * HALF) = w; } }
    }
};
typedef EpiInT<false> EpiIn;
typedef EpiInT<true> EpiInQ;

template <int SECOND> struct EpiMerge {
    static constexpr bool PERM = true, AFTER_DRAIN = false;
    const bf16_t* P; int goff; const bf16_t* Tin; bf16_t* O;
    __device__ __forceinline__ void operator()(const f32x4 (&acc)[2][2][4][2], const Unit& u, int wr, int wc, int fr, int fq) const {
        const int row0 = u.pm * BM + wr * 64 + fr; const int col0 = u.pn * BM + wc * 32 + 8 * fq;
#pragma unroll
        for (int ai = 0; ai < 2; ++ai)
#pragma unroll
            for (int m = 0; m < 4; ++m) { const int row = row0 + ai * HALF + m * 16;
#pragma unroll
                for (int bj = 0; bj < 2; ++bj) { const int col = col0 + bj * HALF;
                    const u32x4 gw = *(const u32x4*)(P + (size_t)row * E_NP + goff + col);
                    f32x4 v0 = acc[ai][bj][m][0], v1 = acc[ai][bj][m][1];
                    v0[0] *= sigmoid_f(bf_lo(gw.x)); v0[1] *= sigmoid_f(bf_hi(gw.x)); v0[2] *= sigmoid_f(bf_lo(gw.y)); v0[3] *= sigmoid_f(bf_hi(gw.y));
                    v1[0] *= sigmoid_f(bf_lo(gw.z)); v1[1] *= sigmoid_f(bf_hi(gw.z)); v1[2] *= sigmoid_f(bf_lo(gw.w)); v1[3] *= sigmoid_f(bf_hi(gw.w));
                    if (SECOND) { const u32x4 tw = *(const u32x4*)(Tin + (size_t)row * 2048 + col);
                        v0[0] += bf_lo(tw.x); v0[1] += bf_hi(tw.x); v0[2] += bf_lo(tw.y); v0[3] += bf_hi(tw.y); v1[0] += bf_lo(tw.z); v1[1] += bf_hi(tw.z); v1[2] += bf_lo(tw.w); v1[3] += bf_hi(tw.w); }
                    u32x4 w; w.x = cvt_pk_bf16(v0[0], v0[1]); w.y = cvt_pk_bf16(v0[2], v0[3]); w.z = cvt_pk_bf16(v1[0], v1[1]); w.w = cvt_pk_bf16(v1[2], v1[3]);
                    *(u32x4*)(O + (size_t)row * 2048 + col) = w; } }
    }
};

struct PairOrder {
    StaticOrder base; int single;
    __device__ bool next(int i, Unit& u) const {
        if (single >= 0) { if (i >= 1) return false; const int t = single & 15, br = single >> 4; u.pm = 128 + (t >> 3) + 130 * br; u.pn = (t & 7) + 8 * br; return true; }
        if (!base.next(i >> 1, u)) return false;
        if (i & 1) { u.pm += 130; u.pn += 8; }
        return true; }
    __device__ __forceinline__ void a_ready(const Unit&) const {}
    __device__ __forceinline__ void done(const Unit&) const {}
};
struct MapOrder {
    StaticOrder base; unsigned mask; int i0 = 0, i1 = 1 << 30, n2 = 0, n1 = 0;
    __device__ bool next(int i, Unit& u) const {
        i += i0; if (i >= i1) return false;
        if (n2 > 0 && i >= base.nwg / base.G) {
            const int j = i - base.nwg / base.G, c = base.c; long L = (long)(base.nwg / base.G) * base.G;
            if (c < n2) { if (j >= 2) return false; L += 2 * c + j; } else if (c < n2 + n1) { if (j >= 1) return false; L += 2 * n2 + (c - n2); } else return false;
            if (!base.at(L, u)) return false;
        } else
        if (!base.next(i, u)) return false;
        const int g = u.pn >> 3; int pos = 10, cnt = 0;
#pragma unroll
        for (int b = 0; b < 10; ++b) if ((mask >> b) & 1u) { if (cnt == g) pos = b; ++cnt; }
        u.pn = pos * 8 + (u.pn & 7);
        return true; }
    __device__ __forceinline__ void a_ready(const Unit&) const {}
    __device__ __forceinline__ void done(const Unit&) const {}
};
struct EpiMergePair {
    static constexpr bool PERM = true, AFTER_DRAIN = false;
    const bf16_t* P; bf16_t* T; long yoff; int add_t;
    __device__ __forceinline__ void operator()(const f32x4 (&acc)[2][2][4][2], const Unit& u, int wr, int wc, int fr, int fq) const {
        asm volatile("" : "+v"(fr), "+v"(fq));
        const bool second = u.pn >= 8; const int pm = second ? u.pm - 130 : u.pm, pn = second ? u.pn - 8 : u.pn; const int goff = second ? 18432 : 16384;
        const int row0 = pm * BM + wr * 64 + fr; const int col0 = pn * BM + wc * 32 + 8 * fq;
        const bool addt = second && add_t;
#pragma unroll
        for (int ai = 0; ai < 2; ++ai) {
            u32x4 gw[4][2], tw[4][2];
#pragma unroll
            for (int m = 0; m < 4; ++m)
#pragma unroll
                for (int bj = 0; bj < 2; ++bj) { const int row = row0 + ai * HALF + m * 16, col = col0 + bj * HALF;
                    gw[m][bj] = *(const u32x4*)(P + (size_t)row * E_NP + goff + col);
                    tw[m][bj] = addt ? *(const u32x4*)(T + (size_t)row * 2048 + col) : (u32x4){0u, 0u, 0u, 0u}; }
#pragma unroll
            for (int m = 0; m < 4; ++m)
#pragma unroll
                for (int bj = 0; bj < 2; ++bj) { const int row = row0 + ai * HALF + m * 16, col = col0 + bj * HALF;
                    const u32x4 g = gw[m][bj], t = tw[m][bj];
                    f32x4 v0 = acc[ai][bj][m][0], v1 = acc[ai][bj][m][1];
                    v0[0] = v0[0] * sigmoid_f(bf_lo(g.x)) + bf_lo(t.x); v0[1] = v0[1] * sigmoid_f(bf_hi(g.x)) + bf_hi(t.x); v0[2] = v0[2] * sigmoid_f(bf_lo(g.y)) + bf_lo(t.y); v0[3] = v0[3] * sigmoid_f(bf_hi(g.y)) + bf_hi(t.y);
                    v1[0] = v1[0] * sigmoid_f(bf_lo(g.z)) + bf_lo(t.z); v1[1] = v1[1] * sigmoid_f(bf_hi(g.z)) + bf_hi(t.z); v1[2] = v1[2] * sigmoid_f(bf_lo(g.w)) + bf_lo(t.w); v1[3] = v1[3] * sigmoid_f(bf_hi(g.w)) + bf_hi(t.w);
                    u32x4 w; w.x = cvt_pk_bf16(v0[0], v0[1]); w.y = cvt_pk_bf16(v0[2], v0[3]); w.z = cvt_pk_bf16(v1[0], v1[1]); w.w = cvt_pk_bf16(v1[2], v1[3]);
                    *(u32x4*)(T + (second ? yoff : 0l) + (size_t)row * 2048 + col) = w; }
        }
        if (!second && add_t != 2) asm volatile("s_waitcnt vmcnt(0)" ::: "memory");
    }
};

struct SliceOrder {
    int c;
    __device__ bool next(int i, Unit& u) const { if (i >= 1 || c >= 64) return false; const int t = c >> 2; u.pm = 128 + (t >> 3); u.pn = t & 7; return true; }
    __device__ __forceinline__ void a_ready(const Unit&) const {}
    __device__ __forceinline__ void done(const Unit&) const {}
};
struct EpiPart {
    static constexpr bool PERM = true, AFTER_DRAIN = false;
    float* part;
    __device__ __forceinline__ void operator()(const f32x4 (&acc)[2][2][4][2], const Unit& u, int wr, int wc, int fr, int fq) const {
        const int row0 = (u.pm - 128) * BM + wr * 64 + fr; const int col0 = u.pn * BM + wc * 32 + 8 * fq;
#pragma unroll
        for (int ai = 0; ai < 2; ++ai)
#pragma unroll
            for (int m = 0; m < 4; ++m)
#pragma unroll
                for (int bj = 0; bj < 2; ++bj)
#pragma unroll
                    for (int n = 0; n < 2; ++n) *(f32x4*)(part + (size_t)(row0 + ai * HALF + m * 16) * 2048 + col0 + bj * HALF + 4 * n) = acc[ai][bj][m][n];
    }
};

struct EpiMergeQ {
    static constexpr bool PERM = true, AFTER_DRAIN = false;
    const bf16_t* P; bf16_t* T; long yoff; const float* rs; const float* cs;
    __device__ __forceinline__ void operator()(const f32x4 (&acc)[2][2][4][2], const Unit& u, int wr, int wc, int fr, int fq) const {
        { int l_; asm volatile("v_mbcnt_lo_u32_b32 %0, -1, 0\n\tv_mbcnt_hi_u32_b32 %0, -1, %0" : "=v"(l_)); fr = l_ & 15; fq = l_ >> 4; }
        const int row0 = u.pm * BM + wr * 64 + fr; const int col0 = u.pn * BM + wc * 32 + 8 * fq;
        {
            f32x4 (&A)[2][2][4][2] = const_cast<f32x4 (&)[2][2][4][2]>(acc);
            f32x4 cv[2][2]; float rsv[2][4];
#pragma unroll
            for (int bj = 0; bj < 2; ++bj)
#pragma unroll
                for (int n = 0; n < 2; ++n) cv[bj][n] = *(const f32x4*)(cs + col0 + bj * HALF + 4 * n);
#pragma unroll
            for (int ai = 0; ai < 2; ++ai)
#pragma unroll
                for (int m = 0; m < 4; ++m) rsv[ai][m] = rs[row0 + ai * HALF + m * 16];
#pragma unroll
            for (int ai = 0; ai < 2; ++ai)
#pragma unroll
                for (int m = 0; m < 4; ++m)
#pragma unroll
                    for (int bj = 0; bj < 2; ++bj)
#pragma unroll
                        for (int n = 0; n < 2; ++n) A[ai][bj][m][n] = __builtin_convertvector(__builtin_bit_cast(i32x4, A[ai][bj][m][n]), f32x4) * (cv[bj][n] * rsv[ai][m]);
        }
#pragma unroll
        for (int ah = 0; ah < 4; ++ah) { const int ai = ah >> 1, mh = ah & 1;
            u32x4 gw[2][2], tw[2][2];
#pragma unroll
            for (int mm = 0; mm < 2; ++mm)
#pragma unroll
                for (int bj = 0; bj < 2; ++bj) { const int m = 2 * mh + mm; const int row = row0 + ai * HALF + m * 16, col = col0 + bj * HALF;
                    gw[mm][bj] = *(const u32x4*)(P + (size_t)row * E_NP + 18432 + col);
                    tw[mm][bj] = *(const u32x4*)(T + (size_t)row * 2048 + col); }
#pragma unroll
            for (int mm = 0; mm < 2; ++mm)
#pragma unroll
                for (int bj = 0; bj < 2; ++bj) { const int m = 2 * mh + mm; const int row = row0 + ai * HALF + m * 16, col = col0 + bj * HALF;
                    const u32x4 g = gw[mm][bj], t = tw[mm][bj];
                    f32x4 v0 = acc[ai][bj][m][0], v1 = acc[ai][bj][m][1];
                    v0[0] = v0[0] * sigmoid_f(bf_lo(g.x)) + bf_lo(t.x); v0[1] = v0[1] * sigmoid_f(bf_hi(g.x)) + bf_hi(t.x); v0[2] = v0[2] * sigmoid_f(bf_lo(g.y)) + bf_lo(t.y); v0[3] = v0[3] * sigmoid_f(bf_hi(g.y)) + bf_hi(t.y);
                    v1[0] = v1[0] * sigmoid_f(bf_lo(g.z)) + bf_lo(t.z); v1[1] = v1[1] * sigmoid_f(bf_hi(g.z)) + bf_hi(t.z); v1[2] = v1[2] * sigmoid_f(bf_lo(g.w)) + bf_lo(t.w); v1[3] = v1[3] * sigmoid_f(bf_hi(g.w)) + bf_hi(t.w);
                    u32x4 w; w.x = cvt_pk_bf16(v0[0], v0[1]); w.y = cvt_pk_bf16(v0[2], v0[3]); w.z = cvt_pk_bf16(v1[0], v1[1]); w.w = cvt_pk_bf16(v1[2], v1[3]);
                    *(u32x4*)(T + yoff + (size_t)row * 2048 + col) = w; }
        }
    }
};

template <bool I8> struct EpiOutT {
    static constexpr bool PERM = true, AFTER_DRAIN = false;
    const float* xin_lat; float* xout_lat; const float* xin_ctx; float* xout_ctx; const float* mod; const float* bout;
    const float* rs; const float* cs;
    __device__ __forceinline__ void operator()(const f32x4 (&acc)[2][2][4][2], const Unit& u, int wr, int wc, int fr, int fq) const {
        if constexpr (I8) { int l_; asm volatile("v_mbcnt_lo_u32_b32 %0, -1, 0\n\tv_mbcnt_hi_u32_b32 %0, -1, %0" : "=v"(l_)); fr = l_ & 15; fq = l_ >> 4; }
        const int row0 = u.pm * BM + wr * 64 + fr; const int col0 = u.pn * BM + wc * 32 + 8 * fq;
        if constexpr (I8) {
            f32x4 (&A)[2][2][4][2] = const_cast<f32x4 (&)[2][2][4][2]>(acc);
            f32x4 cv[2][2]; float rsv[2][4];
#pragma unroll
            for (int bj = 0; bj < 2; ++bj)
#pragma unroll
                for (int n = 0; n < 2; ++n) cv[bj][n] = *(const f32x4*)(cs + col0 + bj * HALF + 4 * n);
#pragma unroll
            for (int ai = 0; ai < 2; ++ai)
#pragma unroll
                for (int m = 0; m < 4; ++m) rsv[ai][m] = rs[row0 + ai * HALF + m * 16];
#pragma unroll
            for (int ai = 0; ai < 2; ++ai)
#pragma unroll
                for (int m = 0; m < 4; ++m)
#pragma unroll
                    for (int bj = 0; bj < 2; ++bj)
#pragma unroll
                        for (int n = 0; n < 2; ++n) A[ai][bj][m][n] = __builtin_convertvector(__builtin_bit_cast(i32x4, A[ai][bj][m][n]), f32x4) * (cv[bj][n] * rsv[ai][m]);
        }
        const bool lat = u.pm * BM < E_MLAT; const int jb = lat ? ((u.pm * BM) >> 14) : 2;
        const float* gt = mod + jb * 6144 + 4096;
        f32x4 gv[2][2], bo[2][2];
#pragma unroll
        for (int bj = 0; bj < 2; ++bj)
#pragma unroll
            for (int n = 0; n < 2; ++n) { const int col = col0 + bj * HALF + 4 * n; gv[bj][n] = *(const f32x4*)(gt + col); bo[bj][n] = *(const f32x4*)(bout + col); }
        if constexpr (I8) {
            f32x4 (&A)[2][2][4][2] = const_cast<f32x4 (&)[2][2][4][2]>(acc);
#pragma unroll
            for (int ai = 0; ai < 2; ++ai)
#pragma unroll
                for (int m = 0; m < 4; ++m)
#pragma unroll
                    for (int bj = 0; bj < 2; ++bj)
#pragma unroll
                        for (int n = 0; n < 2; ++n) A[ai][bj][m][n] = gv[bj][n] * (A[ai][bj][m][n] + bo[bj][n]);
        }
        constexpr int RPB = I8 ? 1 : 2;
#pragma unroll
        for (int ai = 0; ai < 2; ++ai)
#pragma unroll
            for (int mh = 0; mh < 4 / RPB; ++mh) {
                f32x4 xv[RPB][2][2];
#pragma unroll
                for (int mm = 0; mm < RPB; ++mm) { const int row = row0 + ai * HALF + (RPB * mh + mm) * 16;
                    const float* xi = lat ? xin_lat + (size_t)row * 2048 : xin_ctx + (size_t)(row - E_MLAT) * 2048;
#pragma unroll
                    for (int bj = 0; bj < 2; ++bj)
#pragma unroll
                        for (int n = 0; n < 2; ++n) xv[mm][bj][n] = *(const f32x4*)(xi + col0 + bj * HALF + 4 * n); }
#pragma unroll
                for (int mm = 0; mm < RPB; ++mm) { const int m = RPB * mh + mm, row = row0 + ai * HALF + m * 16;
                    float* xo = lat ? xout_lat + (size_t)row * 2048 : xout_ctx + (size_t)(row - E_MLAT) * 2048;
#pragma unroll
                    for (int bj = 0; bj < 2; ++bj)
#pragma unroll
                        for (int n = 0; n < 2; ++n)
                            *(f32x4*)(xo + col0 + bj * HALF + 4 * n) = I8 ? xv[mm][bj][n] + acc[ai][bj][m][n] : xv[mm][bj][n] + gv[bj][n] * (acc[ai][bj][m][n] + bo[bj][n]); }
            }
    }
};
typedef EpiOutT<false> EpiOut;
typedef EpiOutT<true> EpiOutQ;
template <class Epi, class Sched, bool ALIGN_EPI = false, bool SP2 = false, bool I8 = false>
__device__ __forceinline__ void gemm_phase(PG8_LAS unsigned char* lds, const Gemm g, const Sched& S, const Epi& E, const int wid_in) {
    int lane_o; asm volatile("v_mbcnt_lo_u32_b32 %0, -1, 0\n\tv_mbcnt_hi_u32_b32 %0, -1, %0" : "=v"(lane_o)); const int tid = wid_in * 64 + lane_o;
    const int wid = wid_in, lane = lane_o, wr = wid >> 2, wc = wid & 3, fr = lane & 15, fq = lane >> 4;
    const int K = g.K, nt = g.kext / BK;
    unsigned voffA[2], voffB[2];
#pragma unroll
    for (int i = 0; i < 2; ++i) { int R, C; stage_rc(tid * 16 + i * 8192, R, C); const int Rb = Epi::PERM ? ((R & ~31) + perm32(R & 31)) : R;
        voffA[i] = (unsigned)(R * K + C) * 2u; voffB[i] = (unsigned)(Rb * K + C) * 2u; }
    const size_t kstep = (size_t)(BK * 2);
    const size_t hstep = (size_t)HALF * K * 2;
    const size_t tstep = 2 * hstep;
    const unsigned ldsw = (unsigned)wid * 1024u;
    const int aoff = lds_byte(wr * 64 + fr, fq * 8), boff = lds_byte(wc * 32 + fr, fq * 8);
#define PG8_SA(b, h) (((b) * 2 + (h)) * HTB)
#define PG8_SB(b, h) ((4 + (b) * 2 + (h)) * HTB)
#define PG8_STAGE(bufoff, gbase, voff) do { _Pragma("unroll") for (int _i = 0; _i < 2; ++_i) \
        __builtin_amdgcn_global_load_lds((const unsigned*)((const char*)(gbase) + (voff)[_i]), (PG8_LAS unsigned*)(lds + (bufoff) + ldsw + _i * 8192), 16, 0, 0); } while (0)
#define PG8_LDA(dst, b, h) do { _Pragma("unroll") for (int m = 0; m < 4; ++m) _Pragma("unroll") for (int k = 0; k < 2; ++k) dst[m][k] = *(const PG8_LAS bf16x8*)(lds + PG8_SA(b, h) + aoff + m * 2048 + k * 1024); } while (0)
#define PG8_LDB(dst, b, h) do { _Pragma("unroll") for (int n = 0; n < 2; ++n) _Pragma("unroll") for (int k = 0; k < 2; ++k) dst[n][k] = *(const PG8_LAS bf16x8*)(lds + PG8_SB(b, h) + boff + n * 2048 + k * 1024); } while (0)
#define PG8_MMA(ai, bj, At, Bt) do { __builtin_amdgcn_s_setprio(1); _Pragma("unroll") for (int m = 0; m < 4; ++m) _Pragma("unroll") for (int n = 0; n < 2; ++n) _Pragma("unroll") for (int k = 0; k < 2; ++k) \
        { if constexpr (I8) acc[ai][bj][m][n] = __builtin_bit_cast(f32x4, __builtin_amdgcn_mfma_i32_16x16x64_i8(__builtin_bit_cast(i32x4, Bt[n][k]), __builtin_bit_cast(i32x4, At[m][k]), __builtin_bit_cast(i32x4, acc[ai][bj][m][n]), 0, 0, 0)); \
          else acc[ai][bj][m][n] = __builtin_amdgcn_mfma_f32_16x16x32_bf16(Bt[n][k], At[m][k], acc[ai][bj][m][n], 0, 0, 0); } __builtin_amdgcn_s_setprio(0); } while (0)
#define PG8_WAIT_V(n) asm volatile("s_waitcnt vmcnt(" #n ")" ::: "memory")
#define PG8_WAIT_L(n) asm volatile("s_waitcnt lgkmcnt(" #n ")" ::: "memory")
#define PG8_BAR __builtin_amdgcn_s_barrier()
#define PG8_SCHED __builtin_amdgcn_sched_barrier(0)
    Unit cur, nxt; int ui = 0;
    if (!S.next(0, cur)) return;
    f32x4 acc[2][2][4][2];
#pragma unroll
    for (int a = 0; a < 2; ++a)
#pragma unroll
        for (int b = 0; b < 2; ++b)
#pragma unroll
            for (int m = 0; m < 4; ++m)
#pragma unroll
                for (int n = 0; n < 2; ++n) acc[a][b][m][n] = (f32x4){0.f, 0.f, 0.f, 0.f};
    bf16x8 At[4][2], B0[2][2], B1[2][2];
    const char* cA = (const char*)g.A + (size_t)cur.pm * tstep; const char* cB = (const char*)g.Bt + (size_t)cur.pn * tstep;
    S.a_ready(cur);
    if constexpr (SP2) {
        PG8_STAGE(PG8_SB(0, 0), cB, voffB); PG8_STAGE(PG8_SB(0, 1), cB + hstep, voffB); PG8_STAGE(PG8_SA(0, 0), cA, voffA); PG8_STAGE(PG8_SA(0, 1), cA + hstep, voffA);
        if (wr == 1) PG8_BAR;
        PG8_WAIT_V(2); PG8_BAR;
        PG8_STAGE(PG8_SB(1, 0), cB + kstep, voffB); PG8_STAGE(PG8_SA(1, 0), cA + kstep, voffA); PG8_STAGE(PG8_SB(1, 1), cB + hstep + kstep, voffB);
        PG8_WAIT_V(6); PG8_BAR;
    } else {
        PG8_STAGE(PG8_SB(0, 0), cB, voffB); PG8_STAGE(PG8_SA(0, 0), cA, voffA); PG8_STAGE(PG8_SB(0, 1), cB + hstep, voffB); PG8_STAGE(PG8_SA(0, 1), cA + hstep, voffA);
        if (wr == 1) PG8_BAR;
        PG8_WAIT_V(4); PG8_BAR;
        PG8_STAGE(PG8_SB(1, 0), cB + kstep, voffB); PG8_STAGE(PG8_SA(1, 0), cA + kstep, voffA); PG8_STAGE(PG8_SB(1, 1), cB + hstep + kstep, voffB);
        PG8_WAIT_V(6); PG8_BAR;
    }
    for (;;) {
        const bool has_next = S.next(ui + 1, nxt);
        const char* nA = has_next ? (const char*)g.A + (size_t)nxt.pm * tstep : cA; const char* nB = has_next ? (const char*)g.Bt + (size_t)nxt.pn * tstep : cB;
        for (int t = 0; t < nt; t += 2) {
            const bool last = (t == nt - 2);
            const char* a1 = cA + (size_t)(t + 1) * kstep;
            const char* a2 = last ? nA : cA + (size_t)(t + 2) * kstep; const char* b2 = last ? nB : cB + (size_t)(t + 2) * kstep;
            const char* a3 = a2 + kstep; const char* b3 = b2 + kstep;
            if (last && has_next) S.a_ready(nxt);
            if constexpr (SP2) {
            PG8_LDB(B0, 0, 0); PG8_LDB(B1, 0, 1); PG8_SCHED; PG8_LDA(At, 0, 0); PG8_STAGE(PG8_SA(1, 1), a1 + hstep, voffA);
            PG8_WAIT_V(8); PG8_WAIT_L(0); PG8_BAR; PG8_MMA(0, 0, At, B0); PG8_MMA(0, 1, At, B1); PG8_BAR; PG8_SCHED;
            PG8_LDA(At, 0, 1); PG8_STAGE(PG8_SB(0, 0), b2, voffB); PG8_STAGE(PG8_SB(0, 1), b2 + hstep, voffB); PG8_STAGE(PG8_SA(0, 0), a2, voffA);
            PG8_WAIT_V(8); PG8_WAIT_L(0); PG8_BAR; PG8_MMA(1, 0, At, B0); PG8_MMA(1, 1, At, B1); PG8_BAR; PG8_SCHED;
            PG8_LDB(B0, 1, 0); PG8_LDB(B1, 1, 1); PG8_SCHED; PG8_LDA(At, 1, 0); PG8_STAGE(PG8_SA(0, 1), a2 + hstep, voffA);
            PG8_WAIT_V(8); PG8_WAIT_L(0); PG8_BAR; PG8_MMA(0, 0, At, B0); PG8_MMA(0, 1, At, B1); PG8_BAR; PG8_SCHED;
            PG8_LDA(At, 1, 1); PG8_STAGE(PG8_SB(1, 0), b3, voffB); PG8_STAGE(PG8_SB(1, 1), b3 + hstep, voffB); PG8_STAGE(PG8_SA(1, 0), a3, voffA);
            PG8_WAIT_V(8); PG8_WAIT_L(0); PG8_BAR; PG8_MMA(1, 0, At, B0); PG8_MMA(1, 1, At, B1); PG8_BAR; PG8_SCHED;
            } else {
            PG8_LDB(B0, 0, 0); PG8_SCHED; PG8_LDA(At, 0, 0); PG8_STAGE(PG8_SA(1, 1), a1 + hstep, voffA);
            PG8_WAIT_L(8); PG8_BAR; PG8_WAIT_L(0); PG8_MMA(0, 0, At, B0); PG8_BAR; PG8_SCHED;
            PG8_LDB(B1, 0, 1); PG8_STAGE(PG8_SB(0, 0), b2, voffB);
            PG8_BAR; PG8_WAIT_L(0); PG8_MMA(0, 1, At, B1); PG8_BAR;
            PG8_LDA(At, 0, 1); PG8_STAGE(PG8_SA(0, 0), a2, voffA);
            PG8_BAR; PG8_WAIT_L(0); PG8_MMA(1, 0, At, B0); PG8_BAR; PG8_SCHED;
            PG8_STAGE(PG8_SB(0, 1), b2 + hstep, voffB);
            PG8_WAIT_V(6); PG8_BAR; PG8_MMA(1, 1, At, B1); PG8_BAR;
            PG8_LDB(B0, 1, 0); PG8_SCHED; PG8_LDA(At, 1, 0); PG8_STAGE(PG8_SA(0, 1), a2 + hstep, voffA);
            PG8_WAIT_L(8); PG8_BAR; PG8_WAIT_L(0); PG8_MMA(0, 0, At, B0); PG8_BAR; PG8_SCHED;
            PG8_LDB(B1, 1, 1); PG8_STAGE(PG8_SB(1, 0), b3, voffB);
            PG8_BAR; PG8_WAIT_L(0); PG8_MMA(0, 1, At, B1); PG8_BAR;
            PG8_LDA(At, 1, 1); PG8_STAGE(PG8_SA(1, 0), a3, voffA);
            PG8_BAR; PG8_WAIT_L(0); PG8_MMA(1, 0, At, B0); PG8_BAR; PG8_SCHED;
            PG8_STAGE(PG8_SB(1, 1), b3 + hstep, voffB);
            PG8_WAIT_V(6); PG8_BAR; PG8_MMA(1, 1, At, B1); PG8_BAR;
            }
        }
        if constexpr (ALIGN_EPI) { if (wr == 0) PG8_BAR; }
        if constexpr (!Epi::AFTER_DRAIN) { E(acc, cur, wr, wc, fr, fq); S.done(cur); }
        if (!has_next) break;
#pragma unroll
        for (int a = 0; a < 2; ++a)
#pragma unroll
            for (int b = 0; b < 2; ++b)
#pragma unroll
                for (int m = 0; m < 4; ++m)
#pragma unroll
                    for (int n = 0; n < 2; ++n) acc[a][b][m][n] = (f32x4){0.f, 0.f, 0.f, 0.f};
        cur = nxt; cA = nA; cB = nB; ++ui;
        if constexpr (ALIGN_EPI) { if (wr == 1) PG8_BAR; }
    }
    PG8_WAIT_V(0);
    if constexpr (!ALIGN_EPI) { if (wr == 0) PG8_BAR; }
    PG8_BAR;
    if constexpr (Epi::AFTER_DRAIN) { E.fused(acc, cur, wr, wc, fr, fq, lds, wid, lane); S.done(cur); }
#undef PG8_SA
#undef PG8_SB
#undef PG8_STAGE
#undef PG8_LDA
#undef PG8_LDB
#undef PG8_MMA
#undef PG8_WAIT_V
#undef PG8_WAIT_L
#undef PG8_BAR
#undef PG8_SCHED
}
}
#define GAS __attribute__((address_space(1)))
#define LAS __attribute__((address_space(3)))
typedef unsigned short bf16;
typedef unsigned v4u __attribute__((ext_vector_type(4)));
typedef float f32x4 __attribute__((ext_vector_type(4)));
typedef short bf16x8 __attribute__((ext_vector_type(8)));
typedef GAS unsigned gu32;
typedef GAS unsigned long long gu64;
#define RLX_AGENT __ATOMIC_RELAXED, __HIP_MEMORY_SCOPE_AGENT
#define LDS_WAIT() asm volatile("s_waitcnt lgkmcnt(0)" ::: "memory")
#define VM_WAIT() asm volatile("s_waitcnt vmcnt(0)" ::: "memory")
__device__ __forceinline__ unsigned long long rt() { return __builtin_amdgcn_s_memrealtime(); }
__device__ __forceinline__ unsigned f2bf(float f) { unsigned u = __builtin_bit_cast(unsigned, f); return (u + 0x7fffu + ((u >> 16) & 1u)) >> 16; }
__device__ __forceinline__ unsigned pk2(float lo, float hi) { return f2bf(lo) | (f2bf(hi) << 16); }

#define XB_TMO      128
#define XB_XCNT(j)  (256  + 64 * (j))
#define XB_XSUB(j)  (1280 + 64 * (j))
#define XB_XGEN(j)  (2304 + 64 * (j))
#define XB_TOP      3328
#define XB_TOPGEN   3392
#define XCD_BAR_WORDS 3456
#define XB_SPIN_CAP (1u << 18)

__device__ __forceinline__ unsigned xb_ld(unsigned* p)              { return __hip_atomic_load(p, __ATOMIC_RELAXED, __HIP_MEMORY_SCOPE_AGENT); }
__device__ __forceinline__ unsigned xb_add(unsigned* p, unsigned v) { return __hip_atomic_fetch_add(p, v, __ATOMIC_RELAXED, __HIP_MEMORY_SCOPE_AGENT); }
__device__ __forceinline__ unsigned xb_xcc_id() { return (unsigned)__builtin_amdgcn_s_getreg((3 << 11) | 20) & 0xFu; }
#define XB_SPIN(cond, bar) do { unsigned _sp = 0; while (cond) { __builtin_amdgcn_s_sleep(1); \
    if ((++_sp & 255u) == 0u) { if (xb_ld(&(bar)[XB_TMO])) break; if (_sp > XB_SPIN_CAP) { atomicAdd(&(bar)[XB_TMO], 1u); break; } } } } while (0)

struct XcdBarrier {
    unsigned* bar; unsigned x;
    volatile LAS unsigned* st;
};

__device__ __forceinline__ XcdBarrier xcd_barrier_post(unsigned* bar, volatile LAS unsigned* st) {
    XcdBarrier b; b.bar = bar; b.x = xb_xcc_id(); b.st = st;
    if (threadIdx.x == 0) (void)xb_add(&bar[XB_XCNT(b.x)], 1u);
    return b;
}
__device__ __forceinline__ void xcd_barrier_complete(unsigned* bar, unsigned x, unsigned& nloc, unsigned& nx) {
    const unsigned G = gridDim.x * gridDim.y * gridDim.z;
    unsigned sum, cnt, mine, sp = 0u;
    for (;;) {
        sum = 0u; cnt = 0u; mine = 0u;
#pragma unroll
        for (unsigned j = 0; j < 16; ++j) { const unsigned c = xb_ld(&bar[XB_XCNT(j)]); sum += c; cnt += (c > 0u) ? 1u : 0u; mine = (j == x) ? c : mine; }
        if (sum == G) break;
        __builtin_amdgcn_s_sleep(1);
        if ((++sp & 255u) == 0u) { if (xb_ld(&bar[XB_TMO])) break; if (sp > XB_SPIN_CAP) { atomicAdd(&bar[XB_TMO], 1u); break; } }
    }
    nloc = mine > 0u ? mine : 1u; nx = cnt > 0u ? cnt : 1u;
}

__device__ __forceinline__ void xcd_barrier(const XcdBarrier& b) {
    asm volatile("s_waitcnt vmcnt(0)" ::: "memory");
    __syncthreads();
    if (threadIdx.x == 0) {
        unsigned* bar = b.bar;
        __builtin_amdgcn_s_waitcnt(0);
        unsigned nloc = b.st[0], nx = b.st[1];
        if (nloc == 0u) { xcd_barrier_complete(bar, b.x, nloc, nx); b.st[0] = nloc; b.st[1] = nx; }
        const unsigned old = xb_add(&bar[XB_XSUB(b.x)], 1u);
        const unsigned gen = old / nloc;
        if (old + 1u == (gen + 1u) * nloc) {
            __builtin_amdgcn_fence(__ATOMIC_RELEASE, "agent");
            asm volatile("s_waitcnt vmcnt(0)" ::: "memory");
            const unsigned og = xb_add(&bar[XB_TOP], 1u);
            const unsigned tg = og / nx;
            if (og + 1u == (tg + 1u) * nx) xb_add(&bar[XB_TOPGEN], 1u);
            else XB_SPIN(xb_ld(&bar[XB_TOPGEN]) == tg, bar);
            __builtin_amdgcn_fence(__ATOMIC_ACQUIRE, "agent");
            xb_add(&bar[XB_XGEN(b.x)], 1u);
            asm volatile("s_waitcnt vmcnt(0)" ::: "memory");
        } else {
            XB_SPIN(xb_ld(&bar[XB_XGEN(b.x)]) == gen, bar);
            __builtin_amdgcn_fence(__ATOMIC_ACQUIRE, "agent");
            asm volatile("s_waitcnt vmcnt(0)" ::: "memory");
        }
    }
    __syncthreads();
}


#ifndef G1_I8
#define G1_I8 1
#endif
#ifndef I8_MASK
#define I8_MASK 0x3FEu
#endif
#ifndef POST_XR
#define POST_XR 2304
#endif
#ifndef YQ_XR
#define YQ_XR 5376
#endif
#ifndef G2B_I8
#define G2B_I8 1
#endif
#ifndef G3_I8
#define G3_I8 1
#endif
#ifndef G1_WGMQ
#define G1_WGMQ 5
#endif
#ifndef G1_BAL
#define G1_BAL 0
#endif
#ifndef G1_STAGGER
#define G1_STAGGER 0
#endif
#define I8_TILE(pn) ((pn) < 80 && ((I8_MASK >> ((pn) >> 3)) & 1u))
#define I8_NT (8 * __builtin_popcount(I8_MASK))
constexpr int NWAVES = 8;
constexpr int DM = 2048, NBATCH = 2, SEQ = 16384, CTXL = 256, DEPTH = 4;
constexpr int MLAT = NBATCH * SEQ, MCTX = NBATCH * CTXL, MALL = MLAT + MCTX;
constexpr int NIN = 20512, NP = 20608, NPAD = 20736;
constexpr int OFF_AQ = 0, OFF_AK = 1024, OFF_AV = 2048, OFF_AO = 4096, OFF_AZ = 6144, OFF_BQ = 8192, OFF_BK = 10240, OFF_BV = 12288, OFF_BZ = 14336, OFF_GA = 16384, OFF_GB = 18432;
constexpr float EPS = 1e-6f;
static_assert(MALL % 256 == 0 && NPAD % 256 == 0 && pg8::E_MLAT == MLAT && pg8::E_NP == NP, "shapes");

constexpr size_t MiB = 1u << 20;
constexpr size_t WS_CTL = 0, CTL_ZERO_BYTES = 1 * MiB;
constexpr size_t WS_MOD = 1 * MiB;
constexpr size_t WS_ROPE = 1 * MiB + 512 * 1024;
constexpr size_t WS_XC = 2 * MiB;
constexpr size_t WS_G = 6 * MiB;
constexpr size_t WS_SSQ = 11 * MiB;
constexpr size_t WS_STC = 28 * MiB;
constexpr size_t WS_STN = 64 * MiB;
constexpr size_t WS_STS = 64 * MiB + 256 * 1024;
constexpr size_t WS_WIN = 65 * MiB;
constexpr size_t WS_WAB = 389 * MiB;
constexpr size_t WS_WO = 453 * MiB;
constexpr size_t WS_H = 485 * MiB;
constexpr size_t WS_YB = 615 * MiB;
constexpr size_t WS_HF = 745 * MiB;
constexpr size_t WS_HB = 875 * MiB;
constexpr size_t WS_P = 1005 * MiB;
constexpr size_t WS_PART = 2320 * MiB;
constexpr size_t WS_WQ = 2336 * MiB;
constexpr size_t WS_CS = 2498 * MiB;
constexpr size_t WS_RS = 2498 * MiB + 512 * 1024;
constexpr size_t WS_HQ = WS_YB;
constexpr size_t WS_END = 2499 * MiB;
constexpr size_t WS_WBQ0 = WS_WIN + (size_t)2048 * 4096;
constexpr size_t WS_CSB = WS_WIN + (size_t)3072 * 4096;
constexpr size_t WS_YBQ = WS_WIN + (size_t)4096 * 4096;
constexpr size_t WS_RSB = 2498 * MiB + 768 * 1024;
constexpr size_t WS_WOQ0 = WS_WIN + ((size_t)NPAD + 4096) * 4096;
constexpr size_t WS_CSO = WS_WIN + ((size_t)NPAD + 8192) * 4096;
constexpr size_t WS_YBH8 = WS_YB;
constexpr size_t WS_SHB = WS_WIN + ((size_t)2 * NPAD + 4096) * 4096;
static_assert(WS_YBQ + (size_t)MLAT * 2048 <= WS_WIN + (size_t)20480 * 4096 && WS_RSB + (size_t)MLAT * 4 <= WS_END && WS_RS + (size_t)MALL * 4 <= WS_RSB, "ws map 4");
static_assert(WS_WQ + (size_t)4 * NPAD * 2048 <= WS_CS && WS_CS + (size_t)4 * NPAD * 4 <= WS_RS && WS_RS + (size_t)MALL * 4 <= WS_END, "ws map 3");
static_assert(WS_G + (size_t)MALL * 32 * 4 <= WS_SSQ && WS_SSQ + (size_t)2 * MALL * 64 * 4 <= WS_STC && WS_STC + (size_t)288 * 131072 <= WS_STN, "ws map 1");
static_assert(WS_WIN + (size_t)4 * NPAD * 2048 * 2 <= WS_WAB && WS_H + (size_t)MALL * 2048 * 2 <= WS_YB && WS_P + (size_t)MALL * NP * 2 <= WS_END, "ws map 2");
constexpr int CW_BAR = 4096;

constexpr int RING_BYTES = 131072;
constexpr int MISC_OFF = RING_BYTES + 320;
constexpr int LDS_BYTES = 147456;

typedef short s16x4 __attribute__((ext_vector_type(4)));
typedef float f32x16 __attribute__((ext_vector_type(16)));
typedef unsigned v2u __attribute__((ext_vector_type(2)));
typedef float f32x2 __attribute__((ext_vector_type(2)));
typedef __bf16 bf16x2_t __attribute__((ext_vector_type(2)));
__device__ __forceinline__ unsigned pkh(float lo, float hi) { f32x2 v = {lo, hi}; bf16x2_t b = __builtin_convertvector(v, bf16x2_t); return __builtin_bit_cast(unsigned, b); }
#define MFMA32(a, b, c) __builtin_amdgcn_mfma_f32_32x32x16_bf16((a), (b), (c), 0, 0, 0)
#define MFMA16(a, b, c) __builtin_amdgcn_mfma_f32_16x16x32_bf16((a), (b), (c), 0, 0, 0)

__device__ __forceinline__ float bf2f(unsigned short x) { return __builtin_bit_cast(float, (unsigned)x << 16); }
__device__ __forceinline__ float bflo(unsigned w) { return __builtin_bit_cast(float, w << 16); }
__device__ __forceinline__ float bfhi(unsigned w) { return __builtin_bit_cast(float, w & 0xffff0000u); }
__device__ __forceinline__ float sigm(float x) { return __builtin_amdgcn_rcpf(1.0f + __builtin_amdgcn_exp2f(-1.4426950408889634f * x)); }
__device__ __forceinline__ float silu(float x) { return x * __builtin_amdgcn_rcpf(1.0f + __builtin_amdgcn_exp2f(-1.4426950408889634f * x)); }
__device__ __forceinline__ int crow(int reg, int h) { return (reg & 3) + 8 * (reg >> 2) + 4 * h; }
__device__ __forceinline__ float shx(float v, int mask, int lane) { return __builtin_bit_cast(float, __builtin_amdgcn_ds_bpermute((lane ^ mask) << 2, __builtin_bit_cast(int, v))); }
__device__ __forceinline__ float shi(float v, int src, int lane) { (void)lane; return __builtin_bit_cast(float, __builtin_amdgcn_ds_bpermute(src << 2, __builtin_bit_cast(int, v))); }
__device__ __forceinline__ float shup(float v, int d, int lane) { return __builtin_bit_cast(float, __builtin_amdgcn_ds_bpermute((lane >= d ? lane - d : lane) << 2, __builtin_bit_cast(int, v))); }
__device__ __forceinline__ float wave_sum(float v, int lane) {
#pragma unroll
    for (int o = 1; o < 64; o <<= 1) v += shx(v, o, lane);
    return v;
}
__device__ __forceinline__ s16x4 tr_read(const LAS unsigned char* p) { return __builtin_bit_cast(s16x4, __builtin_amdgcn_ds_read_tr16_b64_v4i16((LAS s16x4*)p)); }
__device__ __forceinline__ bf16x8 cat8(s16x4 lo, s16x4 hi) { return __builtin_shufflevector(lo, hi, 0, 1, 2, 3, 4, 5, 6, 7); }
__device__ __forceinline__ int fresh_lane() { int l; asm volatile("v_mbcnt_lo_u32_b32 %0, -1, 0\n\tv_mbcnt_hi_u32_b32 %0, -1, %0" : "=v"(l)); return l; }
#define LBAR() asm volatile("s_waitcnt lgkmcnt(0)\n\ts_barrier" ::: "memory")
__device__ __forceinline__ void pair_swap(v2u& a, v2u& b) {
    auto r0 = __builtin_amdgcn_permlane32_swap(a.x, b.x, false, false); a.x = r0[0]; b.x = r0[1];
    auto r1 = __builtin_amdgcn_permlane32_swap(a.y, b.y, false, false); a.y = r1[0]; b.y = r1[1];
}
__device__ __forceinline__ int clampi(int v, int lo, int hi) { return v < lo ? lo : (v > hi ? hi : v); }

struct Args { const float* in[17]; float* out; unsigned char* ws; int ph_lo, ph_hi; };

__device__ __forceinline__ void transpose_item(const float* W, int K, int N, bf16* WT, int dst_row0, int rstride, int k0, int n0, LAS float* scr, int lane) {
    { f32x4 v[8];
#pragma unroll
        for (int i = 0; i < 8; ++i) v[i] = *(const GAS f32x4*)(W + (size_t)(k0 + 8 * i + (lane >> 3)) * N + n0 + 4 * (lane & 7));
#pragma unroll
        for (int i = 0; i < 8; ++i) { LAS float* d = scr + (8 * i + (lane >> 3)) * 33 + 4 * (lane & 7); d[0] = v[i].x; d[1] = v[i].y; d[2] = v[i].z; d[3] = v[i].w; } }
    LDS_WAIT(); asm volatile("" ::: "memory");
    const int c = lane & 7;
#pragma unroll
    for (int j = 0; j < 4; ++j) { const int n = (lane >> 3) + 8 * j; const LAS float* s = scr + (8 * c) * 33 + n;
        v4u o; o.x = pkh(s[0 * 33], s[1 * 33]); o.y = pkh(s[2 * 33], s[3 * 33]); o.z = pkh(s[4 * 33], s[5 * 33]); o.w = pkh(s[6 * 33], s[7 * 33]);
        *(GAS v4u*)(WT + (size_t)(dst_row0 + n * rstride) * K + k0 + 8 * c) = o; }
    LDS_WAIT(); asm volatile("" ::: "memory");
}

__constant__ float ROPE_INV[32] = {
1.000000000e+00f, 7.498942614e-01f, 5.623413324e-01f, 4.216965139e-01f, 3.162277639e-01f, 2.371373773e-01f, 1.778279394e-01f, 1.333521307e-01f, 1.000000015e-01f, 7.498941571e-02f, 5.623413250e-02f, 4.216965288e-02f, 3.162277490e-02f, 2.371373773e-02f, 1.778279431e-02f, 1.333521493e-02f, 9.999999776e-03f, 7.498941850e-03f, 5.623413250e-03f, 4.216964822e-03f, 3.162277630e-03f, 2.371373586e-03f, 1.778279431e-03f, 1.333521446e-03f, 1.000000047e-03f, 7.498942432e-04f, 5.623413017e-04f, 4.216965172e-04f, 3.162277571e-04f, 2.371373703e-04f, 1.778279402e-04f, 1.333521504e-04f
};

__device__ __forceinline__ float wave_max(float v, int lane) {
#pragma unroll
    for (int o = 1; o < 64; o <<= 1) v = fmaxf(v, shx(v, o, lane));
    return v;
}
__device__ __forceinline__ unsigned pack_i8(float a, float b, float c, float d) {
    const unsigned ua = __builtin_bit_cast(unsigned, a + 12582912.0f), ub = __builtin_bit_cast(unsigned, b + 12582912.0f), uc = __builtin_bit_cast(unsigned, c + 12582912.0f), ud = __builtin_bit_cast(unsigned, d + 12582912.0f);
    return (ua & 0xffu) | ((ub & 0xffu) << 8) | ((uc & 0xffu) << 16) | (ud << 24);
}
constexpr int SLAB_RS = 4104, SLAB_WMAX = 132096, SLAB_SLOT = 133120, CW_SLAB = 64;
__device__ __forceinline__ void win_slab_item(const Args& a, LAS unsigned char* lds, int l, int nb, int tid, int lane, int wave) {
    unsigned char* ws = a.ws;
    const float* W = a.in[7] + (size_t)l * 2048 * NIN + 32 * nb;
    LAS float* wmax = (LAS float*)(lds + SLAB_WMAX);
    const int cg = tid & 7, kr2 = tid >> 3;
    f32x4 mxv = {0.f, 0.f, 0.f, 0.f};
    for (int s0 = 0; s0 < 16; s0 += 8) {
        f32x4 v0[8], v1[8];
#pragma unroll
        for (int s = 0; s < 8; ++s) { const int k = 2 * kr2 + 128 * (s0 + s); v0[s] = *(const GAS f32x4*)(W + (size_t)k * NIN + 4 * cg); v1[s] = *(const GAS f32x4*)(W + (size_t)(k + 1) * NIN + 4 * cg); }
#pragma unroll
        for (int s = 0; s < 8; ++s) { const int k = 2 * kr2 + 128 * (s0 + s);
            LAS unsigned char* d = lds + (4 * cg) * SLAB_RS + 2 * k;
            const unsigned p0 = pkh(v0[s].x, v1[s].x), p1 = pkh(v0[s].y, v1[s].y), p2 = pkh(v0[s].z, v1[s].z), p3 = pkh(v0[s].w, v1[s].w);
            *(LAS unsigned*)(d) = p0; *(LAS unsigned*)(d + SLAB_RS) = p1; *(LAS unsigned*)(d + 2 * SLAB_RS) = p2; *(LAS unsigned*)(d + 3 * SLAB_RS) = p3;
            mxv.x = fmaxf(mxv.x, fmaxf(__builtin_fabsf(bflo(p0)), __builtin_fabsf(bfhi(p0)))); mxv.y = fmaxf(mxv.y, fmaxf(__builtin_fabsf(bflo(p1)), __builtin_fabsf(bfhi(p1))));
            mxv.z = fmaxf(mxv.z, fmaxf(__builtin_fabsf(bflo(p2)), __builtin_fabsf(bfhi(p2)))); mxv.w = fmaxf(mxv.w, fmaxf(__builtin_fabsf(bflo(p3)), __builtin_fabsf(bfhi(p3)))); }
    }
#pragma unroll
    for (int o = 8; o < 64; o <<= 1) { mxv.x = fmaxf(mxv.x, shx(mxv.x, o, lane)); mxv.y = fmaxf(mxv.y, shx(mxv.y, o, lane)); mxv.z = fmaxf(mxv.z, shx(mxv.z, o, lane)); mxv.w = fmaxf(mxv.w, shx(mxv.w, o, lane)); }
    if (lane < 8) *(LAS f32x4*)(wmax + wave * 32 + 4 * lane) = mxv;
    __syncthreads();
    int dst = nb < 256 ? 32 * nb : (nb == 256 ? 20480 : 32 * nb - 32), rstr = 1;
    if (nb < 64) { const int n0 = 32 * nb, w0 = n0 & 127; dst = (n0 & ~127) + 64 * (w0 >> 6) + ((w0 >> 5) & 1); rstr = 2; }
    else if (nb >= 128 && nb < 192) { dst = 4096 + 2 * (32 * nb - 4096); rstr = 2; }
    else if (nb >= 192 && nb < 256) { dst = 4096 + 2 * (32 * nb - 6144) + 1; rstr = 2; }
#pragma unroll 1
    for (int cc = 0; cc < 4; ++cc) { const int col = 4 * wave + cc, drow = dst + col * rstr;
        float mx = 0.f;
#pragma unroll
        for (int w = 0; w < 8; ++w) mx = fmaxf(mx, wmax[w * 32 + col]);
        const LAS unsigned char* src = lds + col * SLAB_RS + 8 * lane;
        v2u p[8];
#pragma unroll
        for (int i = 0; i < 8; ++i) p[i] = *(const LAS v2u*)(src + 512 * i);
        if (I8_TILE(drow >> 8)) {
            mx = fmaxf(mx, 1e-30f); const float inv = 127.0f * __builtin_amdgcn_rcpf(mx);
            GAS unsigned* o = (GAS unsigned*)(ws + WS_WQ + ((size_t)l * NPAD + drow) * 2048) + lane;
#pragma unroll
            for (int i = 0; i < 8; ++i) o[64 * i] = pack_i8(bflo(p[i].x) * inv, bfhi(p[i].x) * inv, bflo(p[i].y) * inv, bfhi(p[i].y) * inv);
            if (lane == 0) ((float*)(ws + WS_CS))[(size_t)l * NPAD + drow] = mx * (1.0f / 127.0f);
        } else {
            GAS v2u* o = (GAS v2u*)(ws + WS_WIN + ((size_t)l * NPAD + drow) * 4096) + lane;
#pragma unroll
            for (int i = 0; i < 8; ++i) o[64 * i] = p[i];
        }
    }
}

__device__ __forceinline__ void prologue(const Args& a, LAS unsigned char* lds, int tid, int lane, int wave, int rep = 0) {
    unsigned char* ws = a.ws;
    const int G = gridDim.x, bx = blockIdx.x;
    {
        const float* c = a.in[1]; const float* cctx = a.in[3]; const float* wmod = a.in[4]; const float* bmod = a.in[5];
        float* MOD = (float*)(ws + WS_MOD);
        LAS float* red = (LAS float*)lds;
        for (int uu = bx; uu < 96; uu += G) {
            const int l = uu / 24, nc = uu % 24;
            f32x4 a0 = {0.f, 0.f, 0.f, 0.f}, a1 = a0, a2 = a0;
            const float* wp = wmod + ((size_t)l * 2048 + wave * 256) * 6144 + nc * 256 + 4 * lane;
#pragma unroll 16
            for (int k = 0; k < 256; ++k) { const int kk = wave * 256 + k;
                const f32x4 wv = *(const f32x4*)(wp + (size_t)k * 6144);
                const float s0 = silu(c[kk]), s1 = silu(c[2048 + kk]), s2 = silu(cctx[kk]);
                a0 += wv * s0; a1 += wv * s1; a2 += wv * s2; }
            *(LAS f32x4*)(red + (wave * 3 + 0) * 256 + 4 * lane) = a0; *(LAS f32x4*)(red + (wave * 3 + 1) * 256 + 4 * lane) = a1; *(LAS f32x4*)(red + (wave * 3 + 2) * 256 + 4 * lane) = a2;
            __syncthreads();
            for (int o = tid; o < 768; o += 512) { const int j = o >> 8, ci = o & 255; float s = 0.f;
#pragma unroll
                for (int w = 0; w < 8; ++w) s += red[(w * 3 + j) * 256 + ci];
                MOD[(size_t)(l * 3 + j) * 6144 + nc * 256 + ci] = s + bmod[(size_t)l * 6144 + nc * 256 + ci]; }
            __syncthreads();
        }
    }
    {
        float* ROPE = (float*)(ws + WS_ROPE);
        const int gid = bx * 512 + tid;
        if (gid < 8192) { const int pos = gid >> 5, i = gid & 31;
            const float ang = (float)pos * ROPE_INV[i]; const double x = (double)ang;
            const double kq = __builtin_rint(x * 0.63661977236758134308); double r = __builtin_fma(-kq, 1.57079632679489655800, x); r = __builtin_fma(-kq, 6.12323399573676603587e-17, r);
            const int q = ((int)kq) & 3; const double r2 = r * r;
            const double sn = r * (1.0 + r2 * (-1.0 / 6 + r2 * (1.0 / 120 + r2 * (-1.0 / 5040 + r2 * (1.0 / 362880 + r2 * (-1.0 / 39916800 + r2 * (1.0 / 6227020800.0)))))));
            const double cs = 1.0 + r2 * (-0.5 + r2 * (1.0 / 24 + r2 * (-1.0 / 720 + r2 * (1.0 / 40320 + r2 * (-1.0 / 3628800 + r2 * (1.0 / 479001600.0 + r2 * (-1.0 / 87178291200.0)))))));
            const double co = q == 0 ? cs : (q == 1 ? -sn : (q == 2 ? -cs : sn)); const double si = q == 0 ? sn : (q == 1 ? cs : (q == 2 ? -sn : -cs));
            ROPE[gid * 2] = (float)co; ROPE[gid * 2 + 1] = (float)si; }
    }
    {
        LAS float* scr = (LAS float*)(lds + wave * 8448);
        const int gw = bx * NWAVES + wave, NGW = G * NWAVES;
        constexpr int I_SQ = 32 * 64;
        for (int r0 = gw; r0 < 12 * I_SQ; r0 += NGW) {
            const int mat = r0 / (4 * I_SQ), r1 = r0 % (4 * I_SQ), l = r1 / I_SQ, r = r1 % I_SQ, kb = r / 64, nb = r % 64;
            const float* src = (mat == 0 ? a.in[10] : (mat == 1 ? a.in[11] : a.in[15])) + (size_t)l * 2048 * 2048;
            bf16* dstp = mat == 2 ? (bf16*)(ws + WS_WO) + (size_t)l * 2048 * 2048 : (bf16*)(ws + WS_WAB) + ((size_t)l * 2 + mat) * 2048 * 2048;
            transpose_item(src, 2048, 2048, dstp, 32 * nb, 1, 64 * kb, 32 * nb, scr, lane);
        }
        const int gt = bx * 512 + tid, NGT = G * 512;
        for (int p = gt; p < 4 * 57344; p += NGT) { const int l = p / 57344, q = p % 57344;
            *(GAS v4u*)((unsigned char*)(ws + WS_WIN) + ((size_t)l * NPAD + 20512) * 4096 + (size_t)q * 16) = (v4u){0u, 0u, 0u, 0u}; }
    }
    {
        volatile LAS int* slot = (volatile LAS int*)(lds + SLAB_SLOT);
        for (;;) {
            __syncthreads();
            if (tid == 0) *slot = (int)__hip_atomic_fetch_add((unsigned*)(ws + WS_CTL) + CW_SLAB + rep, 1u, __ATOMIC_RELAXED, __HIP_MEMORY_SCOPE_AGENT);
            __syncthreads();
            const int it = __builtin_amdgcn_readfirstlane(*slot);
            if (it >= 4 * 641) break;
            win_slab_item(a, lds, it / 641, it % 641, tid, lane, wave);
        }
    }
}

__device__ __forceinline__ void wquant_rows(unsigned char* ws, int lane, int wave) {
    const int gw = blockIdx.x * NWAVES + wave, NGW = gridDim.x * NWAVES;
    for (int r = gw; r < 4 * NPAD; r += NGW) {
        { const int pn = (r % NPAD) >> 8; if (!I8_TILE(pn)) continue; }
        const GAS v4u* src = (const GAS v4u*)(ws + WS_WIN + (size_t)r * 4096) + lane;
        v4u p[4];
#pragma unroll
        for (int i = 0; i < 4; ++i) p[i] = src[64 * i];
        float mx = 0.f;
#pragma unroll
        for (int i = 0; i < 4; ++i) { mx = fmaxf(mx, fmaxf(fmaxf(__builtin_fabsf(bflo(p[i].x)), __builtin_fabsf(bfhi(p[i].x))), fmaxf(__builtin_fabsf(bflo(p[i].y)), __builtin_fabsf(bfhi(p[i].y)))));
            mx = fmaxf(mx, fmaxf(fmaxf(__builtin_fabsf(bflo(p[i].z)), __builtin_fabsf(bfhi(p[i].z))), fmaxf(__builtin_fabsf(bflo(p[i].w)), __builtin_fabsf(bfhi(p[i].w))))); }
        mx = fmaxf(wave_max(mx, lane), 1e-30f);
        const float inv = 127.0f * __builtin_amdgcn_rcpf(mx);
        GAS v2u* dst = (GAS v2u*)(ws + WS_WQ + (size_t)r * 2048) + lane;
#pragma unroll
        for (int i = 0; i < 4; ++i) { v2u o; o.x = pack_i8(bflo(p[i].x) * inv, bfhi(p[i].x) * inv, bflo(p[i].y) * inv, bfhi(p[i].y) * inv); o.y = pack_i8(bflo(p[i].z) * inv, bfhi(p[i].z) * inv, bflo(p[i].w) * inv, bfhi(p[i].w) * inv);
            dst[64 * i] = o; }
        if (lane == 0) ((float*)(ws + WS_CS))[r] = mx * (1.0f / 127.0f);
    }
}

__device__ __forceinline__ void wbquant_rows(unsigned char* ws, size_t src0, size_t src_lstride, size_t dst0, size_t dst_lstride, size_t cs0, int lane, int wave) {
    int gw = blockIdx.x * NWAVES + wave; const int NGW = gridDim.x * NWAVES;
    asm volatile("" : "+s"(gw));
    for (int r = gw; r < 4 * 2048; r += NGW) { const int lw = r >> 11, n = r & 2047;
        const GAS v4u* src = (const GAS v4u*)(ws + src0 + (size_t)lw * src_lstride + (size_t)n * 4096) + lane;
        v4u p[4];
#pragma unroll
        for (int i = 0; i < 4; ++i) p[i] = src[64 * i];
        float mx = 0.f;
#pragma unroll
        for (int i = 0; i < 4; ++i) { mx = fmaxf(mx, fmaxf(fmaxf(__builtin_fabsf(bflo(p[i].x)), __builtin_fabsf(bfhi(p[i].x))), fmaxf(__builtin_fabsf(bflo(p[i].y)), __builtin_fabsf(bfhi(p[i].y)))));
            mx = fmaxf(mx, fmaxf(fmaxf(__builtin_fabsf(bflo(p[i].z)), __builtin_fabsf(bfhi(p[i].z))), fmaxf(__builtin_fabsf(bflo(p[i].w)), __builtin_fabsf(bfhi(p[i].w))))); }
        mx = fmaxf(wave_max(mx, lane), 1e-30f);
        const float inv = 127.0f * __builtin_amdgcn_rcpf(mx);
        GAS v2u* dst = (GAS v2u*)(ws + dst0 + (size_t)lw * dst_lstride + (size_t)n * 2048) + lane;
#pragma unroll
        for (int i = 0; i < 4; ++i) { v2u o; o.x = pack_i8(bflo(p[i].x) * inv, bfhi(p[i].x) * inv, bflo(p[i].y) * inv, bfhi(p[i].y) * inv); o.y = pack_i8(bflo(p[i].z) * inv, bfhi(p[i].z) * inv, bflo(p[i].w) * inv, bfhi(p[i].w) * inv);
            dst[64 * i] = o; }
        if (lane == 0) ((float*)(ws + cs0))[r] = mx * (1.0f / 127.0f);
    }
}

__device__ __forceinline__ void norm_phase(const Args& a, LAS unsigned char* lds, int l, int tid, int lane, int wave) {
    unsigned char* ws = a.ws;
    const float* MOD = (const float*)(ws + WS_MOD) + (size_t)l * 3 * 6144;
    const float* g = a.in[6] + (size_t)l * 2048;
    LAS float* Al = (LAS float*)lds; LAS float* Sl = Al + 3 * 2048;
    for (int idx = tid; idx < 3 * 2048; idx += 512) { const int j = idx >> 11, col = idx & 2047;
        Al[idx] = g[col] * (1.0f + MOD[j * 6144 + 2048 + col]); Sl[idx] = MOD[j * 6144 + col]; }
    __syncthreads();
    const float* xlat = l == 0 ? a.in[0] : a.out; const float* xctx = l <= 1 ? a.in[2] : (const float*)(ws + WS_XC);
    bf16* H = (bf16*)(ws + WS_H);
    const int gw = blockIdx.x * NWAVES + wave, NGW = gridDim.x * NWAVES;
    f32x4 vn[8];
#define NORM_LOAD(row_, dst) do { const bool lat_ = (row_) < MLAT; const float* xr_ = lat_ ? xlat + (size_t)(row_) * 2048 : xctx + (size_t)((row_) - MLAT) * 2048; \
        _Pragma("unroll") for (int jj = 0; jj < 8; ++jj) dst[jj] = *(const GAS f32x4*)(xr_ + 4 * lane + 256 * jj); } while (0)
    if (gw < MALL) NORM_LOAD(gw, vn);
    for (int row = gw; row < MALL; row += NGW) {
        const bool lat = row < MLAT; const int j = lat ? (row >> 14) : 2;
        f32x4 v[8]; float ss = 0.f;
#pragma unroll
        for (int jj = 0; jj < 8; ++jj) v[jj] = vn[jj];
        if (row + NGW < MALL) NORM_LOAD(row + NGW, vn);
        if (!lat && l > 0) {
            const float* part = (const float*)(ws + WS_PART) + (size_t)(row - MLAT) * 2048; const float* gt = (const float*)(ws + WS_MOD) + (size_t)(l - 1) * 3 * 6144 + 2 * 6144 + 4096; const float* bo = a.in[16] + (size_t)(l - 1) * 2048;
            float* xw = (float*)(ws + WS_XC) + (size_t)(row - MLAT) * 2048;
#pragma unroll
            for (int jj = 0; jj < 8; ++jj) { const int col = 4 * lane + 256 * jj;
                const f32x4 p0 = *(const GAS f32x4*)(part + col), p1 = *(const GAS f32x4*)(part + (size_t)512 * 2048 + col), p2 = *(const GAS f32x4*)(part + (size_t)2 * 512 * 2048 + col), p3 = *(const GAS f32x4*)(part + (size_t)3 * 512 * 2048 + col);
                v[jj] = v[jj] + *(const GAS f32x4*)(gt + col) * (((p0 + p1) + (p2 + p3)) + *(const GAS f32x4*)(bo + col));
                *(GAS f32x4*)(xw + col) = v[jj]; }
        }
#pragma unroll
        for (int jj = 0; jj < 8; ++jj) ss += (v[jj].x * v[jj].x + v[jj].y * v[jj].y) + (v[jj].z * v[jj].z + v[jj].w * v[jj].w);
        const float rstd = __builtin_amdgcn_rsqf(wave_sum(ss, lane) * (1.0f / 2048.0f) + EPS);
#if G1_I8
        float mx = 0.f;
        GAS unsigned long long* o8 = (GAS unsigned long long*)(H + (size_t)row * 2048) + lane;
#pragma unroll
        for (int jj = 0; jj < 8; ++jj) { const f32x4 av = *(LAS f32x4*)(Al + j * 2048 + 4 * lane + 256 * jj), sv = *(LAS f32x4*)(Sl + j * 2048 + 4 * lane + 256 * jj);
            v[jj] = v[jj] * rstd * av + sv;
            o8[64 * jj] = (unsigned long long)pkh(v[jj].x, v[jj].y) | ((unsigned long long)pkh(v[jj].z, v[jj].w) << 32);
            mx = fmaxf(mx, fmaxf(fmaxf(__builtin_fabsf(v[jj].x), __builtin_fabsf(v[jj].y)), fmaxf(__builtin_fabsf(v[jj].z), __builtin_fabsf(v[jj].w)))); }
        mx = fmaxf(wave_max(mx, lane), 1e-30f);
        const float inv = 127.0f * __builtin_amdgcn_rcpf(mx);
        GAS unsigned* o4 = (GAS unsigned*)(ws + WS_HQ + (size_t)row * 2048) + lane;
#pragma unroll
        for (int jj = 0; jj < 8; ++jj) o4[64 * jj] = pack_i8(v[jj].x * inv, v[jj].y * inv, v[jj].z * inv, v[jj].w * inv);
        if (lane == 0) ((float*)(ws + WS_RS))[row] = mx * (1.0f / 127.0f);
#else
        GAS unsigned long long* o8 = (GAS unsigned long long*)(H + (size_t)row * 2048) + lane;
#pragma unroll
        for (int jj = 0; jj < 8; ++jj) { const f32x4 av = *(LAS f32x4*)(Al + j * 2048 + 4 * lane + 256 * jj), sv = *(LAS f32x4*)(Sl + j * 2048 + 4 * lane + 256 * jj);
            const f32x4 o = v[jj] * rstd * av + sv;
            o8[64 * jj] = (unsigned long long)pkh(o.x, o.y) | ((unsigned long long)pkh(o.z, o.w) << 32); }
#endif
    }
#undef NORM_LOAD
    __syncthreads();
}

constexpr int ML_KT = 0, ML_QT = 17408, ML_KW = 34816, ML_VT = 55296, ML_PT = 92160, ML_SC = 101376;
constexpr int KT_STR = 272, KW_STR = 320, VT_STR = 576, PT_STR = 144;
constexpr int SC_U = 0, SC_MJ = 256, SC_WI = 512, SC_TH = 768, SC_NQ = 1024, SC_N = 1280;
constexpr int GS_BS = 103680, GS_U = 111872, GS_CM = 120064, GS_G = 128256;
__device__ __forceinline__ v4u scale_bf8(v4u x, float s) {
    v4u o; o.x = pkh(bflo(x.x) * s, bfhi(x.x) * s); o.y = pkh(bflo(x.y) * s, bfhi(x.y) * s); o.z = pkh(bflo(x.z) * s, bfhi(x.z) * s); o.w = pkh(bflo(x.w) * s, bfhi(x.w) * s); return o;
}
__device__ __forceinline__ bf16x8 pack_acc8(const f32x16& x, int s) {
    v4u p; p.x = pkh(x[8 * s + 0], x[8 * s + 1]); p.y = pkh(x[8 * s + 2], x[8 * s + 3]); p.z = pkh(x[8 * s + 4], x[8 * s + 5]); p.w = pkh(x[8 * s + 6], x[8 * s + 7]);
    return __builtin_bit_cast(bf16x8, p);
}

__device__ __forceinline__ int ml_chunk_base(int seg, int dir, int b, int ci) {
    if (seg == 0) { const int c = dir ? 3 - ci : ci; return MLAT + b * 256 + 64 * c; }
    const int cc = 32 * (seg - 1) + ci; const int c = dir ? 255 - cc : cc; return b * 16384 + 64 * c;
}
template <bool with_out, bool init_comb>
__device__ __forceinline__ void mlstm_unit(const Args& a, LAS unsigned char* lds, int b, int h, int dir, int seg, int tid_, int lane_, int wave) {
    const int lane = fresh_lane(), tid = wave * 64 + lane;
    unsigned char* ws = a.ws;
    const bf16* P = (const bf16*)(ws + WS_P); const float* Gt = (const float*)(ws + WS_G);
    bf16* HOUT = (bf16*)(ws + (dir ? WS_HB : WS_HF));
    float* STC = (float*)(ws + WS_STC); float* STN = (float*)(ws + WS_STN); float* STS = (float*)(ws + WS_STS);
    const int r = lane & 31, hh = lane >> 5, q4 = (lane & 15) >> 2, p4 = lane & 3, blk = (lane >> 4) & 1;
    const int sidx0 = ((b * 8 + h) * 2 + dir) * 9, sidx = sidx0 + seg;
    LAS float* nl = (LAS float*)(lds + ML_SC + SC_N);
    f32x16 C[4];
#pragma unroll
    for (int i = 0; i < 4; ++i)
#pragma unroll
        for (int e = 0; e < 16; ++e) C[i][e] = 0.f;
    float m = -1e30f, Ftot = 0.f; int nb = 0;
    __syncthreads();
    if (!init_comb) { if (tid < 128) nl[tid] = 0.f; }
    else {
        float run = 0.f, m_in = -3e38f;
        for (int k = seg - 1; k >= 0; --k) { const float mk = STS[(sidx0 + k) * 4], fk = STS[(sidx0 + k) * 4 + 1]; m_in = fmaxf(m_in, mk + run); run += fk; }
        run = 0.f; float nacc = 0.f;
#pragma unroll 2
        for (int k = seg - 1; k >= 0; --k) { const float mk = STS[(sidx0 + k) * 4], fk = STS[(sidx0 + k) * 4 + 1]; const float cf = __expf(mk + run - m_in); run += fk;
            const f32x4* src = (const f32x4*)(STC + (size_t)(sidx0 + k) * 32768) + tid;
#pragma unroll
            for (int i = 0; i < 4; ++i)
#pragma unroll
                for (int g4 = 0; g4 < 4; ++g4) { const f32x4 v = src[(4 * i + g4) * 512];
                    C[i][4 * g4 + 0] += cf * v.x; C[i][4 * g4 + 1] += cf * v.y; C[i][4 * g4 + 2] += cf * v.z; C[i][4 * g4 + 3] += cf * v.w; }
            if (tid < 128) nacc += cf * STN[(sidx0 + k) * 128 + tid];
        }
        if (tid < 128) nl[tid] = nacc;
        m = m_in;
    }
    const int nch = seg == 0 ? 4 : 32;
    {
        const int lrow_g = dir ? 63 - lane : lane; const int off_g = lrow_g * 32 + 16 * dir + h;
        float gi4[4], gf4[4];
#pragma unroll
        for (int q = 0; q < 4; ++q) { const int cj = wave + 8 * q; gi4[q] = 0.f; gf4[q] = 0.f;
            if (cj < nch) { const float* gb_ = Gt + (size_t)ml_chunk_base(seg, dir, b, cj) * 32; gi4[q] = gb_[off_g]; gf4[q] = gb_[off_g + 8]; } }
#pragma unroll
        for (int q = 0; q < 4; ++q) { const int cj = wave + 8 * q;
            if (cj < nch) { const float gi = gi4[q], gf = gf4[q];
            const float logf = fminf(gf, 0.f) - log1pf(__expf(-fabsf(gf)));
            float bs = logf;
#pragma unroll
            for (int o = 1; o < 64; o <<= 1) { const float t = shup(bs, o, lane); if (lane >= o) bs += t; }
            const float u = gi - bs; float cm = u;
#pragma unroll
            for (int o = 1; o < 64; o <<= 1) { const float t = shup(cm, o, lane); if (lane >= o) cm = fmaxf(cm, t); }
            *(LAS float*)(lds + GS_BS + (cj * 64 + lane) * 4) = bs; *(LAS float*)(lds + GS_U + (cj * 64 + lane) * 4) = u; *(LAS float*)(lds + GS_CM + (cj * 64 + lane) * 4) = cm;
            if (lane == 63) { *(LAS float*)(lds + GS_G + cj * 4) = bs; *(LAS float*)(lds + GS_G + 128 + cj * 4) = cm; } } }
    }
    v4u kreg[2], qreg[2], vreg[4];
    const int lrow_kq = dir ? 63 - (tid >> 4) : (tid >> 4), lrow_v = dir ? 63 - (tid >> 5) : (tid >> 5);
    const int off_kq = lrow_kq * NP + 8 * (tid & 15), off_v = lrow_v * NP + 8 * (tid & 31);
    const int step_kq = (dir ? -32 : 32) * NP, step_v = (dir ? -16 : 16) * NP;
#define ML_PREFETCH_Q(ci) do { const int base_ = ml_chunk_base(seg, dir, b, ci); const bf16* pb_ = P + (size_t)base_ * NP; \
        if (with_out) { _Pragma("unroll") for (int i = 0; i < 2; ++i) qreg[i] = *(const GAS v4u*)(pb_ + (OFF_AQ + h * 128 + i * step_kq) + off_kq); } } while (0)
#define ML_PREFETCH(ci) do { const int base_ = ml_chunk_base(seg, dir, b, ci); const bf16* pb_ = P + (size_t)base_ * NP; \
        _Pragma("unroll") for (int i = 0; i < 2; ++i) { kreg[i] = *(const GAS v4u*)(pb_ + (OFF_AK + h * 128 + i * step_kq) + off_kq); } \
        _Pragma("unroll") for (int i = 0; i < 4; ++i) vreg[i] = *(const GAS v4u*)(pb_ + (OFF_AV + h * 256 + i * step_v) + off_v); } while (0)
    ML_PREFETCH(0);
    ML_PREFETCH_Q(0);
    for (int ci = 0; ci < nch; ++ci) {
        const int base = ml_chunk_base(seg, dir, b, ci);
        LBAR();
        const float g = *(LAS float*)(lds + GS_G + ci * 4), cm63 = *(LAS float*)(lds + GS_G + 128 + ci * 4);
        const float m_new = fmaxf(g + m, g + cm63);
        const float w_prev = __expf(g + m - m_new);
#pragma unroll
        for (int i = 0; i < 2; ++i) { const int idx = tid + 512 * i, srow = idx >> 4, ch = idx & 15; const float wt = __expf(g + *(LAS float*)(lds + GS_U + (ci * 64 + srow) * 4) - m_new);
            *(LAS v4u*)(lds + ML_KW + srow * KW_STR + ch * 16) = scale_bf8(kreg[i], wt);
            if (with_out) { *(LAS v4u*)(lds + ML_KT + srow * KT_STR + ch * 16) = kreg[i]; *(LAS v4u*)(lds + ML_QT + srow * KT_STR + ch * 16) = qreg[i]; } }
#pragma unroll
        for (int i = 0; i < 4; ++i) { const int idx = tid + 512 * i, srow = idx >> 5, ch = idx & 31; *(LAS v4u*)(lds + ML_VT + srow * VT_STR + ch * 16) = vreg[i]; }
        LBAR();
        if (with_out) {
            const int jt16 = wave >> 1, l15 = lane & 15, l4 = lane >> 4;
            const int j = 16 * jt16 + l15; const float Mjj = fmaxf(m, *(LAS float*)(lds + GS_CM + (ci * 64 + j) * 4));
            bf16x8 qb[4];
#pragma unroll
            for (int ks = 0; ks < 4; ++ks) qb[ks] = *(LAS bf16x8*)(lds + ML_QT + (16 * jt16 + l15) * KT_STR + (32 * ks + 8 * l4) * 2);
#pragma unroll
            for (int tt = 0; tt < 2; ++tt) { const int st16 = 2 * (wave & 1) + tt; f32x4 sacc = {0.f, 0.f, 0.f, 0.f};
                bf16x8 ka[4];
#pragma unroll
                for (int ks = 0; ks < 4; ++ks) ka[ks] = *(LAS bf16x8*)(lds + ML_KT + (16 * st16 + l15) * KT_STR + (32 * ks + 8 * l4) * 2);
                const int s0 = 16 * st16 + 4 * l4; const f32x4 uv = *(LAS f32x4*)(lds + GS_U + (ci * 64 + s0) * 4);
#pragma unroll
                for (int ks = 0; ks < 4; ++ks) sacc = MFMA16(ka[ks], qb[ks], sacc);
                float pv[4];
#pragma unroll
                for (int e = 0; e < 4; ++e) pv[e] = (s0 + e <= j) ? sacc[e] * __expf(uv[e] - Mjj) : 0.f;
                v2u w; w.x = pkh(pv[0], pv[1]); w.y = pkh(pv[2], pv[3]);
                *(LAS v2u*)(lds + ML_PT + j * PT_STR + s0 * 2) = w; }
            { const int jq = tid >> 3, part = tid & 7; const v4u q0 = *(LAS v4u*)(lds + ML_QT + jq * KT_STR + part * 32), q1 = *(LAS v4u*)(lds + ML_QT + jq * KT_STR + part * 32 + 16);
                const LAS f32x4* np = (const LAS f32x4*)(nl + nb * 128 + part * 16); const f32x4 n0 = np[0], n1 = np[1], n2 = np[2], n3 = np[3];
                float s = bflo(q0.x) * n0.x + bfhi(q0.x) * n0.y + bflo(q0.y) * n0.z + bfhi(q0.y) * n0.w + bflo(q0.z) * n1.x + bfhi(q0.z) * n1.y + bflo(q0.w) * n1.z + bfhi(q0.w) * n1.w
                        + bflo(q1.x) * n2.x + bfhi(q1.x) * n2.y + bflo(q1.y) * n2.z + bfhi(q1.y) * n2.w + bflo(q1.z) * n3.x + bfhi(q1.z) * n3.y + bflo(q1.w) * n3.z + bfhi(q1.w) * n3.w;
                s += shx(s, 1, lane); s += shx(s, 2, lane); s += shx(s, 4, lane);
                if (part == 0) *(LAS float*)(lds + ML_SC + SC_NQ + 4 * jq) = s; }
            LBAR();
        }
        if (ci + 1 < nch) ML_PREFETCH(ci + 1);
        bf16x8 vf[4];
#pragma unroll
        for (int ks = 0; ks < 4; ++ks) { const LAS unsigned char* vp = lds + ML_VT + (16 * ks + 8 * hh + q4) * VT_STR + (32 * wave + 16 * blk + 4 * p4) * 2;
            vf[ks] = cat8(tr_read(vp), tr_read(vp + 4 * VT_STR)); }
        if (with_out) {
#pragma unroll 1
            for (int jt = 0; jt < 2; ++jt) {
                f32x16 acc; float rs = 0.f;
#pragma unroll
                for (int e = 0; e < 16; ++e) acc[e] = 0.f;
                const int j = 32 * jt + r;
                const float Mj = fmaxf(m, *(LAS float*)(lds + GS_CM + (ci * 64 + j) * 4)), bsj = *(LAS float*)(lds + GS_BS + (ci * 64 + j) * 4);
                const float wint = __expf(m - Mj), thr = __expf(-(bsj + Mj)), nq = *(LAS float*)(lds + ML_SC + SC_NQ + 4 * j);
                v4u pw[4];
#pragma unroll
                for (int ih = 0; ih < 2; ++ih) { bf16x8 qfr[4];
#pragma unroll
                    for (int ii = 0; ii < 2; ++ii)
#pragma unroll
                        for (int s2 = 0; s2 < 2; ++s2) { const int i = 2 * ih + ii; const LAS unsigned char* qp = lds + ML_QT + (32 * jt + r) * KT_STR + (32 * i + 16 * s2 + 4 * hh) * 2; qfr[2 * ii + s2] = cat8(*(LAS s16x4*)qp, *(LAS s16x4*)(qp + 16)); }
#pragma unroll
                    for (int ii = 0; ii < 2; ++ii)
#pragma unroll
                        for (int s2 = 0; s2 < 2; ++s2) acc = MFMA32(pack_acc8(C[2 * ih + ii], s2), qfr[2 * ii + s2], acc);
                }
#pragma unroll
                for (int ks = 0; ks < 4; ++ks) pw[ks] = *(LAS v4u*)(lds + ML_PT + (32 * jt + r) * PT_STR + (16 * ks + 8 * hh) * 2);
#pragma unroll
                for (int e = 0; e < 16; ++e) acc[e] *= wint;
#pragma unroll
                for (int ks = 0; ks < 4; ++ks) { rs += (bflo(pw[ks].x) + bfhi(pw[ks].x)) + (bflo(pw[ks].y) + bfhi(pw[ks].y)) + (bflo(pw[ks].z) + bfhi(pw[ks].z)) + (bflo(pw[ks].w) + bfhi(pw[ks].w));
                    acc = MFMA32(vf[ks], __builtin_bit_cast(bf16x8, pw[ks]), acc); }
                rs += shx(rs, 32, lane);
                const float den = rs + wint * nq; const float inv = __builtin_amdgcn_rcpf(fmaxf(fabsf(den), thr));
                bf16* op = HOUT + (size_t)base * 2048 + (h * 256 + 32 * wave) + ((dir ? 63 - j : j) * 2048 + 8 * hh);
#pragma unroll
                for (int gp = 0; gp < 2; ++gp) { const int ga = 8 * gp, gb = 8 * gp + 4; v2u wa, wb;
                    wa.x = pkh(acc[ga + 0] * inv, acc[ga + 1] * inv); wa.y = pkh(acc[ga + 2] * inv, acc[ga + 3] * inv); wb.x = pkh(acc[gb + 0] * inv, acc[gb + 1] * inv); wb.y = pkh(acc[gb + 2] * inv, acc[gb + 3] * inv);
                    pair_swap(wa, wb);
                    *(GAS v4u*)(op + 16 * gp) = (v4u){wa.x, wa.y, wb.x, wb.y}; }
            }
            __builtin_amdgcn_sched_barrier(0);
        }
        if (ci + 1 < nch) ML_PREFETCH_Q(ci + 1);
#pragma unroll
        for (int i = 0; i < 4; ++i) {
            bf16x8 ka[4];
#pragma unroll
            for (int ks = 0; ks < 4; ++ks) { const LAS unsigned char* kp = lds + ML_KW + (16 * ks + 8 * hh + q4) * KW_STR + (32 * i + 16 * blk + 4 * p4) * 2; ka[ks] = cat8(tr_read(kp), tr_read(kp + 4 * KW_STR)); }
#pragma unroll
            for (int e = 0; e < 16; ++e) C[i][e] *= w_prev;
#pragma unroll
            for (int ks = 0; ks < 4; ++ks) C[i] = MFMA32(ka[ks], vf[ks], C[i]);
            if (wave == i) { f32x16 nacc;
#pragma unroll
                for (int e = 0; e < 16; ++e) nacc[e] = 0.f;
                const bf16x8 ones = {0x3F80, 0x3F80, 0x3F80, 0x3F80, 0x3F80, 0x3F80, 0x3F80, 0x3F80};
#pragma unroll
                for (int ks = 0; ks < 4; ++ks) nacc = MFMA32(ones, ka[ks], nacc);
                if (hh == 0) nl[(nb ^ 1) * 128 + 32 * i + r] = w_prev * nl[nb * 128 + 32 * i + r] + nacc[0]; }
            __builtin_amdgcn_sched_barrier(0);
        }
        m = m_new; Ftot += g; nb ^= 1;
    }
#undef ML_PREFETCH
#undef ML_PREFETCH_Q
    if (!init_comb) {
        const int tid2 = wave * 64 + fresh_lane();
        f32x4* dst = (f32x4*)((float*)(a.ws + WS_STC) + (size_t)sidx * 32768) + tid2;
#pragma unroll
        for (int i = 0; i < 4; ++i)
#pragma unroll
            for (int g4 = 0; g4 < 4; ++g4) dst[(4 * i + g4) * 512] = (f32x4){C[i][4 * g4 + 0], C[i][4 * g4 + 1], C[i][4 * g4 + 2], C[i][4 * g4 + 3]};
        __syncthreads();
        if (tid2 < 128) ((float*)(a.ws + WS_STN))[sidx * 128 + tid2] = ((LAS float*)(lds + ML_SC + SC_N))[nb * 128 + tid2];
        if (tid2 == 0) { ((float*)(a.ws + WS_STS))[sidx * 4] = m; ((float*)(a.ws + WS_STS))[sidx * 4 + 1] = Ftot; }
    }
}

template <int SUB>
__device__ __forceinline__ void mlstm_phase(const Args& a, LAS unsigned char* lds, int pass, bool need_ctx, int tid, int lane, int wave) {
    if (pass == 1) {
        if (SUB != 2) for (int uu = blockIdx.x; uu < 32; uu += gridDim.x) { const int b = uu >> 4, h = (uu >> 1) & 7, dir = uu & 1; mlstm_unit<true, false>(a, lds, b, h, dir, 0, tid, lane, wave); }
        int v0 = (int)blockIdx.x - 32; if (v0 < 0) v0 += gridDim.x;
        if (SUB != 1) for (int v = v0; v < 224; v += gridDim.x) { const int bhd = v / 7, seg = 1 + v % 7; const int b = bhd >> 4, h = (bhd >> 1) & 7, dir = bhd & 1; mlstm_unit<false, false>(a, lds, b, h, dir, seg, tid, lane, wave); }
    } else {
        for (int u0 = blockIdx.x; u0 < 256; u0 += gridDim.x) { const int uu = (gridDim.x == 256) ? ((u0 & 7) * 32 + (u0 >> 3)) : u0;     const int bhd = uu >> 3, seg = 1 + (uu & 7); const int b = bhd >> 4, h = (bhd >> 1) & 7, dir = bhd & 1; mlstm_unit<true, true>(a, lds, b, h, dir, seg, tid, lane, wave); }
    }
    __syncthreads();
}

__device__ __forceinline__ void post_rows(const Args& a, LAS unsigned char* lds, int l, int row0, int row1, int wrank, int nworkers, int tid, int lane, int wave) {
    unsigned char* ws = a.ws;
    const bf16* P = (const bf16*)(ws + WS_P); const bf16* HF = (const bf16*)(ws + WS_HF); const bf16* HB = (const bf16*)(ws + WS_HB); bf16* YA = (bf16*)(ws + WS_H);
    LAS float* gl = (LAS float*)lds;
    for (int idx = tid; idx < 2048; idx += 512) gl[idx] = a.in[9][(size_t)l * 2048 + idx];
    __syncthreads();
    v4u xh[4], yh[4], gzr[4]; v4u ybr[2]; float shr = 0.f;
    const bool cvt_yb = G2B_I8 && row1 <= MLAT;
    const bf16* YBs = (const bf16*)(ws + WS_YB);
#define POST_LOAD(row_) do { _Pragma("unroll") for (int c = 0; c < 4; ++c) { xh[c] = *(const GAS v4u*)(HF + (size_t)(row_) * 2048 + 32 * lane + 8 * c); yh[c] = *(const GAS v4u*)(HB + (size_t)(row_) * 2048 + 32 * lane + 8 * c); \
            gzr[c] = *(const GAS v4u*)(P + (size_t)(row_) * NP + OFF_AO + 32 * lane + 8 * c); } if (cvt_yb) { const GAS v4u* yq_ = (const GAS v4u*)(ws + WS_YBH8 + (size_t)(row_) * 2048 + 32 * lane); ybr[0] = yq_[0]; ybr[1] = yq_[1]; shr = ((const float*)(ws + WS_SHB))[(size_t)(row_) * 16 + (lane >> 2)]; } } while (0)
    if (row0 + wrank < row1) POST_LOAD(row0 + wrank);
    for (int row = row0 + wrank; row < row1; row += nworkers) {
        float hs[32]; float ss = 0.f; v4u gz[4];
        if (cvt_yb) {
            const float srow = fmaxf(wave_max(shr, lane), 1e-37f); const float ratio = shr * __builtin_amdgcn_rcpf(srow);
            v4u q[2];
#pragma unroll
            for (int c = 0; c < 2; ++c) { const unsigned w4[4] = {ybr[c].x, ybr[c].y, ybr[c].z, ybr[c].w}; unsigned o4[4];
#pragma unroll
                for (int d = 0; d < 4; ++d) { const int w = (int)w4[d];
                    o4[d] = pack_i8((float)((w << 24) >> 24) * ratio, (float)((w << 16) >> 24) * ratio, (float)((w << 8) >> 24) * ratio, (float)(w >> 24) * ratio); }
                q[c] = (v4u){o4[0], o4[1], o4[2], o4[3]}; }
            GAS v4u* qd = (GAS v4u*)(ws + WS_YBQ + (size_t)row * 2048 + 32 * lane); qd[0] = q[0]; qd[1] = q[1];
            if (lane == 0) ((float*)(ws + WS_RSB))[row] = srow;
        }
#pragma unroll
        for (int c = 0; c < 4; ++c) { const v4u x = xh[c], y = yh[c]; gz[c] = gzr[c];
            hs[8 * c + 0] = bflo(x.x) + bflo(y.x); hs[8 * c + 1] = bfhi(x.x) + bfhi(y.x); hs[8 * c + 2] = bflo(x.y) + bflo(y.y); hs[8 * c + 3] = bfhi(x.y) + bfhi(y.y);
            hs[8 * c + 4] = bflo(x.z) + bflo(y.z); hs[8 * c + 5] = bfhi(x.z) + bfhi(y.z); hs[8 * c + 6] = bflo(x.w) + bflo(y.w); hs[8 * c + 7] = bfhi(x.w) + bfhi(y.w); }
        if (row + nworkers < row1) POST_LOAD(row + nworkers);
#pragma unroll
        for (int e = 0; e < 32; ++e) ss += hs[e] * hs[e];
        ss += shx(ss, 1, lane); ss += shx(ss, 2, lane); ss += shx(ss, 4, lane);
        const float rstd = __builtin_amdgcn_rsqf(ss * (1.0f / 256.0f) + EPS);
#pragma unroll
        for (int c = 0; c < 4; ++c) {
            const f32x4 g0 = *(LAS f32x4*)(gl + 32 * lane + 8 * c), g1 = *(LAS f32x4*)(gl + 32 * lane + 8 * c + 4);
            float o[8];
            o[0] = hs[8 * c + 0] * rstd * g0.x * bflo(gz[c].x); o[1] = hs[8 * c + 1] * rstd * g0.y * bfhi(gz[c].x);
            o[2] = hs[8 * c + 2] * rstd * g0.z * bflo(gz[c].y); o[3] = hs[8 * c + 3] * rstd * g0.w * bfhi(gz[c].y);
            o[4] = hs[8 * c + 4] * rstd * g1.x * bflo(gz[c].z); o[5] = hs[8 * c + 5] * rstd * g1.y * bfhi(gz[c].z);
            o[6] = hs[8 * c + 6] * rstd * g1.z * bflo(gz[c].w); o[7] = hs[8 * c + 7] * rstd * g1.w * bfhi(gz[c].w);
#ifdef FAKEQ_YA
#pragma unroll
            for (int e = 0; e < 8; ++e) hs[8 * c + e] = o[e];
        }
        { float mx = 0.f;
#pragma unroll
            for (int e = 0; e < 32; ++e) mx = fmaxf(mx, __builtin_fabsf(hs[e]));
            mx = fmaxf(wave_max(mx, lane), 1e-30f); const float inv = 127.0f * __builtin_amdgcn_rcpf(mx), sc = mx * (1.0f / 127.0f);
#pragma unroll
            for (int e = 0; e < 32; ++e) hs[e] = ((hs[e] * inv + 12582912.0f) - 12582912.0f) * sc; }
#pragma unroll
        for (int c = 0; c < 4; ++c) { float o[8];
#pragma unroll
            for (int e = 0; e < 8; ++e) o[e] = hs[8 * c + e];
#endif
            v4u w; w.x = pkh(o[0], o[1]); w.y = pkh(o[2], o[3]); w.z = pkh(o[4], o[5]); w.w = pkh(o[6], o[7]);
            *(GAS v4u*)(YA + (size_t)row * 2048 + 32 * lane + 8 * c) = w; }
    }
#undef POST_LOAD
    __syncthreads();
}

__device__ __forceinline__ void yquant_rows(unsigned char* ws, int row0, int row1, int gw, int NGW, int lane, int wave) {
    const bf16* Y = (const bf16*)(ws + WS_HB);
    v4u rn[4];
#define YQ_LOAD(row_) do { _Pragma("unroll") for (int c = 0; c < 4; ++c) rn[c] = *(const GAS v4u*)(Y + (size_t)(row_) * 2048 + 32 * lane + 8 * c); } while (0)
    if (row0 + gw < row1) YQ_LOAD(row0 + gw);
    for (int row = row0 + gw; row < row1; row += NGW) {
        v4u r[4];
#pragma unroll
        for (int c = 0; c < 4; ++c) r[c] = rn[c];
        if (row + NGW < row1) YQ_LOAD(row + NGW);
        float mx = 0.f;
#pragma unroll
        for (int c = 0; c < 4; ++c) { mx = fmaxf(mx, fmaxf(fmaxf(__builtin_fabsf(bflo(r[c].x)), __builtin_fabsf(bfhi(r[c].x))), fmaxf(__builtin_fabsf(bflo(r[c].y)), __builtin_fabsf(bfhi(r[c].y)))));
            mx = fmaxf(mx, fmaxf(fmaxf(__builtin_fabsf(bflo(r[c].z)), __builtin_fabsf(bfhi(r[c].z))), fmaxf(__builtin_fabsf(bflo(r[c].w)), __builtin_fabsf(bfhi(r[c].w))))); }
        mx = fmaxf(wave_max(mx, lane), 1e-30f);
        const float inv = 127.0f * __builtin_amdgcn_rcpf(mx);
        v4u q0, q1;
        q0.x = pack_i8(bflo(r[0].x) * inv, bfhi(r[0].x) * inv, bflo(r[0].y) * inv, bfhi(r[0].y) * inv); q0.y = pack_i8(bflo(r[0].z) * inv, bfhi(r[0].z) * inv, bflo(r[0].w) * inv, bfhi(r[0].w) * inv);
        q0.z = pack_i8(bflo(r[1].x) * inv, bfhi(r[1].x) * inv, bflo(r[1].y) * inv, bfhi(r[1].y) * inv); q0.w = pack_i8(bflo(r[1].z) * inv, bfhi(r[1].z) * inv, bflo(r[1].w) * inv, bfhi(r[1].w) * inv);
        q1.x = pack_i8(bflo(r[2].x) * inv, bfhi(r[2].x) * inv, bflo(r[2].y) * inv, bfhi(r[2].y) * inv); q1.y = pack_i8(bflo(r[2].z) * inv, bfhi(r[2].z) * inv, bflo(r[2].w) * inv, bfhi(r[2].w) * inv);
        q1.z = pack_i8(bflo(r[3].x) * inv, bfhi(r[3].x) * inv, bflo(r[3].y) * inv, bfhi(r[3].y) * inv); q1.w = pack_i8(bflo(r[3].z) * inv, bfhi(r[3].z) * inv, bflo(r[3].w) * inv, bfhi(r[3].w) * inv);
        GAS v4u* qd = (GAS v4u*)(ws + WS_YBQ + (size_t)row * 2048 + 32 * lane); qd[0] = q0; qd[1] = q1;
        if (lane == 0) ((float*)(ws + WS_RSB))[row] = mx * (1.0f / 127.0f);
    }
#undef YQ_LOAD
}

constexpr int NA_KT0 = 0, NA_VT0 = 34816, NA_RK0 = 75776, NA_RPB = 76288, NA_FAC = 80128;
constexpr int NK_STR = 272, NV_STR = 320;
constexpr float NEG_BIG = -1e30f, LOG2E = 1.4426950408889634f, NA_THR = 8.0f;

template <bool LAT>
__device__ __forceinline__ void na_tile(const LAS unsigned char* kt, const LAS unsigned char* vt, const LAS float* rkl, int ko, const bf16x8 (&qf)[8], f32x16 (&O)[4], float& mrun, float& lsum,
                                        const LAS unsigned char* baddr, unsigned cmr, int r, int hh, int q4, int p4, int blk, int lane) {
    f32x16 sacc;
#pragma unroll
    for (int e = 0; e < 16; ++e) sacc[e] = 0.f;
    { bf16x8 kf[8];
#pragma unroll
        for (int ks = 0; ks < 8; ++ks) kf[ks] = *(const LAS bf16x8*)(kt + (ko + r) * NK_STR + (16 * ks + 8 * hh) * 2);
#pragma unroll
        for (int ks = 0; ks < 8; ++ks) sacc = MFMA32(kf[ks], qf[ks], sacc); }
    bf16x8 vf[8];
#pragma unroll
    for (int s2 = 0; s2 < 2; ++s2)
#pragma unroll
        for (int i = 0; i < 4; ++i) { const LAS unsigned char* vp = vt + (ko + 16 * s2 + 4 * hh + q4) * NV_STR + (32 * i + 16 * blk + 4 * p4) * 2; vf[4 * s2 + i] = cat8(tr_read(vp), tr_read(vp + 8 * NV_STR)); }
    float tmax = NEG_BIG;
#pragma unroll
    for (int g4 = 0; g4 < 4; ++g4) { const f32x4 rk4 = *(const LAS f32x4*)(rkl + ko + 8 * g4 + 4 * hh);
#pragma unroll
        for (int e = 0; e < 4; ++e) { const int reg = 4 * g4 + e; float s = sacc[reg] * rk4[e];
            if (LAT) { s += *(const LAS float*)(baddr + (8 * g4 + e) * 4); s = (cmr & (1u << reg)) ? s : NEG_BIG; }
            sacc[reg] = s; tmax = fmaxf(tmax, s); } }
    tmax = fmaxf(tmax, shx(tmax, 32, lane));
    if (__builtin_amdgcn_ballot_w64(tmax > mrun + NA_THR) != 0ull) {
        const float mnew = fmaxf(mrun, tmax); const float alpha = __builtin_amdgcn_exp2f(mrun - mnew); mrun = mnew; lsum *= alpha;
#pragma unroll
        for (int i = 0; i < 4; ++i)
#pragma unroll
            for (int e = 0; e < 16; ++e) O[i][e] *= alpha;
    }
    float psum = 0.f;
#pragma unroll
    for (int e = 0; e < 16; ++e) { sacc[e] = __builtin_amdgcn_exp2f(sacc[e] - mrun); psum += sacc[e]; }
    lsum += psum;
#pragma unroll
    for (int s2 = 0; s2 < 2; ++s2) { const bf16x8 pb = pack_acc8(sacc, s2);
#pragma unroll
        for (int i = 0; i < 4; ++i) O[i] = MFMA32(vf[4 * s2 + i], pb, O[i]); }
}

__device__ __forceinline__ void na_unit(const Args& a, LAS unsigned char* lds, int l, int b, int head, int r0, bool is_ctx, int& tab_head, int tid_, int lane_, int wave) {
    const int lane = fresh_lane(), tid = wave * 64 + lane;
    unsigned char* ws = a.ws;
    const bf16* P = (const bf16*)(ws + WS_P); const float* SSQ = (const float*)(ws + WS_SSQ); bf16* YB = (bf16*)(ws + WS_YB);
    const int r = lane & 31, hh = lane >> 5, q4 = (lane & 15) >> 2, p4 = lane & 3, blk = (lane >> 4) & 1;
    const int cb = wave & 3, pair = wave >> 2;
    const int qrow = r0 + 2 * pair + (r >> 4), qcol = 16 * cb + (r & 15);
    const size_t qtok = is_ctx ? (size_t)(MLAT + b * 256 + 32 * wave + r) : (size_t)(b * 16384 + qrow * 64 + qcol);
    const int ws_q = clampi(qcol - 8, 0, 48), rs_q = clampi(qrow - 4, 0, 248);
    const int cs = clampi(16 * cb - 8, 0, 32);
    const int rs_a = clampi(r0 + 2 * pair - 4, 0, 248), rs_b = clampi(r0 + 2 * pair + 1 - 4, 0, 248);
    const int kr_lo = clampi(r0 - 4, 0, 248), kr_hi = clampi(r0 + 3 - 4, 0, 248) + 8;
    const int nlat = is_ctx ? 0 : kr_hi - kr_lo, nsteps = 4 + nlat;
    unsigned cmask = 0u;
#pragma unroll
    for (int reg = 0; reg < 16; ++reg) { const int kc = cs + crow(reg, hh); cmask |= (kc >= ws_q && kc < ws_q + 16) ? (1u << reg) : 0u; }
    const int bidx0 = cs - qcol + 31 + 4 * hh;
    v4u kreg[2], vreg[2]; f32x4 sreg = {0.f, 0.f, 0.f, 0.f};
    const int koff = (tid >> 4) * NP + 8 * (tid & 15);
#define NA_PREFETCH(st) do { const size_t row0_ = (st) < 4 ? (size_t)(MLAT + b * 256 + 64 * (st)) : (size_t)(b * 16384 + (kr_lo + (st) - 4) * 64); const bf16* pb_ = P + row0_ * NP + head * 128; \
        _Pragma("unroll") for (int i = 0; i < 2; ++i) { kreg[i] = *(const GAS v4u*)(pb_ + (OFF_BK + i * 32 * NP) + koff); vreg[i] = *(const GAS v4u*)(pb_ + (OFF_BV + i * 32 * NP) + koff); } \
        if (tid < 64) sreg = *(const GAS f32x4*)(SSQ + (((size_t)MALL + row0_ + tid) * 16 + head) * 4); } while (0)
    NA_PREFETCH(0);
    LBAR();
    if (head != tab_head) { const float* rp = a.in[14] + ((size_t)l * 16 + head) * 465; LAS float* rl = (LAS float*)(lds + NA_RPB);
        for (int idx = tid; idx < 960; idx += 512) { const int dr = idx >> 6, dc = (idx & 63) - 16; rl[idx] = (dc >= 0 && dc < 31) ? rp[dr * 31 + dc] * LOG2E : 0.f; }
        if (tid < 128) ((LAS float*)(lds + NA_FAC))[tid] = a.in[12][(size_t)l * 128 + tid] * a.in[13][(size_t)l * 128 + tid] * (0.08838834764831845f * LOG2E);
        tab_head = head;
        __syncthreads(); }
    bf16x8 qf[8];
    { const f32x4 sq = *(const GAS f32x4*)(SSQ + (qtok * 16 + head) * 4); const float rq = __builtin_amdgcn_rsqf(((sq.x + sq.y) + (sq.z + sq.w)) * (1.0f / 128.0f) + EPS);
        v4u xq[8];
#pragma unroll
        for (int ks = 0; ks < 8; ++ks) xq[ks] = *(const GAS v4u*)(P + qtok * NP + OFF_BQ + head * 128 + 16 * ks + 8 * hh);
#pragma unroll
        for (int ks = 0; ks < 8; ++ks) { const v4u x = xq[ks];
            const LAS f32x4* fp = (const LAS f32x4*)(lds + NA_FAC + (16 * ks + 8 * hh) * 4); const f32x4 f0 = fp[0] * rq, f1 = fp[1] * rq;
            v4u o; o.x = pkh(bflo(x.x) * f0.x, bfhi(x.x) * f0.y); o.y = pkh(bflo(x.y) * f0.z, bfhi(x.y) * f0.w); o.z = pkh(bflo(x.z) * f1.x, bfhi(x.z) * f1.y); o.w = pkh(bflo(x.w) * f1.z, bfhi(x.w) * f1.w);
            qf[ks] = __builtin_bit_cast(bf16x8, o); } }
    f32x16 O[4];
#pragma unroll
    for (int i = 0; i < 4; ++i)
#pragma unroll
        for (int e = 0; e < 16; ++e) O[i][e] = 0.f;
    float mrun = NEG_BIG, lsum = 0.f;
#define NA_STAGE(st) do { \
        _Pragma("unroll") for (int i = 0; i < 2; ++i) { const int idx = tid + 512 * i, kk = idx >> 4, ch = idx & 15; \
            *(LAS v4u*)(kt + kk * NK_STR + ch * 16) = kreg[i]; *(LAS v4u*)(vt + kk * NV_STR + ch * 16) = vreg[i]; } \
        if (tid < 64) rkl[tid] = __builtin_amdgcn_rsqf(((sreg.x + sreg.y) + (sreg.z + sreg.w)) * (1.0f / 128.0f) + EPS); \
        if ((st) + 1 < nsteps) NA_PREFETCH((st) + 1); \
        LBAR(); } while (0)
#pragma unroll 1
    for (int st = 0; st < 4; ++st) {
        const int buf = st & 1;
        LAS unsigned char* kt = lds + NA_KT0 + buf * 17408; LAS unsigned char* vt = lds + NA_VT0 + buf * 20480; LAS float* rkl = (LAS float*)(lds + NA_RK0 + buf * 256);
        NA_STAGE(st);
#pragma unroll 1
        for (int tl = 0; tl < 2; ++tl) na_tile<false>(kt, vt, rkl, 32 * tl, qf, O, mrun, lsum, nullptr, 0u, r, hh, q4, p4, blk, lane);
    }
#pragma unroll 1
    for (int st = 4; st < nsteps; ++st) {
        const int buf = st & 1;
        LAS unsigned char* kt = lds + NA_KT0 + buf * 17408; LAS unsigned char* vt = lds + NA_VT0 + buf * 20480; LAS float* rkl = (LAS float*)(lds + NA_RK0 + buf * 256);
        NA_STAGE(st);
        const int kr = kr_lo + st - 4;
        const bool active = (kr >= rs_a && kr < rs_a + 8) || (kr >= rs_b && kr < rs_b + 8);
        if (active) {
            const bool rowok = kr >= rs_q && kr < rs_q + 8;
            const int dr = clampi(kr - qrow + 7, 0, 14);
            na_tile<true>(kt, vt, rkl, cs, qf, O, mrun, lsum, lds + NA_RPB + (dr * 64 + bidx0) * 4, rowok ? cmask : 0u, r, hh, q4, p4, blk, lane);
        }
    }
#undef NA_STAGE
#undef NA_PREFETCH
    lsum += shx(lsum, 32, lane);
    const float inv = __builtin_amdgcn_rcpf(lsum);
    v4u zq[4][2];
#pragma unroll
    for (int i = 0; i < 4; ++i)
#pragma unroll
        for (int gp = 0; gp < 2; ++gp) zq[i][gp] = *(const GAS v4u*)(P + qtok * NP + OFF_BZ + head * 128 + 32 * i + 16 * gp + 8 * hh);
    if (G2B_I8 && !is_ctx) {
        float mx = 0.f;
#pragma unroll
        for (int i = 0; i < 4; ++i)
#pragma unroll
            for (int gp = 0; gp < 2; ++gp) {
                v2u za = {zq[i][gp].x, zq[i][gp].y}, zb = {zq[i][gp].z, zq[i][gp].w}; pair_swap(za, zb);
                const int ga = 4 * (2 * gp), gb = 4 * (2 * gp + 1);
                O[i][ga + 0] *= inv * silu(bflo(za.x)); O[i][ga + 1] *= inv * silu(bfhi(za.x)); O[i][ga + 2] *= inv * silu(bflo(za.y)); O[i][ga + 3] *= inv * silu(bfhi(za.y));
                O[i][gb + 0] *= inv * silu(bflo(zb.x)); O[i][gb + 1] *= inv * silu(bfhi(zb.x)); O[i][gb + 2] *= inv * silu(bflo(zb.y)); O[i][gb + 3] *= inv * silu(bfhi(zb.y));
#pragma unroll
                for (int c = 0; c < 4; ++c) mx = fmaxf(mx, fmaxf(__builtin_fabsf(O[i][ga + c]), __builtin_fabsf(O[i][gb + c]))); }
        mx = fmaxf(fmaxf(mx, shx(mx, 32, lane)), 1e-30f);
        const float qs = 127.0f * __builtin_amdgcn_rcpf(mx);
        if (hh == 0) ((float*)(ws + WS_SHB))[qtok * 16 + head] = mx * (1.0f / 127.0f);
        unsigned char* yq8 = ws + WS_YBH8 + qtok * 2048 + head * 128;
#pragma unroll
        for (int i = 0; i < 4; ++i)
#pragma unroll
            for (int gp = 0; gp < 2; ++gp) { const int ga = 4 * (2 * gp), gb = 4 * (2 * gp + 1);
                unsigned wa = pack_i8(O[i][ga + 0] * qs, O[i][ga + 1] * qs, O[i][ga + 2] * qs, O[i][ga + 3] * qs), wb = pack_i8(O[i][gb + 0] * qs, O[i][gb + 1] * qs, O[i][gb + 2] * qs, O[i][gb + 3] * qs);
                auto sw = __builtin_amdgcn_permlane32_swap(wa, wb, false, false); wa = sw[0]; wb = sw[1];
                *(GAS v2u*)(yq8 + 32 * i + 16 * gp + 8 * hh) = (v2u){wa, wb}; }
        return;
    }
#pragma unroll
    for (int i = 0; i < 4; ++i)
#pragma unroll
        for (int gp = 0; gp < 2; ++gp) {
            v2u za = {zq[i][gp].x, zq[i][gp].y}, zb = {zq[i][gp].z, zq[i][gp].w}; pair_swap(za, zb);
            const int ga = 4 * (2 * gp), gb = 4 * (2 * gp + 1);
            v2u wa, wb;
            wa.x = pkh(O[i][ga + 0] * inv * silu(bflo(za.x)), O[i][ga + 1] * inv * silu(bfhi(za.x))); wa.y = pkh(O[i][ga + 2] * inv * silu(bflo(za.y)), O[i][ga + 3] * inv * silu(bfhi(za.y)));
            wb.x = pkh(O[i][gb + 0] * inv * silu(bflo(zb.x)), O[i][gb + 1] * inv * silu(bfhi(zb.x))); wb.y = pkh(O[i][gb + 2] * inv * silu(bflo(zb.y)), O[i][gb + 3] * inv * silu(bfhi(zb.y)));
            pair_swap(wa, wb);
            *(GAS v4u*)(YB + qtok * 2048 + head * 128 + 32 * i + 16 * gp + 8 * hh) = (v4u){wa.x, wa.y, wb.x, wb.y}; }
}

__device__ __forceinline__ void na_phase(const Args& a, LAS unsigned char* lds, int l, bool need_ctx, int tid, int lane, int wave) {
    int tab_head = -1;
    const int nper = (2048 + (int)gridDim.x - 1) / (int)gridDim.x;
    const int vbx = (gridDim.x == 256) ? (((int)blockIdx.x & 7) * 32 + ((int)blockIdx.x >> 3)) : (int)blockIdx.x;
    for (int k = 0; k < nper; ++k) { const int uu = vbx * nper + k; if (uu >= 2048) break; const int b = uu >> 10, head = (uu >> 6) & 15, rq = uu & 63; na_unit(a, lds, l, b, head, 4 * rq, false, tab_head, tid, lane, wave); }
    if (need_ctx) for (int v = (int)blockIdx.x; v < 32; v += gridDim.x) na_unit(a, lds, l, v >> 4, v & 15, 0, true, tab_head, tid, lane, wave);
    __syncthreads();
}

constexpr int NPHASE = 1 + 9 * DEPTH;
#ifndef G23_ALIGN
#define G23_ALIGN true
#endif
#ifndef WGM_SMALL
#define WGM_SMALL 2
#endif
#ifndef G1_ALIGN
#define G1_ALIGN true
#endif
#ifndef G1_SP2
#define G1_SP2 true
#endif
#define PH_ON(x) (PHSEL < 0 || PHSEL == (x))
#ifndef REPEAT_PH
#define REPEAT_PH -1
#endif
#define REPS(k) ((REPEAT_PH == (k)) ? 2 : 1)
#ifdef REP_HALFK
#define G1_KEXT(r) (((r) == 0 && REPEAT_PH == 2) ? 1024 : 2048)
#else
#define G1_KEXT(r) 2048
#endif
template <int PHSEL>
__global__ void __launch_bounds__(NWAVES * 64, 2) fwd_kernel(Args args) {
    extern __shared__ __attribute__((aligned(16))) unsigned char lds_raw[];
    LAS unsigned char* lds = (LAS unsigned char*)lds_raw;
    int tid = threadIdx.x, lane = tid & 63, wave = __builtin_amdgcn_readfirstlane(tid >> 6);
#define FRESH_TID() do { lane = fresh_lane(); tid = wave * 64 + lane; } while (0)
    volatile LAS unsigned* MISC = (volatile LAS unsigned*)(lds + MISC_OFF);
    for (int u = tid; u < (LDS_BYTES - RING_BYTES) / 4; u += NWAVES * 64) ((LAS unsigned*)(lds + RING_BYTES))[u] = 0u;
    __syncthreads();
    unsigned char* ws = args.ws;
    gu32* ctl = (gu32*)(ws + WS_CTL);
    const bool use_bar = (args.ph_hi - args.ph_lo) > 1;
    XcdBarrier bar; bar.bar = (unsigned*)(ctl + CW_BAR); bar.x = 0; bar.st = nullptr;
    if (use_bar) bar = xcd_barrier_post((unsigned*)(ctl + CW_BAR), MISC + 8);
    const int lo = args.ph_lo, hi = args.ph_hi;
#define IN(k) (lo <= (k) && (k) < hi)
#define SEAM(k) do { if (IN(k) && IN((k) + 1)) xcd_barrier(bar); } while (0)

    if (PH_ON(0) && IN(0)) { for (int rep_ = 0; rep_ < REPS(0); ++rep_) { prologue(args, lds, tid, lane, wave, rep_); SEAM(0); } }
    for (int l = 0; l < DEPTH; ++l) {
        const int pb = 1 + 9 * l; const bool need_ctx = l < DEPTH - 1;
        const int mrows = need_ctx ? MALL : MLAT;
        const int mrows_ab = MLAT;
        const float* MODl = (const float*)(ws + WS_MOD) + (size_t)l * 3 * 6144;
        if (PH_ON(1) && IN(pb + 0)) { for (int rep_ = 0; rep_ < REPS(1); ++rep_) { FRESH_TID();
#if G2B_I8
            if (l == 0) { wbquant_rows(ws, WS_WAB + (size_t)2048 * 4096, (size_t)2 * 2048 * 4096, WS_WBQ0, (size_t)NPAD * 4096, WS_CSB, lane, wave); FRESH_TID();
#if G3_I8
                wbquant_rows(ws, WS_WO, (size_t)2048 * 4096, WS_WOQ0, (size_t)1024 * 4096, WS_CSO, lane, wave); FRESH_TID();
#endif
            }
#endif
            norm_phase(args, lds, l, tid, lane, wave); SEAM(pb + 0); } }
        if (PH_ON(2) && IN(pb + 1)) { for (int rep_ = 0; rep_ < REPS(2); ++rep_) {
            pg8::StaticOrder S; S.init(MALL, NPAD, (int)gridDim.x, (int)blockIdx.x);
#if G1_I8
            const int nfirst = G1_STAGGER ? ((int)blockIdx.x & 7) % 5 : 0;
            pg8::Gemm gb{(const pg8::bf16_t*)(ws + WS_H), (const pg8::bf16_t*)(ws + WS_WIN) + (size_t)l * NPAD * 2048, MALL, NPAD, 2048, 2048};
            pg8::MapOrder SB; SB.base.init(MALL, (81 - I8_NT) * 256, (int)gridDim.x, (int)gridDim.x - 1 - (int)blockIdx.x); SB.mask = 0x3FFu & ~I8_MASK;
            pg8::EpiIn EB{(pg8::bf16_t*)(ws + WS_P), (float*)(ws + WS_G), (float*)(ws + WS_SSQ), args.in[8] + (size_t)l * NIN, (const float*)(ws + WS_ROPE), MALL};
            if (G1_STAGGER) { SB.i0 = 0; SB.i1 = nfirst; pg8::gemm_phase<pg8::EpiIn, pg8::MapOrder, G1_ALIGN, G1_SP2>(lds, gb, SB, EB, wave); }
            {
                pg8::Gemm g{(const pg8::bf16_t*)(ws + WS_HQ), (const pg8::bf16_t*)(ws + WS_WQ + (size_t)l * NPAD * 2048), MALL, NPAD, 1024, 1024};
                pg8::MapOrder SQ; SQ.base.init(MALL, I8_NT * 256, (int)gridDim.x, (int)blockIdx.x, G1_WGMQ); SQ.mask = I8_MASK;
#if G1_BAL
                { const int G = (int)gridDim.x, remq = (MALL / 256 * I8_NT) % G, remb = (MALL / 256 * (81 - I8_NT)) % G;
                  const int rest = G - remb; if (remq > rest && remq <= 2 * rest) { SQ.n2 = remq - rest; SQ.n1 = rest - SQ.n2; } }
#endif
                pg8::EpiInQ E{(pg8::bf16_t*)(ws + WS_P), (float*)(ws + WS_G), (float*)(ws + WS_SSQ), args.in[8] + (size_t)l * NIN, (const float*)(ws + WS_ROPE), MALL, (const float*)(ws + WS_RS), (const float*)(ws + WS_CS) + (size_t)l * NPAD};
                pg8::gemm_phase<pg8::EpiInQ, pg8::MapOrder, G1_ALIGN, G1_SP2, true>(lds, g, SQ, E, wave);
            }
            SB.i0 = nfirst; SB.i1 = 1 << 30; pg8::gemm_phase<pg8::EpiIn, pg8::MapOrder, G1_ALIGN, G1_SP2>(lds, gb, SB, EB, wave);
#else
            pg8::Gemm g{(const pg8::bf16_t*)(ws + WS_H), (const pg8::bf16_t*)(ws + WS_WIN) + (size_t)l * NPAD * 2048, MALL, NPAD, 2048, G1_KEXT(rep_)};
            pg8::EpiIn E{(pg8::bf16_t*)(ws + WS_P), (float*)(ws + WS_G), (float*)(ws + WS_SSQ), args.in[8] + (size_t)l * NIN, (const float*)(ws + WS_ROPE), MALL};
            pg8::gemm_phase<pg8::EpiIn, pg8::StaticOrder, G1_ALIGN, G1_SP2>(lds, g, S, E, wave);
#endif
            SEAM(pb + 1);
        } }
        if ((PH_ON(3) || PHSEL == 10) && IN(pb + 2)) { for (int rep_ = 0; rep_ < REPS(3); ++rep_) { FRESH_TID(); mlstm_phase<PHSEL == 3 ? 1 : (PHSEL == 10 ? 2 : 0)>(args, lds, 1, need_ctx, tid, lane, wave); if (PHSEL < 0) { FRESH_TID(); na_phase(args, lds, l, need_ctx, tid, lane, wave); } SEAM(pb + 2); } }
        if (PH_ON(4) && IN(pb + 3)) { for (int rep_ = 0; rep_ < REPS(4); ++rep_) { FRESH_TID(); mlstm_phase<0>(args, lds, 2, need_ctx, tid, lane, wave);
            if (need_ctx) { FRESH_TID(); post_rows(args, lds, l, MLAT, MALL, (int)blockIdx.x * NWAVES + wave, (int)gridDim.x * NWAVES, tid, lane, wave); }
            SEAM(pb + 3); } }
        if (PHSEL == 5 && IN(pb + 4)) { FRESH_TID(); na_phase(args, lds, l, need_ctx, tid, lane, wave); }
        if (PH_ON(6) && IN(pb + 5)) { for (int rep_ = 0; rep_ < REPS(6); ++rep_) {
            const int nctxw = need_ctx ? 32 : 0;
            if ((int)blockIdx.x < nctxw) {
                pg8::Gemm g{(const pg8::bf16_t*)(ws + WS_H), (const pg8::bf16_t*)(ws + WS_WAB) + (size_t)l * 2 * 2048 * 2048, 2 * MALL, 4096, 2048, 2048};
                pg8::PairOrder S; S.single = (int)blockIdx.x; S.base.init(256, 256, 1, 0);
                pg8::EpiMergePair E{(const pg8::bf16_t*)(ws + WS_P), (pg8::bf16_t*)(ws + WS_HF), (long)((WS_HB - WS_HF) / 2), 0};
                pg8::gemm_phase<pg8::EpiMergePair, pg8::PairOrder, G23_ALIGN, true>(lds, g, S, E, wave);
                FRESH_TID(); post_rows(args, lds, l, 0, POST_XR, (int)blockIdx.x * NWAVES + wave, nctxw * NWAVES, tid, lane, wave);
            } else { FRESH_TID(); post_rows(args, lds, l, nctxw ? POST_XR : 0, MLAT, ((int)blockIdx.x - nctxw) * NWAVES + wave, ((int)gridDim.x - nctxw) * NWAVES, tid, lane, wave); }
            SEAM(pb + 5); } }
        if (PH_ON(7) && IN(pb + 6)) { for (int rep_ = 0; rep_ < REPS(7); ++rep_) {
            pg8::Gemm g{(const pg8::bf16_t*)(ws + WS_H), (const pg8::bf16_t*)(ws + WS_WAB) + (size_t)l * 2 * 2048 * 2048, 2 * MALL, 4096, 2048, 2048};
            pg8::PairOrder S; S.single = -1; S.base.init(mrows_ab, 2048, (int)gridDim.x, (int)blockIdx.x, WGM_SMALL);
            pg8::EpiMergePair E{(const pg8::bf16_t*)(ws + WS_P), (pg8::bf16_t*)(ws + WS_HF), (long)((WS_HB - WS_HF) / 2), 1};
            if (need_ctx) {
                FRESH_TID(); const int gt = (int)blockIdx.x * 512 + tid, ngt = (int)gridDim.x * 512;
                for (int p = gt; p < MCTX * 256; p += ngt) { const size_t off = (size_t)MLAT * 2048 + (size_t)p * 8;
                    const v4u ta = *(const GAS v4u*)((const bf16*)(ws + WS_HF) + off), tb = *(const GAS v4u*)((const bf16*)(ws + WS_HB) + off);
                    v4u o; o.x = pkh(bflo(ta.x) + bflo(tb.x), bfhi(ta.x) + bfhi(tb.x)); o.y = pkh(bflo(ta.y) + bflo(tb.y), bfhi(ta.y) + bfhi(tb.y)); o.z = pkh(bflo(ta.z) + bflo(tb.z), bfhi(ta.z) + bfhi(tb.z)); o.w = pkh(bflo(ta.w) + bflo(tb.w), bfhi(ta.w) + bfhi(tb.w));
                    *(GAS v4u*)((bf16*)(ws + WS_HB) + off) = o; }
            }
#if G2B_I8
            {
                pg8::Gemm ga{(const pg8::bf16_t*)(ws + WS_H), (const pg8::bf16_t*)(ws + WS_WAB) + (size_t)l * 2 * 2048 * 2048, MLAT, 2048, 2048, 2048};
                pg8::StaticOrder SA; SA.init(mrows_ab, 2048, (int)gridDim.x, (int)blockIdx.x, WGM_SMALL);
                pg8::EpiMergePair EA{(const pg8::bf16_t*)(ws + WS_P), (pg8::bf16_t*)(ws + WS_HF), (long)((WS_HB - WS_HF) / 2), 2};
                pg8::gemm_phase<pg8::EpiMergePair, pg8::StaticOrder, G23_ALIGN, true>(lds, ga, SA, EA, wave);
                pg8::Gemm gq{(const pg8::bf16_t*)(ws + WS_YBQ), (const pg8::bf16_t*)(ws + WS_WBQ0 + (size_t)l * NPAD * 4096), MLAT, 2048, 1024, 1024};
                pg8::EpiMergeQ EQ{(const pg8::bf16_t*)(ws + WS_P), (pg8::bf16_t*)(ws + WS_HF), (long)((WS_HB - WS_HF) / 2), (const float*)(ws + WS_RSB), (const float*)(ws + WS_CSB) + (size_t)l * 2048};
                pg8::gemm_phase<pg8::EpiMergeQ, pg8::StaticOrder, G23_ALIGN, true, true>(lds, gq, SA, EQ, wave);
            }
#else
            pg8::gemm_phase<pg8::EpiMergePair, pg8::PairOrder, G23_ALIGN, true>(lds, g, S, E, wave);
#endif
            SEAM(pb + 6);
        } }
#if G3_I8
        if (PHSEL < 0 && IN(pb + 7)) {
            const int nsl = need_ctx ? 64 : 0;
            if ((int)blockIdx.x < nsl) {
                const int ks = (int)blockIdx.x & 3;
                pg8::Gemm g2{(const pg8::bf16_t*)(ws + WS_HB) + 512 * ks, (const pg8::bf16_t*)(ws + WS_WO) + (size_t)l * 2048 * 2048 + 512 * ks, MALL, 2048, 2048, 512};
                pg8::SliceOrder S2; S2.c = (int)blockIdx.x;
                pg8::EpiPart E2{(float*)(ws + WS_PART) + (size_t)ks * 512 * 2048};
                pg8::gemm_phase<pg8::EpiPart, pg8::SliceOrder, true, true>(lds, g2, S2, E2, wave);
                FRESH_TID(); yquant_rows(ws, 0, YQ_XR, (int)blockIdx.x * NWAVES + wave, nsl * NWAVES, lane, wave);
            } else { FRESH_TID(); yquant_rows(ws, nsl ? YQ_XR : 0, MLAT, ((int)blockIdx.x - nsl) * NWAVES + wave, ((int)gridDim.x - nsl) * NWAVES, lane, wave); }
            SEAM(pb + 7); }
#endif
        if (PH_ON(9) && IN(pb + 8)) {
            pg8::StaticOrder S; S.init(MLAT, 2048, (int)gridDim.x, (int)blockIdx.x, WGM_SMALL);
#if G3_I8
            pg8::Gemm g{(const pg8::bf16_t*)(ws + WS_YBQ), (const pg8::bf16_t*)(ws + WS_WOQ0 + (size_t)l * 1024 * 4096), MLAT, 2048, 1024, 1024};
            pg8::EpiOutQ E{l == 0 ? args.in[0] : args.out, args.out, l == 0 ? args.in[2] : (const float*)(ws + WS_XC), (float*)(ws + WS_XC), MODl, args.in[16] + (size_t)l * 2048, (const float*)(ws + WS_RSB), (const float*)(ws + WS_CSO) + (size_t)l * 2048};
            pg8::gemm_phase<pg8::EpiOutQ, pg8::StaticOrder, true, true, true>(lds, g, S, E, wave);
#else
            pg8::Gemm g{(const pg8::bf16_t*)(ws + WS_HB), (const pg8::bf16_t*)(ws + WS_WO) + (size_t)l * 2048 * 2048, MLAT, 2048, 2048, 2048};
            pg8::EpiOut E{l == 0 ? args.in[0] : args.out, args.out, l == 0 ? args.in[2] : (const float*)(ws + WS_XC), (float*)(ws + WS_XC), MODl, args.in[16] + (size_t)l * 2048};
            pg8::gemm_phase<pg8::EpiOut, pg8::StaticOrder, true, true>(lds, g, S, E, wave);
#endif
            if (need_ctx && !G3_I8) {
                const int ks = (int)blockIdx.x & 3;
                pg8::Gemm g2{(const pg8::bf16_t*)(ws + WS_HB) + 512 * ks, (const pg8::bf16_t*)(ws + WS_WO) + (size_t)l * 2048 * 2048 + 512 * ks, MALL, 2048, 2048, 512};
                pg8::SliceOrder S2; S2.c = (int)blockIdx.x;
                pg8::EpiPart E2{(float*)(ws + WS_PART) + (size_t)ks * 512 * 2048};
                pg8::gemm_phase<pg8::EpiPart, pg8::SliceOrder, true, true>(lds, g2, S2, E2, wave);
            }
            SEAM(pb + 8);
        }
    }
#undef IN
#undef SEAM
}

template <int PHSEL> static void launch_one(const Args& a, int grid, hipStream_t stream, bool first) {
    if (first) (void)hipFuncSetAttribute((const void*)fwd_kernel<PHSEL>, hipFuncAttributeMaxDynamicSharedMemorySize, LDS_BYTES);
    hipLaunchKernelGGL(fwd_kernel<PHSEL>, dim3(grid), dim3(NWAVES * 64), LDS_BYTES, stream, a);
}
extern "C" void kernel_launch(void* const* d_in, const int* in_sizes, int n_in, void* d_out, int out_size, void* d_ws, size_t ws_size, hipStream_t stream) {
    static int grid = 0; static bool first = true;
    if (grid == 0) {
        if (n_in != 17 || out_size != MLAT * DM || ws_size < WS_END) { fprintf(stderr, "kernel_launch: unexpected shapes / workspace (n_in %d out %d ws %zu need %zu)\n", n_in, out_size, ws_size, (size_t)WS_END); grid = -1; return; }
        int dev = 0, cus = 0;
        if (hipGetDevice(&dev) != hipSuccess || hipDeviceGetAttribute(&cus, hipDeviceAttributeMultiprocessorCount, dev) != hipSuccess) { grid = -1; return; }
        grid = cus;
    }
    if (grid < 0) return;
    if (hipMemsetAsync((char*)d_ws + WS_CTL, 0, CTL_ZERO_BYTES, stream) != hipSuccess) return;
    Args a{};
    for (int i = 0; i < 17; ++i) a.in[i] = (const float*)d_in[i];
    a.out = (float*)d_out; a.ws = (unsigned char*)d_ws;
#if N_LAUNCH_MODE == 1
#ifdef PROBE_EXTRA_HI
    a.ph_lo = PROBE_EXTRA_LO; a.ph_hi = PROBE_EXTRA_HI; launch_one<-1>(a, grid, stream, first);
    if (hipMemsetAsync((char*)d_ws + WS_CTL, 0, CTL_ZERO_BYTES, stream) != hipSuccess) return;
#endif
    a.ph_lo = 0; a.ph_hi = NPHASE;
    launch_one<-1>(a, grid, stream, first);
#else
    a.ph_lo = 0; a.ph_hi = 1; launch_one<0>(a, grid, stream, first);
    for (int l = 0; l < DEPTH; ++l) { const int pb = 1 + 9 * l;
        a.ph_lo = pb + 0; a.ph_hi = pb + 1; launch_one<1>(a, grid, stream, first);
        a.ph_lo = pb + 1; a.ph_hi = pb + 2; launch_one<2>(a, grid, stream, first);
        a.ph_lo = pb + 2; a.ph_hi = pb + 3; launch_one<3>(a, grid, stream, first); launch_one<10>(a, grid, stream, first);
        a.ph_lo = pb + 3; a.ph_hi = pb + 4; launch_one<4>(a, grid, stream, first);
        a.ph_lo = pb + 4; a.ph_hi = pb + 5; launch_one<5>(a, grid, stream, first);
        a.ph_lo = pb + 5; a.ph_hi = pb + 6; launch_one<6>(a, grid, stream, first);
        a.ph_lo = pb + 6; a.ph_hi = pb + 7; launch_one<7>(a, grid, stream, first);
        a.ph_lo = pb + 7; a.ph_hi = pb + 8; launch_one<8>(a, grid, stream, first);
        a.ph_lo = pb + 8; a.ph_hi = pb + 9; launch_one<9>(a, grid, stream, first);
    }
#endif
    first = false;
}
```
